# Optimizing an MI355X kernel written in HIP

```python
import math
import jax, jax.numpy as jnp
from jax import lax
import numpy as np

D_MODEL = 2048
BATCH = 4
SEQ = 2048
DEPTH = 2
DEC_BATCH = 128
DEC_SEQ = 1
PAST_LEN = 16384
PAGE_SIZE = 128

DN_HEADS = 8
DN_DK = 128
DN_DV = 128
DN_QK = DN_HEADS * DN_DK
DN_V = DN_HEADS * DN_DV
CONV_W = 4
CONV_CH = 2 * DN_QK + DN_V
CHUNK = 64
S5_CH = D_MODEL // 2
S5_GROUP = 16
S5_GROUPS = S5_CH // S5_GROUP
S5_STATE = 64
FFN_HIDDEN = -((-8 * D_MODEL) // (3 * 256)) * 256
IN_SIZES = (DN_QK, DN_QK, DN_V, DN_V, DN_HEADS, DN_HEADS, S5_CH, D_MODEL, D_MODEL)
IN_DIM = DN_QK + DN_QK + DN_V + DN_V + DN_HEADS + DN_HEADS + S5_CH + D_MODEL + D_MODEL
NORM_EPS = 1e-6
L2_EPS = 1e-6

kernel_name = "hybrid_gdn_s5_decoder_step"


def rms_norm(x, w):
    xf = x.astype(jnp.float32)
    y = xf * lax.rsqrt(jnp.mean(xf * xf, axis=-1, keepdims=True) + NORM_EPS)
    return (y * w.astype(jnp.float32)).astype(x.dtype)


def l2norm(x):
    return x * lax.rsqrt(jnp.sum(x * x, axis=-1, keepdims=True) + L2_EPS)


def causal_conv(x, buf, w):
    L = x.shape[1]
    xp = jnp.concatenate([buf.astype(x.dtype), x], axis=1)
    y = sum(xp[:, i:i + L] * w[i] for i in range(CONV_W))
    return jax.nn.silu(y), xp[:, L:]


def gated_delta_chunked(q, k, v, beta, g, s0):
    b, L, h, _ = q.shape
    dv = v.shape[-1]
    n = L // CHUNK

    def blk(t):
        t = t.reshape((b, n, CHUNK, h) + t.shape[3:])
        return jnp.moveaxis(jnp.moveaxis(t, 1, 0), 2, 3)

    q, k, v, beta, g = (blk(t) for t in (q, k, v, beta, g))
    gc = jnp.cumsum(g, axis=-1)
    idx = jnp.arange(CHUNK)
    causal = idx[:, None] >= idx[None, :]
    strict = idx[:, None] > idx[None, :]
    gamma = jnp.exp(jnp.where(causal, gc[..., :, None] - gc[..., None, :], -jnp.inf))
    kb = k * beta[..., None]
    vb = v * beta[..., None]
    a_mat = jnp.where(strict, jnp.einsum('nbhid,nbhjd->nbhij', kb, k) * gamma, 0.0)
    eye = jnp.eye(CHUNK, dtype=q.dtype)
    t_inv = lax.linalg.triangular_solve(eye + a_mat, jnp.broadcast_to(eye, a_mat.shape),
                                        left_side=True, lower=True)
    u = t_inv @ vb
    w = t_inv @ (kb * jnp.exp(gc)[..., None])
    qk = jnp.einsum('nbhid,nbhjd->nbhij', q, k) * gamma
    q_dec = q * jnp.exp(gc)[..., None]
    g_last = gc[..., -1]
    k_dec = k * jnp.exp(g_last[..., None] - gc)[..., None]

    def step(S, inp):
        u_c, w_c, qk_c, qd_c, kd_c, gl_c = inp
        v_new = u_c - w_c @ S
        o = qd_c @ S + qk_c @ v_new
        S = S * jnp.exp(gl_c)[..., None, None] + jnp.swapaxes(kd_c, -1, -2) @ v_new
        return S, o

    S, o = lax.scan(step, s0, (u, w, qk, q_dec, k_dec, g_last))
    o = jnp.swapaxes(jnp.moveaxis(o, 0, 1), 2, 3).reshape(b, L, h, dv)
    return o, S


def gated_delta_recurrent(q, k, v, beta, g, s0):
    def step(S, inp):
        q_t, k_t, v_t, b_t, g_t = inp
        S = S * jnp.exp(g_t)[..., None, None]
        v_new = (v_t - jnp.einsum('bhk,bhkv->bhv', k_t, S)) * b_t[..., None]
        S = S + jnp.einsum('bhk,bhv->bhkv', k_t, v_new)
        return S, jnp.einsum('bhk,bhkv->bhv', q_t, S)

    xs = tuple(jnp.moveaxis(t, 1, 0) for t in (q, k, v, beta, g))
    S, o = lax.scan(step, s0, xs)
    return jnp.moveaxis(o, 0, 1), S


def s5_scan(u, x0_re, x0_im, lam_re, lam_im, log_dt, b_re, b_im, c_re, c_im, d_skip):
    f32 = jnp.float32
    lam_re, lam_im, log_dt = lam_re.astype(f32), lam_im.astype(f32), log_dt.astype(f32)
    b_re, b_im, c_re, c_im = b_re.astype(f32), b_im.astype(f32), c_re.astype(f32), c_im.astype(f32)
    bsz, L, _ = u.shape
    ug = u.reshape(bsz, L, S5_GROUPS, S5_GROUP)
    dt = jnp.exp(log_dt)[:, None]
    mag = jnp.exp(lam_re * dt)
    ar = mag * jnp.cos(lam_im * dt)
    ai = mag * jnp.sin(lam_im * dt)
    nr = ar - 1.0
    den = lam_re * lam_re + lam_im * lam_im
    fr = (nr * lam_re + ai * lam_im) / den
    fi = (ai * lam_re - nr * lam_im) / den
    bbar_re = fr[..., None] * b_re - fi[..., None] * b_im
    bbar_im = fr[..., None] * b_im + fi[..., None] * b_re
    bu_re = jnp.einsum('gpc,blgc->blgp', bbar_re, ug)
    bu_im = jnp.einsum('gpc,blgc->blgp', bbar_im, ug)
    a_re = jnp.broadcast_to(ar, bu_re.shape)
    a_im = jnp.broadcast_to(ai, bu_im.shape)

    def combine(e1, e2):
        a1r, a1i, b1r, b1i = e1
        a2r, a2i, b2r, b2i = e2
        return (a2r * a1r - a2i * a1i, a2r * a1i + a2i * a1r,
                a2r * b1r - a2i * b1i + b2r, a2r * b1i + a2i * b1r + b2i)

    pr, pim, sr, si = lax.associative_scan(combine, (a_re, a_im, bu_re, bu_im), axis=1)
    x0r = x0_re.astype(f32)[:, None]
    x0i = x0_im.astype(f32)[:, None]
    x_re = pr * x0r - pim * x0i + sr
    x_im = pr * x0i + pim * x0r + si
    y = jnp.einsum('gcp,blgp->blgc', c_re, x_re) - jnp.einsum('gcp,blgp->blgc', c_im, x_im)
    y = y.reshape(bsz, L, S5_CH) + d_skip.astype(f32) * u
    return y, x_re[:, -1], x_im[:, -1]


def decoder_layer(x, conv_buf, dn_s, s5r, s5i, lw, chunked):
    (n1, w_in, conv_w, a_log, dt_bias, dn_nw, w_br_dn, lam_re, lam_im, log_dt,
     b_re, b_im, c_re, c_im, d_s, w_glu, w_br_s5, w_out, n2, wg, wu, wd) = lw
    f32 = jnp.float32
    bsz, L, _ = x.shape
    h = rms_norm(x, n1)
    proj = h @ w_in
    offs = np.cumsum(np.array(IN_SIZES))[:-1].tolist()
    q, k, v, z, bt, a, s5u, gd, gs = jnp.split(proj, offs, axis=-1)

    qkv, conv_new = causal_conv(jnp.concatenate([q, k, v], axis=-1), conv_buf, conv_w)
    qkv = qkv.astype(f32)
    q = l2norm(qkv[..., :DN_QK].reshape(bsz, L, DN_HEADS, DN_DK)) * (DN_DK ** -0.5)
    k = l2norm(qkv[..., DN_QK:2 * DN_QK].reshape(bsz, L, DN_HEADS, DN_DK))
    v = qkv[..., 2 * DN_QK:].reshape(bsz, L, DN_HEADS, DN_DV)
    beta = jax.nn.sigmoid(bt.astype(f32))
    g = -jnp.exp(a_log.astype(f32)) * jax.nn.softplus(a.astype(f32) + dt_bias.astype(f32))
    s0 = dn_s.astype(f32)
    if chunked:
        o, dn_new = gated_delta_chunked(q, k, v, beta, g, s0)
    else:
        o, dn_new = gated_delta_recurrent(q, k, v, beta, g, s0)
    zf = jax.nn.silu(z.astype(f32)).reshape(bsz, L, DN_HEADS, DN_DV)
    o = o * lax.rsqrt(jnp.mean(o * o, axis=-1, keepdims=True) + NORM_EPS) * dn_nw.astype(f32) * zf
    br_dn = o.reshape(bsz, L, DN_V).astype(x.dtype) @ w_br_dn

    y5, s5r_new, s5i_new = s5_scan(s5u.astype(f32), s5r, s5i, lam_re, lam_im, log_dt,
                                   b_re, b_im, c_re, c_im, d_s)
    g5 = jax.nn.gelu(y5)
    g5 = g5 * jax.nn.sigmoid(g5 @ w_glu.astype(f32))
    br_s5 = g5.astype(x.dtype) @ w_br_s5

    merged = jax.nn.sigmoid(gd) * br_dn + jax.nn.sigmoid(gs) * br_s5
    x = x + merged @ w_out

    h2 = rms_norm(x, n2)
    x = x + (jax.nn.silu(h2 @ wg) * (h2 @ wu)) @ wd
    return x, conv_new, dn_new, s5r_new, s5i_new


def setup_inputs(seed: int = 0) -> dict:
    key = jax.random.key(seed)
    ks = iter(jax.random.split(key, 40))
    f32 = jnp.float32

    def nrm(shape, scale):
        return jax.random.normal(next(ks), shape, f32) * scale

    def unif(shape, lo, hi):
        return jax.random.uniform(next(ks), shape, f32, lo, hi)

    x_prompt = nrm((BATCH, SEQ, D_MODEL), 1.0)
    x_sample = nrm((DEC_BATCH, DEC_SEQ, D_MODEL), 1.0)
    state_dn_conv = nrm((DEPTH, DEC_BATCH, CONV_W - 1, CONV_CH), 1.0)
    state_dn_ssm = nrm((DEPTH, DEC_BATCH, DN_HEADS, DN_DK, DN_DV), 0.1)
    state_s5_re = nrm((DEPTH, DEC_BATCH, S5_GROUPS, S5_STATE), 0.3)
    state_s5_im = nrm((DEPTH, DEC_BATCH, S5_GROUPS, S5_STATE), 0.3)

    norm1 = 1.0 + nrm((DEPTH, D_MODEL), 0.01)
    w_in = nrm((DEPTH, D_MODEL, IN_DIM), D_MODEL ** -0.5)
    dn_conv_w = nrm((DEPTH, CONV_W, CONV_CH), CONV_W ** -0.5)
    dn_a_log = jnp.log(unif((DEPTH, DN_HEADS), 1.0, 16.0))
    dt = jnp.exp(unif((DEPTH, DN_HEADS), math.log(1e-3), math.log(1e-1)))
    dn_dt_bias = dt + jnp.log(-jnp.expm1(-dt))
    dn_norm_w = 1.0 + nrm((DEPTH, DN_DV), 0.01)
    w_br_dn = nrm((DEPTH, DN_V, D_MODEL), DN_V ** -0.5)
    s5_lam_re = -0.5 + nrm((DEPTH, S5_GROUPS, S5_STATE), 0.01)
    s5_lam_im = jnp.broadcast_to(math.pi * jnp.arange(S5_STATE, dtype=f32), (DEPTH, S5_GROUPS, S5_STATE)) + 0.0
    s5_log_dt = unif((DEPTH, S5_GROUPS), math.log(1e-3), math.log(1e-1))
    s5_b_re = nrm((DEPTH, S5_GROUPS, S5_STATE, S5_GROUP), (2 * S5_GROUP) ** -0.5)
    s5_b_im = nrm((DEPTH, S5_GROUPS, S5_STATE, S5_GROUP), (2 * S5_GROUP) ** -0.5)
    s5_c_re = nrm((DEPTH, S5_GROUPS, S5_GROUP, S5_STATE), S5_STATE ** -0.5)
    s5_c_im = nrm((DEPTH, S5_GROUPS, S5_GROUP, S5_STATE), S5_STATE ** -0.5)
    s5_d = nrm((DEPTH, S5_CH), 1.0)
    w_glu = nrm((DEPTH, S5_CH, S5_CH), S5_CH ** -0.5)
    w_br_s5 = nrm((DEPTH, S5_CH, D_MODEL), S5_CH ** -0.5)
    w_out = nrm((DEPTH, D_MODEL, D_MODEL), D_MODEL ** -0.5)
    norm2 = 1.0 + nrm((DEPTH, D_MODEL), 0.01)
    w_ffn_gate = nrm((DEPTH, D_MODEL, FFN_HIDDEN), D_MODEL ** -0.5)
    w_ffn_up = nrm((DEPTH, D_MODEL, FFN_HIDDEN), D_MODEL ** -0.5)
    w_ffn_down = nrm((DEPTH, FFN_HIDDEN, D_MODEL), FFN_HIDDEN ** -0.5)
    norm_f = 1.0 + nrm((D_MODEL,), 0.01)
    return {
        "x_prompt": x_prompt, "x_sample": x_sample,
        "state_dn_conv": state_dn_conv, "state_dn_ssm": state_dn_ssm,
        "state_s5_re": state_s5_re, "state_s5_im": state_s5_im,
        "norm1": norm1, "w_in": w_in, "dn_conv_w": dn_conv_w, "dn_a_log": dn_a_log,
        "dn_dt_bias": dn_dt_bias, "dn_norm_w": dn_norm_w, "w_br_dn": w_br_dn,
        "s5_lam_re": s5_lam_re, "s5_lam_im": s5_lam_im, "s5_log_dt": s5_log_dt,
        "s5_b_re": s5_b_re, "s5_b_im": s5_b_im, "s5_c_re": s5_c_re, "s5_c_im": s5_c_im,
        "s5_d": s5_d, "w_glu": w_glu, "w_br_s5": w_br_s5, "w_out": w_out, "norm2": norm2,
        "w_ffn_gate": w_ffn_gate, "w_ffn_up": w_ffn_up, "w_ffn_down": w_ffn_down,
        "norm_f": norm_f,
    }


def reference(x_prompt, x_sample, state_dn_conv, state_dn_ssm, state_s5_re, state_s5_im,
              norm1, w_in, dn_conv_w, dn_a_log, dn_dt_bias, dn_norm_w, w_br_dn,
              s5_lam_re, s5_lam_im, s5_log_dt, s5_b_re, s5_b_im, s5_c_re, s5_c_im, s5_d,
              w_glu, w_br_s5, w_out, norm2, w_ffn_gate, w_ffn_up, w_ffn_down, norm_f):
    weights = (norm1, w_in, dn_conv_w, dn_a_log, dn_dt_bias, dn_norm_w, w_br_dn,
               s5_lam_re, s5_lam_im, s5_log_dt, s5_b_re, s5_b_im, s5_c_re, s5_c_im, s5_d,
               w_glu, w_br_s5, w_out, norm2, w_ffn_gate, w_ffn_up, w_ffn_down)

    def run(x, conv, ssm, sre, sim, chunked):
        conv_l, ssm_l, sre_l, sim_l = [], [], [], []
        for i in range(DEPTH):
            lw = tuple(w[i] for w in weights)
            x, c_new, d_new, r_new, m_new = decoder_layer(x, conv[i], ssm[i], sre[i], sim[i], lw, chunked)
            conv_l.append(c_new)
            ssm_l.append(d_new)
            sre_l.append(r_new)
            sim_l.append(m_new)
        return (rms_norm(x, norm_f), jnp.stack(conv_l), jnp.stack(ssm_l),
                jnp.stack(sre_l), jnp.stack(sim_l))

    f32 = jnp.float32
    p_conv0 = jnp.zeros((DEPTH, BATCH, CONV_W - 1, CONV_CH), x_prompt.dtype)
    p_ssm0 = jnp.zeros((DEPTH, BATCH, DN_HEADS, DN_DK, DN_DV), f32)
    p_s50 = jnp.zeros((DEPTH, BATCH, S5_GROUPS, S5_STATE), f32)
    y_prompt, p_dn_conv, p_dn_ssm, p_s5_re, p_s5_im = run(x_prompt, p_conv0, p_ssm0, p_s50, p_s50, True)
    y_sample, s_dn_conv, s_dn_ssm, s_s5_re, s_s5_im = run(
        x_sample, state_dn_conv, state_dn_ssm, state_s5_re, state_s5_im, False)
    return (y_prompt, y_sample, p_dn_conv, p_dn_ssm, p_s5_re, p_s5_im,
            s_dn_conv, s_dn_ssm, s_s5_re, s_s5_im)
```

```cpp
#include <hip/hip_runtime.h>
#include <stdint.h>
#include <stdio.h>

#define LAS __attribute__((address_space(3)))
#define GAS __attribute__((address_space(1)))
typedef unsigned short bf16_t;
typedef short bf16x8 __attribute__((ext_vector_type(8)));
typedef short s16x4 __attribute__((ext_vector_type(4)));
typedef float f32x4 __attribute__((ext_vector_type(4)));
typedef float f32x2 __attribute__((ext_vector_type(2)));
typedef unsigned u32x4 __attribute__((ext_vector_type(4)));
typedef unsigned u32x2 __attribute__((ext_vector_type(2)));

constexpr int D = 2048, NPROMPT = 8192, NSAMP = 128, MR = 8320, MP = 8448, SEQ = 2048, NB = 4;
constexpr int NH = 8, DK = 128, CONVCH = 3072, S5CH = 1024, S5G = 64, S5P = 64, FF = 5632, IN_DIM = 9232, NIN = 9472;
constexpr int NCHUNK = 32;
constexpr float NORM_EPS = 1e-6f;
constexpr int NPHASE = 20;
constexpr int LDS_BYTES = 163840, MISC_OFF = 163840 - 256;

constexpr size_t MiB = 1u << 20;
constexpr size_t WS_CTL = 0, CTL_ZERO_BYTES = 64 * 1024;
constexpr size_t WS_SSQ = 1 * MiB;
constexpr size_t WS_BA = 2 * MiB;
constexpr size_t WS_DEC = 3 * MiB;
constexpr size_t WS_A16 = 3 * MiB + 65536;
constexpr size_t WS_BBAR = 4 * MiB;
constexpr size_t WS_S5US = 5 * MiB;
constexpr size_t WS_W0 = 8 * MiB, WS_WSTRIDE = 141 * MiB;
constexpr size_t WO_IN = 0, WO_GU = 37 * MiB, WO_D = 81 * MiB, WO_OUT = 103 * MiB, WO_BRDN = 111 * MiB, WO_BRS5 = 115 * MiB, WO_GLU = 119 * MiB, WO_BTY = 121 * MiB, WO_BTL = 133 * MiB;
constexpr size_t WS_XB = 290 * MiB, WS_ZS = 323 * MiB, WS_SGD = WS_ZS + 16 * MiB + 512 * 1024, WS_SGS = WS_SGD + 33 * MiB;
constexpr size_t WS_S5A = WS_SGS + 33 * MiB, WS_S5L = WS_S5A + 24 * MiB, WS_ON = WS_S5L + 16 * MiB, WS_G5 = WS_ON + 16 * MiB + 512 * 1024;
constexpr size_t WS_G5G = WS_G5 + 16 * MiB + 512 * 1024, WS_MERGED = WS_G5G + 16 * MiB + 512 * 1024, WS_QKV = WS_MERGED + 33 * MiB;
constexpr size_t WS_PREP = WS_QKV + 49 * MiB + 512 * 1024, WS_ACT = WS_QKV, WS_END = WS_PREP + 72 * MiB;
constexpr size_t PREP_ITEM = 73728;
static_assert(WS_ACT + (size_t)MP * FF * 2 <= WS_END, "ACT overlay");
static_assert(WS_QKV == 528 * MiB, "map");

__device__ __forceinline__ unsigned f2bf(float f) { unsigned u = __float_as_uint(f); return (u + 0x7fffu + ((u >> 16) & 1u)) >> 16; }
__device__ __forceinline__ unsigned pk2(float lo, float hi) { return f2bf(lo) | (f2bf(hi) << 16); }
__device__ __forceinline__ float bflo(unsigned w) { return __uint_as_float(w << 16); }
__device__ __forceinline__ float bfhi(unsigned w) { return __uint_as_float(w & 0xffff0000u); }
__device__ __forceinline__ float bf2f(bf16_t b) { return __uint_as_float(((unsigned)b) << 16); }
__device__ __forceinline__ unsigned cvt_pk_bf16(float lo, float hi) { unsigned r; asm volatile("v_cvt_pk_bf16_f32 %0, %1, %2" : "=v"(r) : "v"(lo), "v"(hi)); return r; }
__device__ __forceinline__ float sigmoidf_(float x) { return 1.0f / (1.0f + __expf(-x)); }
__device__ __forceinline__ float siluf_(float x) { return x / (1.0f + __expf(-x)); }
__device__ __forceinline__ float softplusf_(float x) { return fmaxf(x, 0.f) + log1pf(__expf(-fabsf(x))); }
__device__ __forceinline__ float geluf_(float x) { const float u = 0.7978845608028654f * (x + 0.044715f * x * x * x); return 0.5f * x * (1.0f + tanhf(u)); }
__device__ __forceinline__ float wave_sum(float v) {
#pragma unroll
    for (int o = 1; o < 64; o <<= 1) v += __shfl_xor(v, o);
    return v;
}
#define LDS_WAIT() asm volatile("s_waitcnt lgkmcnt(0)" ::: "memory")
#define VM_WAIT() asm volatile("s_waitcnt vmcnt(0)" ::: "memory")

#define XB_TMO      128
#define XB_XCNT(j)  (256  + 64 * (j))
#define XB_XSUB(j)  (1280 + 64 * (j))
#define XB_XGEN(j)  (2304 + 64 * (j))
#define XB_TOP      3328
#define XB_TOPGEN   3392
#define XCD_BAR_WORDS 3456
#define XB_SPIN_CAP (1u << 20)
__device__ __forceinline__ unsigned xb_ld(unsigned* p)              { return __hip_atomic_load(p, __ATOMIC_RELAXED, __HIP_MEMORY_SCOPE_AGENT); }
__device__ __forceinline__ unsigned xb_add(unsigned* p, unsigned v) { return __hip_atomic_fetch_add(p, v, __ATOMIC_RELAXED, __HIP_MEMORY_SCOPE_AGENT); }
__device__ __forceinline__ unsigned xb_xcc_id() { return (unsigned)__builtin_amdgcn_s_getreg((3 << 11) | 20) & 0xFu; }
#define XB_SPIN(cond, bar) do { unsigned _sp = 0; while (cond) { __builtin_amdgcn_s_sleep(1); \
    if ((++_sp & 255u) == 0u) { if (xb_ld(&(bar)[XB_TMO])) break; if (_sp > XB_SPIN_CAP) { atomicAdd(&(bar)[XB_TMO], 1u); break; } } } } while (0)
struct XcdBarrier { unsigned* bar; unsigned x; volatile LAS unsigned* st; };
__device__ __forceinline__ XcdBarrier xcd_barrier_post(unsigned* bar, volatile LAS unsigned* st) {
    XcdBarrier b; b.bar = bar; b.x = xb_xcc_id(); b.st = st;
    if (threadIdx.x == 0) (void)xb_add(&bar[XB_XCNT(b.x)], 1u);
    return b;
}
__device__ __forceinline__ void xcd_barrier_complete(unsigned* bar, unsigned x, unsigned& nloc, unsigned& nx) {
    const unsigned G = gridDim.x * gridDim.y * gridDim.z;
    unsigned sum, cnt, mine, sp = 0u;
    for (;;) {
        sum = 0u; cnt = 0u; mine = 0u;
#pragma unroll
        for (unsigned j = 0; j < 16; ++j) { const unsigned c = xb_ld(&bar[XB_XCNT(j)]); sum += c; cnt += (c > 0u) ? 1u : 0u; mine = (j == x) ? c : mine; }
        if (sum == G) break;
        __builtin_amdgcn_s_sleep(1);
        if ((++sp & 255u) == 0u) { if (xb_ld(&bar[XB_TMO])) break; if (sp > XB_SPIN_CAP) { atomicAdd(&bar[XB_TMO], 1u); break; } }
    }
    nloc = mine > 0u ? mine : 1u; nx = cnt > 0u ? cnt : 1u;
}
__device__ __forceinline__ void xcd_barrier(const XcdBarrier& b) {
    asm volatile("s_waitcnt vmcnt(0)" ::: "memory");
    __syncthreads();
    if (threadIdx.x == 0) {
        unsigned* bar = b.bar;
        __builtin_amdgcn_s_waitcnt(0);
        unsigned nloc = b.st[0], nx = b.st[1];
        if (nloc == 0u) { xcd_barrier_complete(bar, b.x, nloc, nx); b.st[0] = nloc; b.st[1] = nx; }
        const unsigned old = xb_add(&bar[XB_XSUB(b.x)], 1u);
        const unsigned gen = old / nloc;
        if (old + 1u == (gen + 1u) * nloc) {
            __builtin_amdgcn_fence(__ATOMIC_RELEASE, "agent");
            asm volatile("s_waitcnt vmcnt(0)" ::: "memory");
            const unsigned og = xb_add(&bar[XB_TOP], 1u);
            const unsigned tg = og / nx;
            if (og + 1u == (tg + 1u) * nx) xb_add(&bar[XB_TOPGEN], 1u);
            else XB_SPIN(xb_ld(&bar[XB_TOPGEN]) == tg, bar);
            __builtin_amdgcn_fence(__ATOMIC_ACQUIRE, "agent");
            xb_add(&bar[XB_XGEN(b.x)], 1u);
            asm volatile("s_waitcnt vmcnt(0)" ::: "memory");
        } else {
            XB_SPIN(xb_ld(&bar[XB_XGEN(b.x)]) == gen, bar);
            __builtin_amdgcn_fence(__ATOMIC_ACQUIRE, "agent");
            asm volatile("s_waitcnt vmcnt(0)" ::: "memory");
        }
    }
    __syncthreads();
}

namespace pg8 {
constexpr int BM = 256, BK = 64, HALF = 128, HTB = HALF * BK * 2, STAGE_BYTES = 8 * HTB, NXCD = 8, WGM = 8;
__device__ __forceinline__ int lds_byte(int r, int c) { const int st = (r >> 4) * 2 + (c >> 5), rr = r & 15, cc = c & 31, ob = rr * 64 + cc * 2; return st * 1024 + (ob ^ (((ob >> 9) & 1) << 5)); }
__device__ __forceinline__ void stage_rc(int b, int& R, int& C) { const int st = b / 1024, sb = b % 1024, swz = sb ^ (((sb >> 9) & 1) << 5); R = (st >> 1) * 16 + swz / 64; C = (st & 1) * 32 + (swz % 64) / 2; }
__device__ __forceinline__ int perm32(int rho) { const int n = rho >> 4, i = rho & 15; return 8 * (i >> 2) + 4 * n + (i & 3); }
struct Unit { int pm, pn; };
struct Gemm { const bf16_t* A; const bf16_t* Bt; int K, lda, ldb; };
struct StaticOrder {
    int nM, nN, nwg, G, c;
    __device__ void init(int nM_, int nN_, int G_, int c_) { nM = nM_; nN = nN_; nwg = nM * nN; G = G_; c = c_; }
    __device__ bool next(int i, Unit& u) const {
        const long L = (long)i * G + c; if (L >= nwg) return false;
        int wgid = (int)L; { const int q = nwg / NXCD, r = nwg % NXCD, xcd = wgid % NXCD, off = wgid / NXCD; wgid = (xcd < r ? xcd * (q + 1) : r * (q + 1) + (xcd - r) * q) + off; }
        const int nig = WGM * nN, gid = wgid / nig, fm = gid * WGM, gsz = (nM - fm) < WGM ? (nM - fm) : WGM;
        u.pm = fm + ((wgid % nig) % gsz); u.pn = (wgid % nig) / gsz; return true;
    }
};
struct S5Order {
    int G, c, c0;
    __device__ bool next(int i, Unit& u) const { const int L = i * G + c - c0; if (c < c0 || L >= 128) return false; u.pm = L; u.pn = L >> 1; return true; }
};
template <class Epi, class Sched>
__device__ __forceinline__ void gemm_phase(LAS unsigned char* lds, const int tid, const Gemm g, const Sched& S, const Epi& E) {
    const int wid = __builtin_amdgcn_readfirstlane(tid >> 6), lane = tid & 63, wr = wid >> 2, wc = wid & 3, fr = lane & 15, fq = lane >> 4;
    const int K = g.K, nt = K / BK;
    unsigned voffA[2], voffB[2];
#pragma unroll
    for (int i = 0; i < 2; ++i) { int R, C; stage_rc(tid * 16 + i * 8192, R, C); const int Rb = Epi::PERM ? ((R & ~31) + perm32(R & 31)) : R;
        voffA[i] = (unsigned)(R * g.lda + C) * 2u; voffB[i] = (unsigned)(Rb * g.ldb + C) * 2u; }
    const size_t kstep = (size_t)(BK * 2);
    const size_t hstepA = (size_t)HALF * g.lda * 2, hstepB = (size_t)HALF * g.ldb * 2;
    const size_t tstepA = 2 * hstepA, tstepB = 2 * hstepB;
    const unsigned ldsw = (unsigned)wid * 1024u;
    const int aoff = lds_byte(wr * 64 + fr, fq * 8), boff = lds_byte(wc * 32 + fr, fq * 8);
#define PG8_SA(b, h) (((b) * 2 + (h)) * HTB)
#define PG8_SB(b, h) ((4 + (b) * 2 + (h)) * HTB)
#define PG8_STAGE(bufoff, gbase, voff) do { _Pragma("unroll") for (int _i = 0; _i < 2; ++_i) \
        __builtin_amdgcn_global_load_lds((const unsigned*)((const char*)(gbase) + (voff)[_i]), (LAS unsigned*)(lds + (bufoff) + ldsw + _i * 8192), 16, 0, 0); } while (0)
#define PG8_LDA(dst, b, h) do { _Pragma("unroll") for (int m = 0; m < 4; ++m) _Pragma("unroll") for (int k = 0; k < 2; ++k) dst[m][k] = *(const LAS bf16x8*)(lds + PG8_SA(b, h) + aoff + m * 2048 + k * 1024); } while (0)
#define PG8_LDB(dst, b, h) do { _Pragma("unroll") for (int n = 0; n < 2; ++n) _Pragma("unroll") for (int k = 0; k < 2; ++k) dst[n][k] = *(const LAS bf16x8*)(lds + PG8_SB(b, h) + boff + n * 2048 + k * 1024); } while (0)
#define PG8_MMA(ai, bj, At, Bt) do { __builtin_amdgcn_s_setprio(1); _Pragma("unroll") for (int m = 0; m < 4; ++m) _Pragma("unroll") for (int n = 0; n < 2; ++n) _Pragma("unroll") for (int k = 0; k < 2; ++k) \
        acc[ai][bj][m][n] = __builtin_amdgcn_mfma_f32_16x16x32_bf16(Bt[n][k], At[m][k], acc[ai][bj][m][n], 0, 0, 0); __builtin_amdgcn_s_setprio(0); } while (0)
#define PG8_WAIT_V(n) asm volatile("s_waitcnt vmcnt(" #n ")" ::: "memory")
#define PG8_WAIT_L(n) asm volatile("s_waitcnt lgkmcnt(" #n ")" ::: "memory")
#define PG8_BAR __builtin_amdgcn_s_barrier()
#define PG8_SCHED __builtin_amdgcn_sched_barrier(0)
    Unit cur, nxt; int ui = 0;
    if (!S.next(0, cur)) return;
    f32x4 acc[2][2][4][2];
#pragma unroll
    for (int a = 0; a < 2; ++a)
#pragma unroll
        for (int b = 0; b < 2; ++b)
#pragma unroll
            for (int m = 0; m < 4; ++m)
#pragma unroll
                for (int n = 0; n < 2; ++n) acc[a][b][m][n] = (f32x4){0.f, 0.f, 0.f, 0.f};
    bf16x8 At[4][2], B0[2][2], B1[2][2];
    const char* cA = (const char*)g.A + (size_t)cur.pm * tstepA; const char* cB = (const char*)g.Bt + (size_t)cur.pn * tstepB;
    PG8_STAGE(PG8_SB(0, 0), cB, voffB); PG8_STAGE(PG8_SB(0, 1), cB + hstepB, voffB); PG8_STAGE(PG8_SA(0, 0), cA, voffA); PG8_STAGE(PG8_SA(0, 1), cA + hstepA, voffA);
    if (wr == 1) PG8_BAR;
    PG8_WAIT_V(2); PG8_BAR;
    PG8_STAGE(PG8_SB(1, 0), cB + kstep, voffB); PG8_STAGE(PG8_SA(1, 0), cA + kstep, voffA); PG8_STAGE(PG8_SB(1, 1), cB + hstepB + kstep, voffB);
    PG8_WAIT_V(6); PG8_BAR;
    for (;;) {
        const bool has_next = S.next(ui + 1, nxt);
        const char* nA = has_next ? (const char*)g.A + (size_t)nxt.pm * tstepA : cA; const char* nB = has_next ? (const char*)g.Bt + (size_t)nxt.pn * tstepB : cB;
        for (int t = 0; t < nt; t += 2) {
            const bool last = (t == nt - 2);
            const char* a1 = cA + (size_t)(t + 1) * kstep;
            const char* a2 = last ? nA : cA + (size_t)(t + 2) * kstep; const char* b2 = last ? nB : cB + (size_t)(t + 2) * kstep;
            const char* a3 = a2 + kstep; const char* b3 = b2 + kstep;
            PG8_LDB(B0, 0, 0); PG8_LDB(B1, 0, 1); PG8_SCHED; PG8_LDA(At, 0, 0); PG8_STAGE(PG8_SA(1, 1), a1 + hstepA, voffA);
            PG8_WAIT_V(8); PG8_WAIT_L(0); PG8_BAR; PG8_MMA(0, 0, At, B0); PG8_MMA(0, 1, At, B1); PG8_BAR; PG8_SCHED;
            PG8_LDA(At, 0, 1); PG8_STAGE(PG8_SB(0, 0), b2, voffB); PG8_STAGE(PG8_SB(0, 1), b2 + hstepB, voffB); PG8_STAGE(PG8_SA(0, 0), a2, voffA);
            PG8_WAIT_V(8); PG8_WAIT_L(0); PG8_BAR; PG8_MMA(1, 0, At, B0); PG8_MMA(1, 1, At, B1); PG8_BAR; PG8_SCHED;
            PG8_LDB(B0, 1, 0); PG8_LDB(B1, 1, 1); PG8_SCHED; PG8_LDA(At, 1, 0); PG8_STAGE(PG8_SA(0, 1), a2 + hstepA, voffA);
            PG8_WAIT_V(8); PG8_WAIT_L(0); PG8_BAR; PG8_MMA(0, 0, At, B0); PG8_MMA(0, 1, At, B1); PG8_BAR; PG8_SCHED;
            PG8_LDA(At, 1, 1); PG8_STAGE(PG8_SB(1, 0), b3, voffB); PG8_STAGE(PG8_SB(1, 1), b3 + hstepB, voffB); PG8_STAGE(PG8_SA(1, 0), a3, voffA);
            PG8_WAIT_V(8); PG8_WAIT_L(0); PG8_BAR; PG8_MMA(1, 0, At, B0); PG8_MMA(1, 1, At, B1); PG8_BAR; PG8_SCHED;
        }
        if (wr == 0) PG8_BAR;
        E(acc, cur, wr, wc, fr, fq);
        if (!has_next) break;
#pragma unroll
        for (int a = 0; a < 2; ++a)
#pragma unroll
            for (int b = 0; b < 2; ++b)
#pragma unroll
                for (int m = 0; m < 4; ++m)
#pragma unroll
                    for (int n = 0; n < 2; ++n) acc[a][b][m][n] = (f32x4){0.f, 0.f, 0.f, 0.f};
        cur = nxt; cA = nA; cB = nB; ++ui;
        if (wr == 1) PG8_BAR;
    }
    PG8_WAIT_V(0);
    PG8_BAR;
#undef PG8_SA
#undef PG8_SB
#undef PG8_STAGE
#undef PG8_LDA
#undef PG8_LDB
#undef PG8_MMA
#undef PG8_WAIT_V
#undef PG8_WAIT_L
#undef PG8_BAR
#undef PG8_SCHED
}

struct EpiProj {
    static constexpr bool PERM = true;
    bf16_t *QKV, *ZS, *S5A, *S5US, *SGD, *SGS; float* BA; const float* SSQ;
    __device__ __forceinline__ void operator()(const f32x4 (&acc)[2][2][4][2], const Unit& u, int wr, int wc, int fr, int fq) const {
        const int row0 = u.pm * BM + wr * 64 + fr, pn = u.pn, cw = wc * 32 + 8 * fq;
#pragma unroll
        for (int ai = 0; ai < 2; ++ai)
#pragma unroll
            for (int m = 0; m < 4; ++m) {
                const int row = row0 + ai * HALF + m * 16;
                const float rstd = 1.0f / sqrtf(SSQ[row] * (1.0f / D) + NORM_EPS);
#pragma unroll
                for (int bj = 0; bj < 2; ++bj) {
                    f32x4 v0 = acc[ai][bj][m][0] * rstd, v1 = acc[ai][bj][m][1] * rstd;
                    const int col = pn * BM + bj * HALF + cw;
                    if (pn == 36) {
                        if (col < 9216 + 16) { float* p = BA + (size_t)row * 16 + (col - 9216); *(f32x4*)p = v0; *(f32x4*)(p + 4) = v1; }
                        continue;
                    }
                    bf16_t* dst;
                    if (pn < 12) dst = QKV + (size_t)row * CONVCH + col;
                    else if (pn < 16) { dst = ZS + (size_t)row * 1024 + (col - 3072);
#pragma unroll
                        for (int j = 0; j < 4; ++j) { v0[j] = siluf_(v0[j]); v1[j] = siluf_(v1[j]); } }
                    else if (pn < 20) { const int c = col - 4096, g = c >> 4, cc = c & 15;
                        if (row < NPROMPT) { const int b = row >> 11, t = row & 2047; dst = S5A + ((size_t)(g * 512 + b * 128 + (t >> 4)) * 384 + (t & 15) * 16 + cc); }
                        else dst = S5US + (size_t)(row - NPROMPT) * 1024 + c; }
                    else { dst = (pn < 28) ? SGD + (size_t)row * D + (col - 5120) : SGS + (size_t)row * D + (col - 7168);
#pragma unroll
                        for (int j = 0; j < 4; ++j) { v0[j] = sigmoidf_(v0[j]); v1[j] = sigmoidf_(v1[j]); } }
                    u32x4 w; w.x = cvt_pk_bf16(v0[0], v0[1]); w.y = cvt_pk_bf16(v0[2], v0[3]); w.z = cvt_pk_bf16(v1[0], v1[1]); w.w = cvt_pk_bf16(v1[2], v1[3]);
                    *(u32x4*)dst = w;
                }
            }
    }
};
struct EpiGlu {
    static constexpr bool PERM = true;
    const bf16_t* G5; bf16_t* G5G;
    __device__ __forceinline__ void operator()(const f32x4 (&acc)[2][2][4][2], const Unit& u, int wr, int wc, int fr, int fq) const {
        const int row0 = u.pm * BM + wr * 64 + fr, col0 = u.pn * BM + wc * 32 + 8 * fq;
#pragma unroll
        for (int ai = 0; ai < 2; ++ai)
#pragma unroll
            for (int m = 0; m < 4; ++m) {
                const size_t ro = (size_t)(row0 + ai * HALF + m * 16) * S5CH + col0;
#pragma unroll
                for (int bj = 0; bj < 2; ++bj) {
                    const u32x4 g = *(const u32x4*)(G5 + ro + bj * HALF);
                    const f32x4 a0 = acc[ai][bj][m][0], a1 = acc[ai][bj][m][1];
                    u32x4 w;
                    w.x = cvt_pk_bf16(bflo(g.x) * sigmoidf_(a0[0]), bfhi(g.x) * sigmoidf_(a0[1]));
                    w.y = cvt_pk_bf16(bflo(g.y) * sigmoidf_(a0[2]), bfhi(g.y) * sigmoidf_(a0[3]));
                    w.z = cvt_pk_bf16(bflo(g.z) * sigmoidf_(a1[0]), bfhi(g.z) * sigmoidf_(a1[1]));
                    w.w = cvt_pk_bf16(bflo(g.w) * sigmoidf_(a1[2]), bfhi(g.w) * sigmoidf_(a1[3]));
                    *(u32x4*)(G5G + ro + bj * HALF) = w;
                }
            }
    }
};
template <bool ADD> struct EpiBr {
    static constexpr bool PERM = true;
    const bf16_t* GATE; bf16_t* MERGED;
    __device__ __forceinline__ void operator()(const f32x4 (&acc)[2][2][4][2], const Unit& u, int wr, int wc, int fr, int fq) const {
        const int row0 = u.pm * BM + wr * 64 + fr, col0 = u.pn * BM + wc * 32 + 8 * fq;
#pragma unroll
        for (int ai = 0; ai < 2; ++ai)
#pragma unroll
            for (int m = 0; m < 4; ++m) {
                const size_t ro = (size_t)(row0 + ai * HALF + m * 16) * D + col0;
#pragma unroll
                for (int bj = 0; bj < 2; ++bj) {
                    const u32x4 g = *(const u32x4*)(GATE + ro + bj * HALF);
                    const f32x4 a0 = acc[ai][bj][m][0], a1 = acc[ai][bj][m][1];
                    float r[8] = {bflo(g.x) * a0[0], bfhi(g.x) * a0[1], bflo(g.y) * a0[2], bfhi(g.y) * a0[3], bflo(g.z) * a1[0], bfhi(g.z) * a1[1], bflo(g.w) * a1[2], bfhi(g.w) * a1[3]};
                    if (ADD) { const u32x4 p = *(const u32x4*)(MERGED + ro + bj * HALF);
                        r[0] += bflo(p.x); r[1] += bfhi(p.x); r[2] += bflo(p.y); r[3] += bfhi(p.y); r[4] += bflo(p.z); r[5] += bfhi(p.z); r[6] += bflo(p.w); r[7] += bfhi(p.w); }
                    u32x4 w; w.x = cvt_pk_bf16(r[0], r[1]); w.y = cvt_pk_bf16(r[2], r[3]); w.z = cvt_pk_bf16(r[4], r[5]); w.w = cvt_pk_bf16(r[6], r[7]);
                    *(u32x4*)(MERGED + ro + bj * HALF) = w;
                }
            }
    }
};
struct EpiRes {
    static constexpr bool PERM = false;
    const float* XP; const float* XS;
    float* X; bf16_t* XB; float* SSQ;
    __device__ __forceinline__ void operator()(const f32x4 (&acc)[2][2][4][2], const Unit& u, int wr, int wc, int fr, int fq) const {
        const int row0 = u.pm * BM + wr * 64 + fr, col0 = u.pn * BM + wc * 32 + 4 * fq;
#pragma unroll
        for (int ai = 0; ai < 2; ++ai)
#pragma unroll
            for (int m = 0; m < 4; ++m) {
                const int row = row0 + ai * HALF + m * 16;
                float ss = 0.f;
                if (row < MR) {
                    const float* xo = (row < NPROMPT ? XP + (size_t)row * D : XS + (size_t)(row - NPROMPT) * D) + col0;
                    float* xn = X + (size_t)row * D + col0; bf16_t* xb = XB + (size_t)row * D + col0;
#pragma unroll
                    for (int bj = 0; bj < 2; ++bj)
#pragma unroll
                        for (int n = 0; n < 2; ++n) {
                            const f32x4 v = *(const f32x4*)(xo + bj * HALF + n * 16) + acc[ai][bj][m][n];
                            *(f32x4*)(xn + bj * HALF + n * 16) = v;
                            u32x2 w; w.x = cvt_pk_bf16(v[0], v[1]); w.y = cvt_pk_bf16(v[2], v[3]);
                            *(u32x2*)(xb + bj * HALF + n * 16) = w;
                            ss += (v[0] * v[0] + v[1] * v[1]) + (v[2] * v[2] + v[3] * v[3]);
                        }
                }
                ss += __shfl_xor(ss, 16); ss += __shfl_xor(ss, 32);
                if (fq == 0 && row < MR) atomicAdd(SSQ + row, ss);
                asm volatile("" ::: "memory");
            }
    }
};
struct EpiGU {
    static constexpr bool PERM = true;
    bf16_t* ACT; const float* SSQ;
    __device__ __forceinline__ void operator()(const f32x4 (&acc)[2][2][4][2], const Unit& u, int wr, int wc, int fr, int fq) const {
        const int row0 = u.pm * BM + wr * 64 + fr, col0 = u.pn * HALF + wc * 32 + 8 * fq;
#pragma unroll
        for (int ai = 0; ai < 2; ++ai)
#pragma unroll
            for (int m = 0; m < 4; ++m) {
                const int row = row0 + ai * HALF + m * 16;
                const float rstd = 1.0f / sqrtf(SSQ[row] * (1.0f / D) + NORM_EPS);
                float r[8];
#pragma unroll
                for (int n = 0; n < 2; ++n)
#pragma unroll
                    for (int j = 0; j < 4; ++j) r[n * 4 + j] = siluf_(acc[ai][0][m][n][j] * rstd) * (acc[ai][1][m][n][j] * rstd);
                u32x4 w; w.x = cvt_pk_bf16(r[0], r[1]); w.y = cvt_pk_bf16(r[2], r[3]); w.z = cvt_pk_bf16(r[4], r[5]); w.w = cvt_pk_bf16(r[6], r[7]);
                *(u32x4*)(ACT + (size_t)row * FF + col0) = w;
            }
    }
};
struct EpiS5L {
    static constexpr bool PERM = false;
    float* L;
    __device__ __forceinline__ void operator()(const f32x4 (&acc)[2][2][4][2], const Unit& u, int wr, int wc, int fr, int fq) const {
        const int row0 = u.pm * BM + wr * 64 + fr, col0 = wc * 32 + 4 * fq;
#pragma unroll
        for (int ai = 0; ai < 2; ++ai)
#pragma unroll
            for (int m = 0; m < 4; ++m) { float* p = L + (size_t)(row0 + ai * HALF + m * 16) * 128 + col0;
#pragma unroll
                for (int n = 0; n < 2; ++n) *(f32x4*)(p + n * 16) = acc[ai][0][m][n]; }
    }
};
struct EpiS5Y {
    static constexpr bool PERM = true;
    bf16_t* G5;
    __device__ __forceinline__ void operator()(const f32x4 (&acc)[2][2][4][2], const Unit& u, int wr, int wc, int fr, int fq) const {
        const int row0 = u.pm * BM + wr * 64 + fr, cw = wc * 32 + 8 * fq;
#pragma unroll
        for (int ai = 0; ai < 2; ++ai)
#pragma unroll
            for (int m = 0; m < 4; ++m) {
                const int row = row0 + ai * HALF + m * 16, g = row >> 9, r5 = row & 511, b = r5 >> 7, ch = r5 & 127;
#pragma unroll
                for (int bj = 0; bj < 2; ++bj) {
                    const int col = bj * HALF + cw, t = col >> 4, c = col & 15;
                    const f32x4 a0 = acc[ai][bj][m][0], a1 = acc[ai][bj][m][1];
                    u32x4 w; w.x = cvt_pk_bf16(geluf_(a0[0]), geluf_(a0[1])); w.y = cvt_pk_bf16(geluf_(a0[2]), geluf_(a0[3]));
                    w.z = cvt_pk_bf16(geluf_(a1[0]), geluf_(a1[1])); w.w = cvt_pk_bf16(geluf_(a1[2]), geluf_(a1[3]));
                    *(u32x4*)(G5 + (size_t)(b * SEQ + ch * 16 + t) * S5CH + g * 16 + c) = w;
                }
            }
    }
};
}

struct Args {
    const float* in[29];
    float* out; unsigned char* ws;
    int ph_lo, ph_hi, use_bar, pad;
};
enum { I_XP = 0, I_XS, I_SCONV, I_SSSM, I_S5RE, I_S5IM, I_N1, I_WIN, I_CONVW, I_ALOG, I_DTB, I_DNNW, I_WBRDN, I_LRE, I_LIM, I_LDT, I_BRE, I_BIM, I_CRE, I_CIM, I_DS, I_WGLU, I_WBRS5, I_WOUT, I_N2, I_WG, I_WU, I_WD, I_NF };
constexpr size_t O_YP = 0, O_YS = 16777216, O_PCONV = 17039360, O_PSSM = 17113088, O_PS5RE = 18161664, O_PS5IM = 18194432, O_SCONV = 18227200, O_SSSM = 20586496, O_SS5RE = 54140928, O_SS5IM = 55189504, O_END = 56238080;

typedef const __attribute__((address_space(4))) Args CArgs;
struct Frame {
    LAS unsigned char* lds;
    int tid, lane, wave, G, bx;
    unsigned char* ws; float* out;
};

__device__ __forceinline__ void p0_transpose_item(const float* W, int ldw, int src, int nvalid, const float* scale, bf16_t* WT, int ldt, int nrow0, int k0, LAS float* scr, int lane) {
    const int nn = lane & 31;
#pragma unroll 8
    for (int i = 0; i < 32; ++i) { const int kk = 2 * i + (lane >> 5);
        float v = (nn < nvalid) ? W[(size_t)(k0 + kk) * ldw + src + nn] : 0.f;
        if (scale) v *= scale[k0 + kk];
        scr[kk * 33 + nn] = v; }
    LDS_WAIT(); asm volatile("" ::: "memory");
    const int c = lane & 7;
#pragma unroll
    for (int j = 0; j < 4; ++j) { const int n = (lane >> 3) + 8 * j; const LAS float* s = scr + (8 * c) * 33 + n;
        u32x4 o; o.x = pk2(s[0 * 33], s[1 * 33]); o.y = pk2(s[2 * 33], s[3 * 33]); o.z = pk2(s[4 * 33], s[5 * 33]); o.w = pk2(s[6 * 33], s[7 * 33]);
        *(u32x4*)(WT + (size_t)(nrow0 + n) * ldt + k0 + 8 * c) = o; }
    LDS_WAIT(); asm volatile("" ::: "memory");
}

__device__ __forceinline__ void p0_s5_precompute(const Frame& F, const CArgs& a, int l, int g) {
    LAS float* apr = (LAS float*)F.lds;
    LAS float* api = apr + 17 * 64;
    LAS float* bbr = api + 17 * 64;
    LAS float* bbi = bbr + 1024;
    LAS float* cre = bbi + 1024;
    LAS float* cim = cre + 1024;
    LAS float* kt = cim + 1024;
    const int tid = F.tid;
    __syncthreads();
    if (tid < 64) {
        const int p = tid;
        const float dt = expf(a.in[I_LDT][l * 64 + g]);
        const float lr = a.in[I_LRE][(l * 64 + g) * 64 + p], li = a.in[I_LIM][(l * 64 + g) * 64 + p];
        for (int d = 0; d <= 16; ++d) { const float mag = expf(lr * dt * (float)d), ang = li * dt * (float)d; apr[d * 64 + p] = mag * cosf(ang); api[d * 64 + p] = mag * sinf(ang); }
        const float ar = apr[64 + p], ai = api[64 + p], nr = ar - 1.0f, den = lr * lr + li * li;
        const float fr = (nr * lr + ai * li) / den, fi = (ai * lr - nr * li) / den;
        float* bb = (float*)(F.ws + WS_BBAR) + ((size_t)(l * 64 + g) * 64 + p) * 32;
        for (int c = 0; c < 16; ++c) { const float br = a.in[I_BRE][((size_t)(l * 64 + g) * 64 + p) * 16 + c], bi = a.in[I_BIM][((size_t)(l * 64 + g) * 64 + p) * 16 + c];
            const float xr = fr * br - fi * bi, xi = fr * bi + fi * br; bbr[p * 16 + c] = xr; bbi[p * 16 + c] = xi; bb[c] = xr; bb[16 + c] = xi; }
        float* a16 = (float*)(F.ws + WS_A16) + ((size_t)(l * 64 + g) * 64 + p) * 2;
        a16[0] = apr[16 * 64 + p]; a16[1] = api[16 * 64 + p];
    }
    for (int i = tid; i < 1024; i += 512) { cre[i] = a.in[I_CRE][(size_t)(l * 64 + g) * 1024 + i]; cim[i] = a.in[I_CIM][(size_t)(l * 64 + g) * 1024 + i]; }
    __syncthreads();
    for (int e = tid; e < 4096; e += 512) { const int d = e >> 8, c = (e >> 4) & 15, cc = e & 15; float s = 0.f;
        for (int p = 0; p < 64; ++p) { const float pr = apr[d * 64 + p], pi = api[d * 64 + p], br = bbr[p * 16 + cc], bi = bbi[p * 16 + cc];
            const float gr = pr * br - pi * bi, gi = pr * bi + pi * br; s += cre[c * 64 + p] * gr - cim[c * 64 + p] * gi; }
        if (d == 0 && c == cc) s += a.in[I_DS][l * 1024 + g * 16 + c];
        kt[e] = s; }
    __syncthreads();
    bf16_t* bty = (bf16_t*)(F.ws + WS_W0 + l * WS_WSTRIDE + WO_BTY) + (size_t)g * 256 * 384;
    for (int ch = tid; ch < 256 * 48; ch += 512) {
        const int row = ch / 48, c8 = (ch % 48) * 8, t = row >> 4, c = row & 15; float v[8];
#pragma unroll
        for (int j = 0; j < 8; ++j) { const int col = c8 + j;
            if (col < 256) { const int s = col >> 4, cc = col & 15; v[j] = (s <= t) ? kt[((t - s) * 16 + c) * 16 + cc] : 0.f; }
            else if (col < 320) { const int p = col - 256; v[j] = cre[c * 64 + p] * apr[(t + 1) * 64 + p] - cim[c * 64 + p] * api[(t + 1) * 64 + p]; }
            else { const int p = col - 320; v[j] = -(cre[c * 64 + p] * api[(t + 1) * 64 + p] + cim[c * 64 + p] * apr[(t + 1) * 64 + p]); } }
        u32x4 o; o.x = pk2(v[0], v[1]); o.y = pk2(v[2], v[3]); o.z = pk2(v[4], v[5]); o.w = pk2(v[6], v[7]);
        *(u32x4*)(bty + (size_t)row * 384 + c8) = o; }
    bf16_t* btl = (bf16_t*)(F.ws + WS_W0 + l * WS_WSTRIDE + WO_BTL) + (size_t)g * 256 * 256;
    for (int ch = tid; ch < 256 * 32; ch += 512) {
        const int row = ch >> 5, c8 = (ch & 31) * 8; float v[8];
#pragma unroll
        for (int j = 0; j < 8; ++j) { const int col = c8 + j, s = col >> 4, cc = col & 15;
            if (row < 128) { const int p = row & 63, d = 15 - s; const float pr = apr[d * 64 + p], pi = api[d * 64 + p], br = bbr[p * 16 + cc], bi = bbi[p * 16 + cc];
                v[j] = (row < 64) ? (pr * br - pi * bi) : (pr * bi + pi * br); }
            else v[j] = 0.f; }
        u32x4 o; o.x = pk2(v[0], v[1]); o.y = pk2(v[2], v[3]); o.z = pk2(v[4], v[5]); o.w = pk2(v[6], v[7]);
        *(u32x4*)(btl + (size_t)row * 256 + c8) = o; }
    __syncthreads();
}

__device__ __forceinline__ void p0_prologue(const Frame& F, const CArgs& a) {
    if (F.bx < 128) p0_s5_precompute(F, a, F.bx >> 6, F.bx & 63);
    __syncthreads();
    LAS float* scr = (LAS float*)(F.lds + F.wave * 16384);
    const int gw = F.bx * 8 + F.wave, NGW = F.G * 8;
    constexpr int I0 = 32 * 289, I1 = 16 * 64, I2 = 16 * 32, I3 = 16 * 64, I4 = 32 * 64, I5 = 32 * 352, I6 = 88 * 64, IL = I0 + I1 + I2 + I3 + I4 + I5 + I6;
    for (int it = gw; it < 2 * IL; it += NGW) {
        const int l = it / IL; int r = it % IL;
        unsigned char* wb = F.ws + WS_W0 + l * WS_WSTRIDE;
        if (r < I0) { const int kb = r / 289, nb = r % 289, n0 = nb * 32; int src, nv = 32;
            if (n0 < 4096) src = n0; else if (n0 < 9216) src = n0 + 16; else { src = 4096; nv = 16; }
            p0_transpose_item(a.in[I_WIN] + (size_t)l * D * IN_DIM, IN_DIM, src, nv, a.in[I_N1] + l * D, (bf16_t*)(wb + WO_IN), D, n0, kb * 64, scr, F.lane); continue; } r -= I0;
        if (r < I1) { const int kb = r / 64, nb = r % 64; p0_transpose_item(a.in[I_WBRDN] + (size_t)l * 1024 * D, D, nb * 32, 32, nullptr, (bf16_t*)(wb + WO_BRDN), 1024, nb * 32, kb * 64, scr, F.lane); continue; } r -= I1;
        if (r < I2) { const int kb = r / 32, nb = r % 32; p0_transpose_item(a.in[I_WGLU] + (size_t)l * 1024 * 1024, 1024, nb * 32, 32, nullptr, (bf16_t*)(wb + WO_GLU), 1024, nb * 32, kb * 64, scr, F.lane); continue; } r -= I2;
        if (r < I3) { const int kb = r / 64, nb = r % 64; p0_transpose_item(a.in[I_WBRS5] + (size_t)l * 1024 * D, D, nb * 32, 32, nullptr, (bf16_t*)(wb + WO_BRS5), 1024, nb * 32, kb * 64, scr, F.lane); continue; } r -= I3;
        if (r < I4) { const int kb = r / 64, nb = r % 64; p0_transpose_item(a.in[I_WOUT] + (size_t)l * D * D, D, nb * 32, 32, nullptr, (bf16_t*)(wb + WO_OUT), D, nb * 32, kb * 64, scr, F.lane); continue; } r -= I4;
        if (r < I5) { const int kb = r / 352, nb = r % 352, n0 = nb * 32, tile = n0 >> 8, j = n0 & 255;
            const float* W = (j < 128 ? a.in[I_WG] : a.in[I_WU]) + (size_t)l * D * FF;
            p0_transpose_item(W, FF, tile * 128 + (j & 127), 32, a.in[I_N2] + l * D, (bf16_t*)(wb + WO_GU), D, n0, kb * 64, scr, F.lane); continue; } r -= I5;
        { const int kb = r / 64, nb = r % 64; p0_transpose_item(a.in[I_WD] + (size_t)l * FF * D, D, nb * 32, 32, nullptr, (bf16_t*)(wb + WO_D), FF, nb * 32, kb * 64, scr, F.lane); }
    }
    const int gt = F.bx * 512 + F.tid, NGT = F.G * 512;
    for (int l = 0; l < 2; ++l) { u32x4* z = (u32x4*)(F.ws + WS_W0 + l * WS_WSTRIDE + WO_IN + (size_t)9248 * D * 2);
        for (int i = gt; i < 224 * D * 2 / 16; i += NGT) z[i] = (u32x4){0u, 0u, 0u, 0u}; }
    { float* s = (float*)(F.ws + WS_SSQ) + MP; for (int i = gt; i < 4 * MP; i += NGT) s[i] = 0.f; }
    float* ssq0 = (float*)(F.ws + WS_SSQ); bf16_t* XB = (bf16_t*)(F.ws + WS_XB);
    for (int m = gw; m < MR; m += NGW) {
        const float* xr = (m < NPROMPT) ? a.in[I_XP] + (size_t)m * D : a.in[I_XS] + (size_t)(m - NPROMPT) * D;
        const f32x4* x4 = (const f32x4*)xr + F.lane; u32x2* o = (u32x2*)(XB + (size_t)m * D) + F.lane; float s = 0.f;
#pragma unroll
        for (int j = 0; j < 8; ++j) { const f32x4 v = x4[64 * j]; s += (v[0] * v[0] + v[1] * v[1]) + (v[2] * v[2] + v[3] * v[3]);
            u32x2 w; w.x = pk2(v[0], v[1]); w.y = pk2(v[2], v[3]); o[64 * j] = w; }
        s = wave_sum(s); if (F.lane == 0) ssq0[m] = s;
    }
}


__device__ __forceinline__ void conv_state_out(const Frame& F, const CArgs& a, int l) {
    const int gt = F.bx * 512 + F.tid, NGT = F.G * 512;
    const bf16_t* QKV = (const bf16_t*)(F.ws + WS_QKV);
    float* pc = F.out + O_PCONV + (size_t)l * NB * 3 * CONVCH;
    for (int i = gt; i < NB * 3 * CONVCH; i += NGT) { const int ch = i % CONVCH, j = (i / CONVCH) % 3, b = i / (3 * CONVCH);
        pc[i] = bf2f(QKV[(size_t)(b * SEQ + SEQ - 3 + j) * CONVCH + ch]); }
    float* sc = F.out + O_SCONV + (size_t)l * NSAMP * 3 * CONVCH; const float* st = a.in[I_SCONV] + (size_t)l * NSAMP * 3 * CONVCH;
    for (int i = gt; i < NSAMP * 3 * CONVCH; i += NGT) { const int ch = i % CONVCH, j = (i / CONVCH) % 3, b = i / (3 * CONVCH);
        sc[i] = (j < 2) ? st[i + CONVCH] : bf2f(QKV[(size_t)(NPROMPT + b) * CONVCH + ch]); }
}


__device__ __forceinline__ void delta_seq(const Frame& F, const CArgs& a, int l, int h, int r0, int L, const float* conv0, const float* ssm0, float* ssm_out) {
    LAS float* raw = (LAS float*)F.lds;
    LAS float* qk = raw + 384;
    LAS float* part = qk + 256;
    LAS float* red = part + 512;
    const int tid = F.tid, lane = F.lane, wave = F.wave, dv = tid & 127, kg = tid >> 7;
    const bf16_t* QKV = (const bf16_t*)(F.ws + WS_QKV); const float* BA = (const float*)(F.ws + WS_BA); const bf16_t* ZS = (const bf16_t*)(F.ws + WS_ZS); bf16_t* ON = (bf16_t*)(F.ws + WS_ON);
    const int ch = (tid < 384) ? ((tid >> 7) * 1024 + h * 128 + (tid & 127)) : 0;
    const float* cw = a.in[I_CONVW] + (size_t)l * 4 * CONVCH;
    const float cw0 = cw[ch], cw1 = cw[CONVCH + ch], cw2 = cw[2 * CONVCH + ch], cw3 = cw[3 * CONVCH + ch];
    float w0 = conv0 ? conv0[ch] : 0.f, w1 = conv0 ? conv0[CONVCH + ch] : 0.f, w2 = conv0 ? conv0[2 * CONVCH + ch] : 0.f;
    float s[32];
#pragma unroll
    for (int i = 0; i < 32; ++i) s[i] = ssm0 ? ssm0[(size_t)(kg * 32 + i) * 128 + dv] : 0.f;
    const float Aexp = expf(a.in[I_ALOG][l * NH + h]), dtb = a.in[I_DTB][l * NH + h], nw = a.in[I_DNNW][l * 128 + dv];
    __syncthreads();
    for (int t = 0; t < L; ++t) {
        const int r = r0 + t;
        if (tid < 384) { const float x = bf2f(QKV[(size_t)r * CONVCH + ch]); const float y = cw0 * w0 + cw1 * w1 + cw2 * w2 + cw3 * x; w0 = w1; w1 = w2; w2 = x; raw[tid] = siluf_(y); }
        __syncthreads();
        if (wave < 2) { const float v0 = raw[wave * 128 + lane], v1 = raw[wave * 128 + 64 + lane]; const float ss = wave_sum(v0 * v0 + v1 * v1);
            const float rs = (1.0f / sqrtf(ss + 1e-6f)) * (wave == 0 ? 0.08838834764831845f : 1.0f); qk[wave * 128 + lane] = v0 * rs; qk[wave * 128 + 64 + lane] = v1 * rs; }
        __syncthreads();
        const float beta = sigmoidf_(BA[(size_t)r * 16 + h]), gg = -Aexp * softplusf_(BA[(size_t)r * 16 + 8 + h] + dtb), dec = expf(gg);
        float ks = 0.f;
#pragma unroll
        for (int i = 0; i < 32; ++i) { s[i] *= dec; ks += qk[128 + kg * 32 + i] * s[i]; }
        part[kg * 128 + dv] = ks;
        __syncthreads();
        const float vnew = (raw[256 + dv] - ((part[dv] + part[128 + dv]) + (part[256 + dv] + part[384 + dv]))) * beta;
        __syncthreads();
        float op = 0.f;
#pragma unroll
        for (int i = 0; i < 32; ++i) { s[i] += qk[128 + kg * 32 + i] * vnew; op += qk[kg * 32 + i] * s[i]; }
        part[kg * 128 + dv] = op;
        __syncthreads();
        const float o = (part[dv] + part[128 + dv]) + (part[256 + dv] + part[384 + dv]);
        const float ss = wave_sum(o * o); if (lane == 0) red[wave] = ss;
        __syncthreads();
        if (tid < 128) { const float rstd = 1.0f / sqrtf((red[0] + red[1]) * (1.0f / 128.0f) + NORM_EPS);
            const float z = bf2f(ZS[(size_t)r * 1024 + h * 128 + dv]); ON[(size_t)r * 1024 + h * 128 + dv] = (bf16_t)f2bf(o * rstd * nw * z); }
    }
#pragma unroll
    for (int i = 0; i < 32; ++i) ssm_out[(size_t)(kg * 32 + i) * 128 + dv] = s[i];
    __syncthreads();
}
__device__ __forceinline__ void s5_seq(const Frame& F, const CArgs& a, int l, int g, int b, bool sample, int L, const float* x0re, const float* x0im, float* ore, float* oim) {
    const int p = F.lane;
    const float dt = expf(a.in[I_LDT][l * 64 + g]);
    const float lr = a.in[I_LRE][(l * 64 + g) * 64 + p], li = a.in[I_LIM][(l * 64 + g) * 64 + p];
    const float mag = expf(lr * dt), ar = mag * cosf(li * dt), ai = mag * sinf(li * dt);
    const float* bb = (const float*)(F.ws + WS_BBAR) + ((size_t)(l * 64 + g) * 64 + p) * 32;
    float br[16], bi[16], cr[16], ci[16];
#pragma unroll
    for (int c = 0; c < 16; ++c) { br[c] = bb[c]; bi[c] = bb[16 + c]; cr[c] = a.in[I_CRE][((size_t)(l * 64 + g) * 16 + c) * 64 + p]; ci[c] = a.in[I_CIM][((size_t)(l * 64 + g) * 16 + c) * 64 + p]; }
    const float dsk = a.in[I_DS][l * 1024 + g * 16 + (p & 15)];
    float xr = x0re ? x0re[p] : 0.f, xi = x0im ? x0im[p] : 0.f;
    const bf16_t* S5A = (const bf16_t*)(F.ws + WS_S5A); const bf16_t* S5US = (const bf16_t*)(F.ws + WS_S5US); bf16_t* G5 = (bf16_t*)(F.ws + WS_G5);
    for (int t = 0; t < L; ++t) {
        const bf16_t* up = sample ? S5US + (size_t)b * 1024 + g * 16 : S5A + ((size_t)(g * 512 + b * 128 + (t >> 4)) * 384 + (t & 15) * 16);
        const u32x4 u0 = *(const u32x4*)up, u1 = *(const u32x4*)(up + 8);
        const float u[16] = {bflo(u0.x), bfhi(u0.x), bflo(u0.y), bfhi(u0.y), bflo(u0.z), bfhi(u0.z), bflo(u0.w), bfhi(u0.w), bflo(u1.x), bfhi(u1.x), bflo(u1.y), bfhi(u1.y), bflo(u1.z), bfhi(u1.z), bflo(u1.w), bfhi(u1.w)};
        float bur = 0.f, bui = 0.f;
#pragma unroll
        for (int c = 0; c < 16; ++c) { bur += br[c] * u[c]; bui += bi[c] * u[c]; }
        const float nxr = ar * xr - ai * xi + bur, nxi = ar * xi + ai * xr + bui; xr = nxr; xi = nxi;
        float y = 0.f, um = 0.f;
#pragma unroll
        for (int c = 0; c < 16; ++c) { const float v = wave_sum(cr[c] * xr - ci[c] * xi); if (p == c) { y = v; um = u[c]; } }
        if (p < 16) { y += dsk * um; const size_t row = sample ? (size_t)(NPROMPT + b) : (size_t)(b * SEQ + t); G5[row * 1024 + g * 16 + p] = (bf16_t)f2bf(geluf_(y)); }
    }
    ore[p] = xr; oim[p] = xi;
}
__device__ __forceinline__ void mixer_reference(const Frame& F, const CArgs& a, int l) {
    if (F.wave == 0) { const int it = F.bx; if (it < 256) { const int b = it >> 6, g = it & 63;
            s5_seq(F, a, l, g, b, false, SEQ, nullptr, nullptr, F.out + O_PS5RE + ((size_t)(l * NB + b) * 64 + g) * 64, F.out + O_PS5IM + ((size_t)(l * NB + b) * 64 + g) * 64); } }
    else { for (int it = F.bx * 7 + (F.wave - 1); it < NSAMP * 64; it += F.G * 7) { const int b = it >> 6, g = it & 63; const size_t so = ((size_t)(l * NSAMP + b) * 64 + g) * 64;
            s5_seq(F, a, l, g, b, true, 1, a.in[I_S5RE] + so, a.in[I_S5IM] + so, F.out + O_SS5RE + so, F.out + O_SS5IM + so); } }
    __syncthreads();
    if (F.bx < 32) { const int b = F.bx >> 3, h = F.bx & 7; delta_seq(F, a, l, h, b * SEQ, SEQ, nullptr, nullptr, F.out + O_PSSM + ((size_t)(l * NB + b) * NH + h) * 16384); }
    else { for (int it = F.bx - 32; it < NSAMP * NH; it += F.G - 32) { const int b = it >> 3, h = it & 7; const size_t so = ((size_t)(l * NSAMP + b) * NH + h) * 16384;
            delta_seq(F, a, l, h, NPROMPT + b, 1, a.in[I_SCONV] + (size_t)(l * NSAMP + b) * 3 * CONVCH, a.in[I_SSSM] + so, F.out + O_SSSM + so); } }
}

__device__ __forceinline__ void final_norm(const Frame& F, const CArgs& a) {
    const int gw = F.bx * 8 + F.wave, NGW = F.G * 8; const float* ssq = (const float*)(F.ws + WS_SSQ) + 4 * MP; const f32x4* nf = (const f32x4*)a.in[I_NF] + F.lane;
    for (int m = gw; m < MR; m += NGW) {
        const float rstd = 1.0f / sqrtf(ssq[m] * (1.0f / D) + NORM_EPS);
        f32x4* x4 = (f32x4*)(F.out + (size_t)m * D) + F.lane;
#pragma unroll
        for (int j = 0; j < 8; ++j) { f32x4 v = x4[64 * j]; const f32x4 w = nf[64 * j]; v = v * rstd * w; x4[64 * j] = v; }
    }
}

__global__ void __launch_bounds__(512, 2) fwd(Args a_unused) {
    extern __shared__ __attribute__((aligned(16))) unsigned char lds_raw[];
    CArgs* ap0 = (CArgs*)__builtin_amdgcn_kernarg_segment_ptr();
    const CArgs& a0 = *ap0;
    Frame F;
    F.lds = (LAS unsigned char*)lds_raw; F.tid = threadIdx.x; F.lane = F.tid & 63; F.wave = __builtin_amdgcn_readfirstlane(F.tid >> 6);
    F.G = gridDim.x; F.bx = blockIdx.x; F.ws = a0.ws; F.out = a0.out;
    volatile LAS unsigned* MISC = (volatile LAS unsigned*)(F.lds + MISC_OFF);
    if (F.tid < 64) MISC[F.tid] = 0u;
    __syncthreads();
    XcdBarrier bar; bar.bar = (unsigned*)(F.ws + WS_CTL) + 1024; bar.x = 0; bar.st = nullptr;
    if (a0.use_bar) bar = xcd_barrier_post((unsigned*)(F.ws + WS_CTL) + 1024, MISC + 8);
    const int ph_lo = a0.ph_lo, ph_hi = a0.ph_hi, use_bar = a0.use_bar;
    for (int ph = ph_lo; ph < ph_hi; ++ph) {
        CArgs* ap = ap0; asm volatile("" : "+s"(ap));
        const CArgs& a = *ap;
        { int t_ = threadIdx.x; asm volatile("" : "+v"(t_)); F.tid = t_; F.lane = t_ & 63; F.wave = __builtin_amdgcn_readfirstlane(t_ >> 6); }
        { int b_ = blockIdx.x; asm volatile("" : "+s"(b_)); F.bx = b_; int g_ = gridDim.x; asm volatile("" : "+s"(g_)); F.G = g_; }
        { unsigned char* w_ = a.ws; asm volatile("" : "+s"(w_)); F.ws = w_; float* o_ = a.out; asm volatile("" : "+s"(o_)); F.out = o_; }
        unsigned char* ws = F.ws;
        float* SSQ = (float*)(ws + WS_SSQ);
        bf16_t* XB = (bf16_t*)(ws + WS_XB);
        if (ph == 0) p0_prologue(F, a);
        else if (ph == NPHASE - 1) final_norm(F, a);
        else {
            const int l = (ph - 1) / 9, sp = (ph - 1) % 9;
            unsigned char* wb = ws + WS_W0 + l * WS_WSTRIDE;
            if (sp == 0) {
                pg8::Gemm g{XB, (const bf16_t*)(wb + WO_IN), D, D, D}; pg8::StaticOrder S; S.init(MP / 256, NIN / 256, F.G, F.bx);
                pg8::EpiProj E{(bf16_t*)(ws + WS_QKV), (bf16_t*)(ws + WS_ZS), (bf16_t*)(ws + WS_S5A), (bf16_t*)(ws + WS_S5US), (bf16_t*)(ws + WS_SGD), (bf16_t*)(ws + WS_SGS), (float*)(ws + WS_BA), SSQ + (size_t)(2 * l) * MP};
                pg8::gemm_phase(F.lds, F.tid, g, S, E);
            } else if (sp == 1) {
                conv_state_out(F, a, l);
                mixer_reference(F, a, l);
            } else if (sp == 2) {
            } else if (sp == 3) {
            } else if (sp == 4) {
                pg8::Gemm g{(const bf16_t*)(ws + WS_G5), (const bf16_t*)(wb + WO_GLU), 1024, 1024, 1024}; pg8::StaticOrder S; S.init(MP / 256, 4, F.G, F.bx);
                pg8::EpiGlu E{(const bf16_t*)(ws + WS_G5), (bf16_t*)(ws + WS_G5G)};
                pg8::gemm_phase(F.lds, F.tid, g, S, E);
            } else if (sp == 5) {
                { pg8::Gemm g{(const bf16_t*)(ws + WS_ON), (const bf16_t*)(wb + WO_BRDN), 1024, 1024, 1024}; pg8::StaticOrder S; S.init(MP / 256, 8, F.G, F.bx);
                  pg8::EpiBr<false> E{(const bf16_t*)(ws + WS_SGD), (bf16_t*)(ws + WS_MERGED)}; pg8::gemm_phase(F.lds, F.tid, g, S, E); }
                { pg8::Gemm g{(const bf16_t*)(ws + WS_G5G), (const bf16_t*)(wb + WO_BRS5), 1024, 1024, 1024}; pg8::StaticOrder S; S.init(MP / 256, 8, F.G, F.bx);
                  pg8::EpiBr<true> E{(const bf16_t*)(ws + WS_SGS), (bf16_t*)(ws + WS_MERGED)}; pg8::gemm_phase(F.lds, F.tid, g, S, E); }
            } else if (sp == 6) {
                pg8::Gemm g{(const bf16_t*)(ws + WS_MERGED), (const bf16_t*)(wb + WO_OUT), D, D, D}; pg8::StaticOrder S; S.init(MP / 256, 8, F.G, F.bx);
                pg8::EpiRes E{l == 0 ? a.in[I_XP] : F.out, l == 0 ? a.in[I_XS] : F.out + (size_t)NPROMPT * D, F.out, XB, SSQ + (size_t)(2 * l + 1) * MP};
                pg8::gemm_phase(F.lds, F.tid, g, S, E);
            } else if (sp == 7) {
                pg8::Gemm g{XB, (const bf16_t*)(wb + WO_GU), D, D, D}; pg8::StaticOrder S; S.init(MP / 256, 44, F.G, F.bx);
                pg8::EpiGU E{(bf16_t*)(ws + WS_ACT), SSQ + (size_t)(2 * l + 1) * MP};
                pg8::gemm_phase(F.lds, F.tid, g, S, E);
            } else {
                pg8::Gemm g{(const bf16_t*)(ws + WS_ACT), (const bf16_t*)(wb + WO_D), FF, FF, FF}; pg8::StaticOrder S; S.init(MP / 256, 8, F.G, F.bx);
                pg8::EpiRes E{F.out, F.out + (size_t)NPROMPT * D, F.out, XB, SSQ + (size_t)(2 * l + 2) * MP};
                pg8::gemm_phase(F.lds, F.tid, g, S, E);
            }
        }
        if (ph + 1 < ph_hi) { if (use_bar) xcd_barrier(bar); else __syncthreads(); }
    }
}

extern "C" void kernel_launch(void* const* d_in, const int* in_sizes, int n_in, void* d_out, int out_size, void* d_ws, size_t ws_size, hipStream_t stream) {
    static int grid = 0;
    if (grid == 0) {
        if (n_in != 29 || (size_t)out_size != O_END || ws_size < WS_END) { fprintf(stderr, "kernel_launch: unexpected problem: n_in %d out %d ws %zu (need %zu)\n", n_in, out_size, ws_size, (size_t)WS_END); grid = -1; return; }
        int dev = 0, cus = 0, per_cu = 0;
        if (hipGetDevice(&dev) != hipSuccess || hipDeviceGetAttribute(&cus, hipDeviceAttributeMultiprocessorCount, dev) != hipSuccess) { grid = -1; return; }
        if (hipFuncSetAttribute((const void*)fwd, hipFuncAttributeMaxDynamicSharedMemorySize, LDS_BYTES) != hipSuccess) { fprintf(stderr, "kernel_launch: hipFuncSetAttribute failed\n"); grid = -1; return; }
        if (hipOccupancyMaxActiveBlocksPerMultiprocessor(&per_cu, (const void*)fwd, 512, LDS_BYTES) != hipSuccess || per_cu < 1) { fprintf(stderr, "kernel_launch: occupancy query says %d\n", per_cu); }
        (void)hipGetLastError();
        grid = cus;
    }
    if (grid < 0) return;
    (void)hipMemsetAsync((char*)d_ws + WS_CTL, 0, CTL_ZERO_BYTES, stream);
    Args a{};
    for (int i = 0; i < 29; ++i) a.in[i] = (const float*)d_in[i];
    a.out = (float*)d_out; a.ws = (unsigned char*)d_ws;
#ifndef MK_MULTI
#define MK_MULTI 1
#endif
#if MK_MULTI
    for (int ph = 0; ph < NPHASE; ++ph) { a.ph_lo = ph; a.ph_hi = ph + 1; a.use_bar = 0; hipLaunchKernelGGL(fwd, dim3(grid), dim3(512), LDS_BYTES, stream, a); }
#else
    a.ph_lo = 0; a.ph_hi = NPHASE; a.use_bar = 1;
    hipLaunchKernelGGL(fwd, dim3(grid), dim3(512), LDS_BYTES, stream, a);
#endif
}
```

```cpp
#include <hip/hip_runtime.h>
#include <stdint.h>
#include <stdio.h>

#define LAS __attribute__((address_space(3)))
#define GAS __attribute__((address_space(1)))
typedef unsigned short bf16_t;
typedef short bf16x8 __attribute__((ext_vector_type(8)));
typedef short s16x4 __attribute__((ext_vector_type(4)));
typedef float f32x4 __attribute__((ext_vector_type(4)));
typedef float f32x2 __attribute__((ext_vector_type(2)));
typedef unsigned u32x4 __attribute__((ext_vector_type(4)));
typedef unsigned u32x2 __attribute__((ext_vector_type(2)));

constexpr int D = 2048, NPROMPT = 8192, NSAMP = 128, MR = 8320, MP = 8448, SEQ = 2048, NB = 4;
constexpr int NH = 8, DK = 128, CONVCH = 3072, S5CH = 1024, S5G = 64, S5P = 64, FF = 5632, IN_DIM = 9232, NIN = 9472;
constexpr int NCHUNK = 32;
constexpr float NORM_EPS = 1e-6f;
constexpr int NPHASE = 21, NSPLIT = 22;
constexpr int LDS_BYTES = 163840, MISC_OFF = 163840 - 256;
#ifndef PADK
#define PADK 64
#endif
constexpr int PK2 = D + PADK, PK5 = FF + PADK, PK1 = S5CH + PADK;

constexpr size_t MiB = 1u << 20;
constexpr size_t WS_CTL = 0, CTL_ZERO_BYTES = 64 * 1024;
constexpr size_t WS_SSQ = 1 * MiB;
constexpr size_t WS_BA = 2 * MiB;
constexpr size_t WS_DEC = 3 * MiB;
constexpr size_t WS_A16 = 3 * MiB + 65536;
constexpr size_t WS_BBAR = 4 * MiB;
constexpr size_t WS_S5US = 5 * MiB;
constexpr size_t WS_MB_OLD = 7 * MiB;
constexpr size_t WS_SSQP = 6 * MiB;
constexpr size_t WS_W0 = 8 * MiB, WS_WSTRIDE = 149 * MiB;
constexpr size_t WO_IN = 0, WO_GU = 39 * MiB, WO_D = 85 * MiB, WO_OUT = 108 * MiB, WO_BRDN = 117 * MiB, WO_GLU = 126 * MiB, WO_BTY = 129 * MiB, WO_BTL = 141 * MiB;
constexpr size_t WS_XB = 306 * MiB, WS_ZS = 341 * MiB, WS_SGD = WS_ZS + 16 * MiB + 512 * 1024, WS_SGS = WS_SGD + 33 * MiB;
constexpr size_t WS_S5A = WS_SGS + 33 * MiB, WS_S5L = WS_S5A + 24 * MiB, WS_ONG = WS_S5L + 16 * MiB, WS_G5 = WS_ONG + 35 * MiB;
constexpr size_t WS_MERGED = WS_G5 + 18 * MiB, WS_MB = WS_MERGED + 35 * MiB, WS_QKV = WS_MB + 2 * MiB;
constexpr size_t WS_PREP = WS_QKV + 49 * MiB + 512 * 1024, WS_ACT = WS_QKV, WS_PART = WS_S5A, WS_END = WS_PREP + 72 * MiB;
constexpr size_t PREP_ITEM = 73728;
static_assert(WS_ACT + (size_t)MP * PK5 * 2 <= WS_END, "ACT overlay");
static_assert((size_t)NIN * PK2 * 2 <= 39 * MiB && (size_t)11264 * PK2 * 2 <= 46 * MiB && (size_t)D * PK5 * 2 <= 23 * MiB && (size_t)D * PK2 * 2 <= 9 * MiB && (size_t)1024 * PK1 * 2 <= 3 * MiB, "weights");
static_assert((size_t)MP * PK2 * 2 <= 35 * MiB && (size_t)MP * PK1 * 2 <= 18 * MiB && (size_t)256 * PK2 * 2 <= 2 * MiB && (size_t)NSPLIT * NSAMP * D * 4 <= 40 * MiB, "acts");
static_assert(WS_END <= 690 * MiB, "map");

__device__ __forceinline__ unsigned f2bf(float f) { unsigned u = __float_as_uint(f); return (u + 0x7fffu + ((u >> 16) & 1u)) >> 16; }
__device__ __forceinline__ unsigned pk2(float lo, float hi);
__device__ __forceinline__ float bflo(unsigned w) { return __uint_as_float(w << 16); }
__device__ __forceinline__ float bfhi(unsigned w) { return __uint_as_float(w & 0xffff0000u); }
__device__ __forceinline__ float bf2f(bf16_t b) { return __uint_as_float(((unsigned)b) << 16); }
__device__ __forceinline__ unsigned cvt_pk_bf16(float lo, float hi) { unsigned r; asm volatile("v_cvt_pk_bf16_f32 %0, %1, %2" : "=v"(r) : "v"(lo), "v"(hi)); return r; }
__device__ __forceinline__ unsigned pk2(float lo, float hi) { return cvt_pk_bf16(lo, hi); }
__device__ __forceinline__ unsigned pk2_sw(float lo, float hi) { return f2bf(lo) | (f2bf(hi) << 16); }
__device__ __forceinline__ float sigmoidf_(float x) { return __builtin_amdgcn_rcpf(1.0f + __expf(-x)); }
__device__ __forceinline__ float siluf_(float x) { return x * __builtin_amdgcn_rcpf(1.0f + __expf(-x)); }
__device__ __forceinline__ float softplusf_(float x) { return fmaxf(x, 0.f) + log1pf(__expf(-fabsf(x))); }
__device__ __forceinline__ float geluf_(float x) { const float u = 1.5957691216057308f * (x + 0.044715f * x * x * x); return x * __builtin_amdgcn_rcpf(1.0f + __expf(-u)); }
__device__ __forceinline__ float dpp_f(float v, int) { return v; }
#define WS_DPP(v, ctrl) __builtin_bit_cast(float, __builtin_amdgcn_update_dpp(__builtin_bit_cast(int, (v)), __builtin_bit_cast(int, (v)), (ctrl), 0xF, 0xF, true))
__device__ __forceinline__ float wave_sum(float v) {
    v += WS_DPP(v, 0xB1);
    v += WS_DPP(v, 0x4E);
    v += WS_DPP(v, 0x141);
    v += WS_DPP(v, 0x140);
    v += __shfl_xor(v, 16); v += __shfl_xor(v, 32);
    return v;
}
#if defined(__HIP_DEVICE_COMPILE__)
#define ASSUME_GLOBAL(p) do { __builtin_assume(!__builtin_amdgcn_is_shared((const void*)(p))); __builtin_assume(!__builtin_amdgcn_is_private((const void*)(p))); } while (0)
#else
#define ASSUME_GLOBAL(p) do { } while (0)
#endif
#ifndef DUPMASK
#define DUPMASK 0x0u
#endif
#ifndef PHMASK
#define PHMASK 0x1FFFFFu
#endif
#ifndef DELTA_FAST
#define DELTA_FAST 1
#endif
#ifndef S5_FAST
#define S5_FAST 1
#endif
#define LDS_WAIT() asm volatile("s_waitcnt lgkmcnt(0)" ::: "memory")
#define VM_WAIT() asm volatile("s_waitcnt vmcnt(0)" ::: "memory")
#define LDS_BAR() do { asm volatile("s_waitcnt lgkmcnt(0)" ::: "memory"); __builtin_amdgcn_s_barrier(); asm volatile("" ::: "memory"); } while (0)

#define XB_TMO      128
#define XB_XCNT(j)  (256  + 64 * (j))
#define XB_XSUB(j)  (1280 + 64 * (j))
#define XB_XGEN(j)  (2304 + 64 * (j))
#define XB_TOP      3328
#define XB_TOPGEN   3392
#define XCD_BAR_WORDS 3456
#define XB_SPIN_CAP (1u << 20)
__device__ __forceinline__ unsigned xb_ld(unsigned* p)              { return __hip_atomic_load(p, __ATOMIC_RELAXED, __HIP_MEMORY_SCOPE_AGENT); }
__device__ __forceinline__ unsigned xb_add(unsigned* p, unsigned v) { return __hip_atomic_fetch_add(p, v, __ATOMIC_RELAXED, __HIP_MEMORY_SCOPE_AGENT); }
__device__ __forceinline__ unsigned xb_xcc_id() { return (unsigned)__builtin_amdgcn_s_getreg((3 << 11) | 20) & 0xFu; }
#define XB_SPIN(cond, bar) do { unsigned _sp = 0; while (cond) { __builtin_amdgcn_s_sleep(1); \
    if ((++_sp & 255u) == 0u) { if (xb_ld(&(bar)[XB_TMO])) break; if (_sp > XB_SPIN_CAP) { atomicAdd(&(bar)[XB_TMO], 1u); break; } } } } while (0)
struct XcdBarrier { unsigned* bar; unsigned x; volatile LAS unsigned* st; };
__device__ __forceinline__ XcdBarrier xcd_barrier_post(unsigned* bar, volatile LAS unsigned* st) {
    XcdBarrier b; b.bar = bar; b.x = xb_xcc_id(); b.st = st;
    if (threadIdx.x == 0) (void)xb_add(&bar[XB_XCNT(b.x)], 1u);
    return b;
}
__device__ __forceinline__ void xcd_barrier_complete(unsigned* bar, unsigned x, unsigned& nloc, unsigned& nx) {
    const unsigned G = gridDim.x * gridDim.y * gridDim.z;
    unsigned sum, cnt, mine, sp = 0u;
    for (;;) {
        sum = 0u; cnt = 0u; mine = 0u;
#pragma unroll
        for (unsigned j = 0; j < 16; ++j) { const unsigned c = xb_ld(&bar[XB_XCNT(j)]); sum += c; cnt += (c > 0u) ? 1u : 0u; mine = (j == x) ? c : mine; }
        if (sum == G) break;
        __builtin_amdgcn_s_sleep(1);
        if ((++sp & 255u) == 0u) { if (xb_ld(&bar[XB_TMO])) break; if (sp > XB_SPIN_CAP) { atomicAdd(&bar[XB_TMO], 1u); break; } }
    }
    nloc = mine > 0u ? mine : 1u; nx = cnt > 0u ? cnt : 1u;
}
__device__ __forceinline__ void xcd_barrier(const XcdBarrier& b) {
    asm volatile("s_waitcnt vmcnt(0)" ::: "memory");
    __syncthreads();
    if (threadIdx.x == 0) {
        unsigned* bar = b.bar;
        __builtin_amdgcn_s_waitcnt(0);
        unsigned nloc = b.st[0], nx = b.st[1];
        if (nloc == 0u) { xcd_barrier_complete(bar, b.x, nloc, nx); b.st[0] = nloc; b.st[1] = nx; }
        const unsigned old = xb_add(&bar[XB_XSUB(b.x)], 1u);
        const unsigned gen = old / nloc;
        if (old + 1u == (gen + 1u) * nloc) {
            __builtin_amdgcn_fence(__ATOMIC_RELEASE, "agent");
            asm volatile("s_waitcnt vmcnt(0)" ::: "memory");
            const unsigned og = xb_add(&bar[XB_TOP], 1u);
            const unsigned tg = og / nx;
            if (og + 1u == (tg + 1u) * nx) xb_add(&bar[XB_TOPGEN], 1u);
            else XB_SPIN(xb_ld(&bar[XB_TOPGEN]) == tg, bar);
            __builtin_amdgcn_fence(__ATOMIC_ACQUIRE, "agent");
            xb_add(&bar[XB_XGEN(b.x)], 1u);
            asm volatile("s_waitcnt vmcnt(0)" ::: "memory");
        } else {
            XB_SPIN(xb_ld(&bar[XB_XGEN(b.x)]) == gen, bar);
            __builtin_amdgcn_fence(__ATOMIC_ACQUIRE, "agent");
            asm volatile("s_waitcnt vmcnt(0)" ::: "memory");
        }
    }
    __syncthreads();
}

namespace pg8 {
constexpr int BM = 256, BK = 64, HALF = 128, HTB = HALF * BK * 2, STAGE_BYTES = 8 * HTB, NXCD = 8, WGM = 8;
__device__ __forceinline__ int lds_byte(int r, int c) { const int st = (r >> 4) * 2 + (c >> 5), rr = r & 15, cc = c & 31, ob = rr * 64 + cc * 2; return st * 1024 + (ob ^ (((ob >> 9) & 1) << 5)); }
__device__ __forceinline__ void stage_rc(int b, int& R, int& C) { const int st = b / 1024, sb = b % 1024, swz = sb ^ (((sb >> 9) & 1) << 5); R = (st >> 1) * 16 + swz / 64; C = (st & 1) * 32 + (swz % 64) / 2; }
__device__ __forceinline__ int perm32(int rho) { const int n = rho >> 4, i = rho & 15; return 8 * (i >> 2) + 4 * n + (i & 3); }
struct Unit { int pm, pn; };
struct Gemm { const bf16_t* A; const bf16_t* Bt; int K, lda, ldb; int a_alias = 0; };
struct StaticOrder {
    int nM, nN, nwg, G, c;
    __device__ void init(int nM_, int nN_, int G_, int c_) { nM = nM_; nN = nN_; nwg = nM * nN; G = G_; c = c_; }
    __device__ bool next(int i, Unit& u) const {
        const int per = G / NXCD, xcd = c / per, off = i * per + c % per;
        const int q = nwg / NXCD, rem = nwg % NXCD, base = (xcd < rem ? xcd * (q + 1) : rem * (q + 1) + (xcd - rem) * q), cnt = (xcd < rem ? q + 1 : q);
        if (off >= cnt) return false;
        const int wgid = base + off;
        const int nig = WGM * nN, gid = wgid / nig, fm = gid * WGM, gsz = (nM - fm) < WGM ? (nM - fm) : WGM;
        u.pm = fm + ((wgid % nig) % gsz); u.pn = (wgid % nig) / gsz; return true;
    }
};
struct S5Order {
    int G, c, c0;
    __device__ bool next(int i, Unit& u) const { const int L = i * G + c - c0; if (c < c0 || L >= 128) return false; u.pm = L; u.pn = L >> 1; return true; }
};
struct SampleOrder {
    int c, c0, n;
    __device__ bool next(int i, Unit& u) const { if (i != 0 || c < c0 || c >= c0 + n) return false; u.pm = 32; u.pn = c - c0; return true; }
};
struct SplitOrder {
    int c, n;
    __device__ bool next(int i, Unit& u) const { if (i != 0 || c >= n) return false; u.pm = 32; u.pn = c & 7; return true; }
};
template <class E, class = void> struct has_mid { static constexpr bool value = false; };
template <class E> struct has_mid<E, decltype((void)E::HAS_MID)> { static constexpr bool value = true; };
template <class Epi, class Sched>
__device__ __forceinline__ void gemm_phase(LAS unsigned char* lds, const int tid_in, const Gemm g, const Sched& S, const Epi& E) {
    int tid = tid_in; asm volatile("" : "+v"(tid));
    const int wid = __builtin_amdgcn_readfirstlane(tid >> 6), lane = tid & 63, wr = wid >> 2, wc = wid & 3, fr = lane & 15, fq = lane >> 4;
    const int K = g.K, nt = K / BK;
    unsigned voffA[2], voffB[2];
#pragma unroll
    for (int i = 0; i < 2; ++i) { int R, C; stage_rc(tid * 16 + i * 8192, R, C); const int Rb = Epi::PERM ? ((R & ~31) + perm32(R & 31)) : R;
        voffA[i] = (unsigned)(R * g.lda + C) * 2u; voffB[i] = (unsigned)(Rb * g.ldb + C) * 2u; }
    const size_t kstep = (size_t)(BK * 2);
    const size_t hstepA = g.a_alias ? (size_t)0 : (size_t)HALF * g.lda * 2, hstepB = (size_t)HALF * g.ldb * 2;
    const size_t tstepA = (size_t)BM * g.lda * 2, tstepB = 2 * hstepB;
    const unsigned ldsw = (unsigned)wid * 1024u;
    const int aoff = lds_byte(wr * 64 + fr, fq * 8), boff = lds_byte(wc * 32 + fr, fq * 8);
#define PG8_SA(b, h) (((b) * 2 + (h)) * HTB)
#define PG8_SB(b, h) ((4 + (b) * 2 + (h)) * HTB)
#define PG8_STAGE(bufoff, gbase, voff) do { _Pragma("unroll") for (int _i = 0; _i < 2; ++_i) \
        __builtin_amdgcn_global_load_lds((const unsigned*)((const char*)(gbase) + (voff)[_i]), (LAS unsigned*)(lds + (bufoff) + ldsw + _i * 8192), 16, 0, 0); } while (0)
#define PG8_LDA(dst, b, h) do { _Pragma("unroll") for (int m = 0; m < 4; ++m) _Pragma("unroll") for (int k = 0; k < 2; ++k) dst[m][k] = *(const LAS bf16x8*)(lds + PG8_SA(b, h) + aoff + m * 2048 + k * 1024); } while (0)
#define PG8_LDB(dst, b, h) do { _Pragma("unroll") for (int n = 0; n < 2; ++n) _Pragma("unroll") for (int k = 0; k < 2; ++k) dst[n][k] = *(const LAS bf16x8*)(lds + PG8_SB(b, h) + boff + n * 2048 + k * 1024); } while (0)
#define PG8_MMA(ai, bj, At, Bt) do { __builtin_amdgcn_s_setprio(1); _Pragma("unroll") for (int m = 0; m < 4; ++m) _Pragma("unroll") for (int n = 0; n < 2; ++n) _Pragma("unroll") for (int k = 0; k < 2; ++k) \
        acc[ai][bj][m][n] = __builtin_amdgcn_mfma_f32_16x16x32_bf16(Bt[n][k], At[m][k], acc[ai][bj][m][n], 0, 0, 0); __builtin_amdgcn_s_setprio(0); } while (0)
#define PG8_WAIT_V(n) asm volatile("s_waitcnt vmcnt(" #n ")" ::: "memory")
#define PG8_WAIT_L(n) asm volatile("s_waitcnt lgkmcnt(" #n ")" ::: "memory")
#define PG8_BAR __builtin_amdgcn_s_barrier()
#define PG8_SCHED __builtin_amdgcn_sched_barrier(0)
    Unit cur, nxt; int ui = 0;
    if (!S.next(0, cur)) return;
    f32x4 acc[2][2][4][2];
#pragma unroll
    for (int a = 0; a < 2; ++a)
#pragma unroll
        for (int b = 0; b < 2; ++b)
#pragma unroll
            for (int m = 0; m < 4; ++m)
#pragma unroll
                for (int n = 0; n < 2; ++n) acc[a][b][m][n] = (f32x4){0.f, 0.f, 0.f, 0.f};
    bf16x8 At[4][2], B0[2][2], B1[2][2];
    const char* cA = (const char*)g.A + (size_t)cur.pm * tstepA; const char* cB = (const char*)g.Bt + (size_t)cur.pn * tstepB;
    PG8_STAGE(PG8_SB(0, 0), cB, voffB); PG8_STAGE(PG8_SB(0, 1), cB + hstepB, voffB); PG8_STAGE(PG8_SA(0, 0), cA, voffA); PG8_STAGE(PG8_SA(0, 1), cA + hstepA, voffA);
    if (wr == 1) PG8_BAR;
    PG8_WAIT_V(2); PG8_BAR;
    PG8_STAGE(PG8_SB(1, 0), cB + kstep, voffB); PG8_STAGE(PG8_SA(1, 0), cA + kstep, voffA); PG8_STAGE(PG8_SB(1, 1), cB + hstepB + kstep, voffB);
    PG8_WAIT_V(6); PG8_BAR;
    for (;;) {
        const bool has_next = S.next(ui + 1, nxt);
        const char* nA = has_next ? (const char*)g.A + (size_t)nxt.pm * tstepA : cA; const char* nB = has_next ? (const char*)g.Bt + (size_t)nxt.pn * tstepB : cB;
#pragma unroll 1
        for (int t = 0; t < nt; t += 2) {
            if constexpr (has_mid<Epi>::value) { if (2 * t == nt) E.mid(acc, cur, wr, wc, fr, fq); }
            const bool last = (t == nt - 2);
            const char* a1 = cA + (size_t)(t + 1) * kstep;
            const char* a2 = last ? nA : cA + (size_t)(t + 2) * kstep; const char* b2 = last ? nB : cB + (size_t)(t + 2) * kstep;
            const char* a3 = a2 + kstep; const char* b3 = b2 + kstep;
            PG8_LDB(B0, 0, 0); PG8_LDB(B1, 0, 1); PG8_SCHED; PG8_LDA(At, 0, 0); PG8_STAGE(PG8_SA(1, 1), a1 + hstepA, voffA);
            PG8_WAIT_V(8); PG8_WAIT_L(0); PG8_BAR; PG8_MMA(0, 0, At, B0); PG8_MMA(0, 1, At, B1); PG8_BAR; PG8_SCHED;
            PG8_LDA(At, 0, 1); PG8_STAGE(PG8_SB(0, 0), b2, voffB); PG8_STAGE(PG8_SB(0, 1), b2 + hstepB, voffB); PG8_STAGE(PG8_SA(0, 0), a2, voffA);
            PG8_WAIT_V(8); PG8_WAIT_L(0); PG8_BAR; PG8_MMA(1, 0, At, B0); PG8_MMA(1, 1, At, B1); PG8_BAR; PG8_SCHED;
            PG8_LDB(B0, 1, 0); PG8_LDB(B1, 1, 1); PG8_SCHED; PG8_LDA(At, 1, 0); PG8_STAGE(PG8_SA(0, 1), a2 + hstepA, voffA);
            PG8_WAIT_V(8); PG8_WAIT_L(0); PG8_BAR; PG8_MMA(0, 0, At, B0); PG8_MMA(0, 1, At, B1); PG8_BAR; PG8_SCHED;
            PG8_LDA(At, 1, 1); PG8_STAGE(PG8_SB(1, 0), b3, voffB); PG8_STAGE(PG8_SB(1, 1), b3 + hstepB, voffB); PG8_STAGE(PG8_SA(1, 0), a3, voffA);
            PG8_WAIT_V(8); PG8_WAIT_L(0); PG8_BAR; PG8_MMA(1, 0, At, B0); PG8_MMA(1, 1, At, B1); PG8_BAR; PG8_SCHED;
        }
        if (wr == 0) PG8_BAR;
        E(acc, cur, wr, wc, fr, fq);
        if (!has_next) break;
#pragma unroll
        for (int a = 0; a < 2; ++a)
#pragma unroll
            for (int b = 0; b < 2; ++b)
#pragma unroll
                for (int m = 0; m < 4; ++m)
#pragma unroll
                    for (int n = 0; n < 2; ++n) acc[a][b][m][n] = (f32x4){0.f, 0.f, 0.f, 0.f};
        cur = nxt; cA = nA; cB = nB; ++ui;
        if (wr == 1) PG8_BAR;
    }
    PG8_WAIT_V(0);
    PG8_BAR;
#undef PG8_SA
#undef PG8_SB
#undef PG8_STAGE
#undef PG8_LDA
#undef PG8_LDB
#undef PG8_MMA
#undef PG8_WAIT_V
#undef PG8_WAIT_L
#undef PG8_BAR
#undef PG8_SCHED
}

struct EpiProj {
    static constexpr bool PERM = true;
    bf16_t *QKV, *ZS, *S5A, *S5US, *SGD, *SGS; float* BA; const float* SSQ;
    __device__ __forceinline__ void operator()(const f32x4 (&acc)[2][2][4][2], const Unit& u, int wr, int wc, int fr, int fq) const {
        const int row0 = u.pm * BM + wr * 64 + fr, pn = u.pn, cw = wc * 32 + 8 * fq;
#pragma unroll
        for (int ai = 0; ai < 2; ++ai)
#pragma unroll
            for (int m = 0; m < 4; ++m) {
                const int row = row0 + ai * HALF + m * 16;
                const float rstd = __builtin_amdgcn_rsqf(SSQ[row] * (1.0f / D) + NORM_EPS);
#pragma unroll
                for (int bj = 0; bj < 2; ++bj) {
                    f32x4 v0 = acc[ai][bj][m][0] * rstd, v1 = acc[ai][bj][m][1] * rstd;
                    const int col = pn * BM + bj * HALF + cw;
                    if (pn == 36) {
                        if (col < 9216 + 16) { float* p = BA + (size_t)row * 16 + (col - 9216); *(f32x4*)p = v0; *(f32x4*)(p + 4) = v1; }
                        continue;
                    }
                    bf16_t* dst;
                    if (pn < 12) dst = QKV + (size_t)row * CONVCH + col;
                    else if (pn < 16) { dst = ZS + (size_t)row * 1024 + (col - 3072);
#pragma unroll
                        for (int j = 0; j < 4; ++j) { v0[j] = siluf_(v0[j]); v1[j] = siluf_(v1[j]); } }
                    else if (pn < 20) { const int c = col - 4096, g = c >> 4, cc = c & 15;
                        if (row < NPROMPT) { const int b = row >> 11, t = row & 2047; dst = S5A + ((size_t)(g * 512 + b * 128 + (t >> 4)) * 384 + (t & 15) * 16 + cc); }
                        else dst = S5US + (size_t)(row - NPROMPT) * 1024 + c; }
                    else { dst = (pn < 28) ? SGD + (size_t)row * D + (col - 5120) : SGS + (size_t)row * D + (col - 7168);
#pragma unroll
                        for (int j = 0; j < 4; ++j) { v0[j] = sigmoidf_(v0[j]); v1[j] = sigmoidf_(v1[j]); } }
                    u32x4 w; w.x = cvt_pk_bf16(v0[0], v0[1]); w.y = cvt_pk_bf16(v0[2], v0[3]); w.z = cvt_pk_bf16(v1[0], v1[1]); w.w = cvt_pk_bf16(v1[2], v1[3]);
                    *(u32x4*)dst = w;
                }
            }
    }
};
struct EpiGlu {
    static constexpr bool PERM = true;
    const bf16_t* G5; bf16_t* G5G;
    __device__ __forceinline__ void operator()(const f32x4 (&acc)[2][2][4][2], const Unit& u, int wr, int wc, int fr, int fq) const {
        const int row0 = u.pm * BM + wr * 64 + fr, col0 = u.pn * BM + wc * 32 + 8 * fq;
#pragma unroll
        for (int ai = 0; ai < 2; ++ai)
#pragma unroll
            for (int m = 0; m < 4; ++m) {
                const size_t ro = (size_t)(row0 + ai * HALF + m * 16) * PK1 + col0;
#pragma unroll
                for (int bj = 0; bj < 2; ++bj) {
                    const u32x4 g = *(const u32x4*)(G5 + ro + bj * HALF);
                    const f32x4 a0 = acc[ai][bj][m][0], a1 = acc[ai][bj][m][1];
                    u32x4 w;
                    w.x = cvt_pk_bf16(bflo(g.x) * sigmoidf_(a0[0]), bfhi(g.x) * sigmoidf_(a0[1]));
                    w.y = cvt_pk_bf16(bflo(g.y) * sigmoidf_(a0[2]), bfhi(g.y) * sigmoidf_(a0[3]));
                    w.z = cvt_pk_bf16(bflo(g.z) * sigmoidf_(a1[0]), bfhi(g.z) * sigmoidf_(a1[1]));
                    w.w = cvt_pk_bf16(bflo(g.w) * sigmoidf_(a1[2]), bfhi(g.w) * sigmoidf_(a1[3]));
                    *(u32x4*)(G5G + (size_t)(row0 + ai * HALF + m * 16) * PK2 + 1024 + col0 + bj * HALF) = w;
                }
            }
    }
};
struct EpiBrM {
    static constexpr bool PERM = true, HAS_MID = true;
    const bf16_t *SGD, *SGS; bf16_t* MERGED;
    __device__ __forceinline__ void mid(f32x4 (&acc)[2][2][4][2], const Unit& u, int wr, int wc, int fr, int fq) const {
        int row0 = u.pm * BM + wr * 64 + fr, col0 = u.pn * BM + wc * 32 + 8 * fq;
        asm volatile("" : "+v"(row0), "+v"(col0));
#pragma unroll
        for (int ai = 0; ai < 2; ++ai)
#pragma unroll
            for (int m2 = 0; m2 < 2; ++m2) {
                u32x4 gdv[2][2], gsv[2][2];
#pragma unroll
                for (int mm = 0; mm < 2; ++mm) { const size_t ro = (size_t)(row0 + ai * HALF + (2 * m2 + mm) * 16) * D + col0;
#pragma unroll
                    for (int bj = 0; bj < 2; ++bj) { gdv[mm][bj] = *(const u32x4*)(SGD + ro + bj * HALF); gsv[mm][bj] = *(const u32x4*)(SGS + ro + bj * HALF); } }
#pragma unroll
                for (int mm = 0; mm < 2; ++mm) { const int m = 2 * m2 + mm;
#pragma unroll
                    for (int bj = 0; bj < 2; ++bj) {
                        const u32x4 gd = gdv[mm][bj], gs = gsv[mm][bj];
                        const unsigned dw[4] = {gd.x, gd.y, gd.z, gd.w}, sw[4] = {gs.x, gs.y, gs.z, gs.w};
#pragma unroll
                        for (int j = 0; j < 4; ++j) {
                            const float r0 = bflo(dw[j]) * __builtin_amdgcn_rcpf(fmaxf(bflo(sw[j]), 9.5367431640625e-07f)), r1 = bfhi(dw[j]) * __builtin_amdgcn_rcpf(fmaxf(bfhi(sw[j]), 9.5367431640625e-07f));
                            acc[ai][bj][m][j >> 1][2 * (j & 1)] *= r0; acc[ai][bj][m][j >> 1][2 * (j & 1) + 1] *= r1; }
                    } }
                asm volatile("" ::: "memory");
            }
    }
    __device__ __forceinline__ void operator()(const f32x4 (&acc)[2][2][4][2], const Unit& u, int wr, int wc, int fr, int fq) const {
        const int row0 = u.pm * BM + wr * 64 + fr, col0 = u.pn * BM + wc * 32 + 8 * fq;
#pragma unroll
        for (int ai = 0; ai < 2; ++ai) {
            u32x4 gv[4][2];
#pragma unroll
            for (int m = 0; m < 4; ++m)
#pragma unroll
                for (int bj = 0; bj < 2; ++bj) gv[m][bj] = *(const u32x4*)(SGS + (size_t)(row0 + ai * HALF + m * 16) * D + col0 + bj * HALF);
#pragma unroll
            for (int m = 0; m < 4; ++m) {
                const size_t ro = (size_t)(row0 + ai * HALF + m * 16) * PK2 + col0;
#pragma unroll
                for (int bj = 0; bj < 2; ++bj) {
                    const u32x4 g = gv[m][bj];
                    const f32x4 a0 = acc[ai][bj][m][0], a1 = acc[ai][bj][m][1];
                    const float c = 9.5367431640625e-07f;
                    u32x4 w; w.x = cvt_pk_bf16(fmaxf(bflo(g.x), c) * a0[0], fmaxf(bfhi(g.x), c) * a0[1]); w.y = cvt_pk_bf16(fmaxf(bflo(g.y), c) * a0[2], fmaxf(bfhi(g.y), c) * a0[3]);
                    w.z = cvt_pk_bf16(fmaxf(bflo(g.z), c) * a1[0], fmaxf(bfhi(g.z), c) * a1[1]); w.w = cvt_pk_bf16(fmaxf(bflo(g.w), c) * a1[2], fmaxf(bfhi(g.w), c) * a1[3]);
                    *(u32x4*)(MERGED + ro + bj * HALF) = w;
                }
            }
            asm volatile("" ::: "memory");
        }
    }
};
struct EpiGate {
    static constexpr bool PERM = true;
    const bf16_t* GATE; bf16_t* OUT;
    __device__ __forceinline__ void operator()(const f32x4 (&acc)[2][2][4][2], const Unit& u, int wr, int wc, int fr, int fq) const {
        const int row0 = u.pm * BM + wr * 64 + fr, col0 = u.pn * BM + wc * 32 + 8 * fq;
#pragma unroll
        for (int ai = 0; ai < 2; ++ai)
#pragma unroll
            for (int m = 0; m < 4; ++m) {
                const size_t ro = (size_t)(row0 + ai * HALF + m * 16) * D + col0, rp = (size_t)(row0 + ai * HALF + m * 16) * PK2 + col0;
#pragma unroll
                for (int bj = 0; bj < 2; ++bj) {
                    const u32x4 g = *(const u32x4*)(GATE + ro + bj * HALF);
                    const f32x4 a0 = acc[ai][bj][m][0], a1 = acc[ai][bj][m][1];
                    u32x4 w; w.x = cvt_pk_bf16(bflo(g.x) * a0[0], bfhi(g.x) * a0[1]); w.y = cvt_pk_bf16(bflo(g.y) * a0[2], bfhi(g.y) * a0[3]);
                    w.z = cvt_pk_bf16(bflo(g.z) * a1[0], bfhi(g.z) * a1[1]); w.w = cvt_pk_bf16(bflo(g.w) * a1[2], bfhi(g.w) * a1[3]);
                    *(u32x4*)(OUT + rp + bj * HALF) = w;
                }
                asm volatile("" ::: "memory");
            }
    }
};
struct EpiRes {
    static constexpr bool PERM = false;
    const float* XP; const float* XS;
    float* X; bf16_t* XB; float* SSQ;
    __device__ __forceinline__ void operator()(const f32x4 (&acc)[2][2][4][2], const Unit& u, int wr, int wc, int fr, int fq) const {
        const int row0 = u.pm * BM + wr * 64 + fr, col0 = u.pn * BM + wc * 32 + 4 * fq;
#pragma unroll
        for (int ai = 0; ai < 2; ++ai) {
            f32x4 xv[4][2][2];
#pragma unroll
            for (int m = 0; m < 4; ++m) { const int row = row0 + ai * HALF + m * 16;
                const float* xo = (row < NPROMPT ? XP + (size_t)row * D : XS + (size_t)(row - NPROMPT) * D) + col0;
#pragma unroll
                for (int bj = 0; bj < 2; ++bj)
#pragma unroll
                    for (int n = 0; n < 2; ++n) xv[m][bj][n] = (row < MR) ? *(const f32x4*)(xo + bj * HALF + n * 16) : (f32x4){0.f, 0.f, 0.f, 0.f}; }
#pragma unroll
            for (int m = 0; m < 4; ++m) {
                const int row = row0 + ai * HALF + m * 16;
                float ss = 0.f;
                if (row < MR) {
                    float* xn = X + (size_t)row * D + col0; bf16_t* xb = XB + (size_t)row * PK2 + col0;
#pragma unroll
                    for (int bj = 0; bj < 2; ++bj)
#pragma unroll
                        for (int n = 0; n < 2; ++n) {
                            const f32x4 v = xv[m][bj][n] + acc[ai][bj][m][n];
                            *(f32x4*)(xn + bj * HALF + n * 16) = v;
                            u32x2 w; w.x = cvt_pk_bf16(v[0], v[1]); w.y = cvt_pk_bf16(v[2], v[3]);
                            *(u32x2*)(xb + bj * HALF + n * 16) = w;
                            ss += (v[0] * v[0] + v[1] * v[1]) + (v[2] * v[2] + v[3] * v[3]);
                        }
                }
                ss += __shfl_xor(ss, 16); ss += __shfl_xor(ss, 32);
                if (fq == 0 && row < MR) atomicAdd(SSQ + row, ss);
            }
            asm volatile("" ::: "memory");
        }
    }
};
struct EpiGU {
    static constexpr bool PERM = true;
    bf16_t* ACT; const float* SSQ;
    __device__ __forceinline__ void operator()(const f32x4 (&acc)[2][2][4][2], const Unit& u, int wr, int wc, int fr, int fq) const {
        const int row0 = u.pm * BM + wr * 64 + fr, col0 = u.pn * HALF + wc * 32 + 8 * fq;
#pragma unroll
        for (int ai = 0; ai < 2; ++ai)
#pragma unroll
            for (int m = 0; m < 4; ++m) {
                const int row = row0 + ai * HALF + m * 16;
                const float rstd = __builtin_amdgcn_rsqf(SSQ[row] * (1.0f / D) + NORM_EPS);
                float r[8];
#pragma unroll
                for (int n = 0; n < 2; ++n)
#pragma unroll
                    for (int j = 0; j < 4; ++j) r[n * 4 + j] = siluf_(acc[ai][0][m][n][j] * rstd) * (acc[ai][1][m][n][j] * rstd);
                u32x4 w; w.x = cvt_pk_bf16(r[0], r[1]); w.y = cvt_pk_bf16(r[2], r[3]); w.z = cvt_pk_bf16(r[4], r[5]); w.w = cvt_pk_bf16(r[6], r[7]);
                *(u32x4*)(ACT + (size_t)row * PK5 + col0) = w;
            }
    }
};
struct EpiPart {
    static constexpr bool PERM = false;
    float* P;
    __device__ __forceinline__ void operator()(const f32x4 (&acc)[2][2][4][2], const Unit& u, int wr, int wc, int fr, int fq) const {
        const int row0 = wr * 64 + fr, col0 = u.pn * BM + wc * 32 + 4 * fq;
#pragma unroll
        for (int m = 0; m < 4; ++m) { float* p = P + (size_t)(row0 + m * 16) * D + col0;
#pragma unroll
            for (int bj = 0; bj < 2; ++bj)
#pragma unroll
                for (int n = 0; n < 2; ++n) *(f32x4*)(p + bj * HALF + n * 16) = acc[0][bj][m][n]; }
    }
};
struct EpiS5L {
    static constexpr bool PERM = false;
    float* L;
    __device__ __forceinline__ void operator()(const f32x4 (&acc)[2][2][4][2], const Unit& u, int wr, int wc, int fr, int fq) const {
        const int row0 = u.pm * BM + wr * 64 + fr, col0 = wc * 32 + 4 * fq;
#pragma unroll
        for (int ai = 0; ai < 2; ++ai)
#pragma unroll
            for (int m = 0; m < 4; ++m) { float* p = L + (size_t)(row0 + ai * HALF + m * 16) * 128 + col0;
#pragma unroll
                for (int n = 0; n < 2; ++n) *(f32x4*)(p + n * 16) = acc[ai][0][m][n]; }
    }
};
struct EpiS5Y {
    static constexpr bool PERM = true;
    bf16_t* G5;
    __device__ __forceinline__ void operator()(const f32x4 (&acc)[2][2][4][2], const Unit& u, int wr, int wc, int fr, int fq) const {
        const int g = u.pm >> 1, cbase = 64 * wr + fr, t0 = 2 * wc + (fq >> 1), c0 = 8 * (fq & 1);
#pragma unroll
        for (int ai = 0; ai < 2; ++ai) {
            const int b = 2 * (u.pm & 1) + ai;
#pragma unroll
            for (int m = 0; m < 4; ++m) {
                bf16_t* p = G5 + (size_t)(b * SEQ + (cbase + 16 * m) * 16 + t0) * PK1 + g * 16 + c0;
#pragma unroll
                for (int bj = 0; bj < 2; ++bj) {
                    const f32x4 a0 = acc[ai][bj][m][0], a1 = acc[ai][bj][m][1];
                    u32x4 w; w.x = cvt_pk_bf16(geluf_(a0[0]), geluf_(a0[1])); w.y = cvt_pk_bf16(geluf_(a0[2]), geluf_(a0[3]));
                    w.z = cvt_pk_bf16(geluf_(a1[0]), geluf_(a1[1])); w.w = cvt_pk_bf16(geluf_(a1[2]), geluf_(a1[3]));
                    *(u32x4*)(p + (size_t)(8 * bj) * PK1) = w;
                }
                asm volatile("" ::: "memory");
            }
        }
    }
};
}

struct Args {
    const float* in[29];
    float* out; unsigned char* ws;
    int ph_lo, ph_hi, use_bar, pad;
};
enum { I_XP = 0, I_XS, I_SCONV, I_SSSM, I_S5RE, I_S5IM, I_N1, I_WIN, I_CONVW, I_ALOG, I_DTB, I_DNNW, I_WBRDN, I_LRE, I_LIM, I_LDT, I_BRE, I_BIM, I_CRE, I_CIM, I_DS, I_WGLU, I_WBRS5, I_WOUT, I_N2, I_WG, I_WU, I_WD, I_NF };
constexpr size_t O_YP = 0, O_YS = 16777216, O_PCONV = 17039360, O_PSSM = 17113088, O_PS5RE = 18161664, O_PS5IM = 18194432, O_SCONV = 18227200, O_SSSM = 20586496, O_SS5RE = 54140928, O_SS5IM = 55189504, O_END = 56238080;

typedef const __attribute__((address_space(4))) Args CArgs;
struct Frame {
    LAS unsigned char* lds;
    int tid, lane, wave, G, bx, vb;
    unsigned char* ws; float* out;
};

__device__ __forceinline__ void p0_transpose_item(const float* W, int ldw, int src, int nvalid, const float* scale, bf16_t* WT, int ldt, int nrow0, int k0, LAS float* scr, int lane) {
    const int l16 = lane & 15, r4 = lane >> 4;
    f32x4 v[16];
    const bool ok = (4 * l16 < nvalid);
#pragma unroll
    for (int i = 0; i < 16; ++i) v[i] = ok ? __builtin_nontemporal_load((const f32x4*)(W + (size_t)(k0 + 4 * i + r4) * ldw + src + 4 * l16)) : (f32x4){0.f, 0.f, 0.f, 0.f};
#pragma unroll
    for (int i = 0; i < 16; ++i) { const int kk = 4 * i + r4; f32x4 x = v[i]; if (scale) x = x * scale[k0 + kk];
        LAS float* s = scr + kk * 65 + 4 * l16; s[0] = x[0]; s[1] = x[1]; s[2] = x[2]; s[3] = x[3]; }
    LDS_WAIT(); asm volatile("" ::: "memory");
    const int c = lane & 7;
#pragma unroll
    for (int j = 0; j < 8; ++j) { const int n = (lane >> 3) + 8 * j; const LAS float* s = scr + (8 * c) * 65 + n;
        u32x4 o; o.x = cvt_pk_bf16(s[0 * 65], s[1 * 65]); o.y = cvt_pk_bf16(s[2 * 65], s[3 * 65]); o.z = cvt_pk_bf16(s[4 * 65], s[5 * 65]); o.w = cvt_pk_bf16(s[6 * 65], s[7 * 65]);
        *(u32x4*)(WT + (size_t)(nrow0 + n) * ldt + k0 + 8 * c) = o; }
    LDS_WAIT(); asm volatile("" ::: "memory");
}

__device__ __forceinline__ void p0_s5_precompute(const Frame& F, const CArgs& a, int l, int g) {
    LAS float* apr = (LAS float*)F.lds;
    LAS float* api = apr + 17 * 64;
    LAS float* bbr = api + 17 * 64;
    LAS float* bbi = bbr + 1024;
    LAS float* cre = bbi + 1024;
    LAS float* cim = cre + 1024;
    LAS float* kt = cim + 1024;
    const int tid = F.tid;
    __syncthreads();
    if (tid < 64) {
        const int p = tid;
        const float dt = expf(a.in[I_LDT][l * 64 + g]);
        const float lr = a.in[I_LRE][(l * 64 + g) * 64 + p], li = a.in[I_LIM][(l * 64 + g) * 64 + p];
        for (int d = 0; d <= 16; ++d) { const float mag = expf(lr * dt * (float)d), ang = li * dt * (float)d; apr[d * 64 + p] = mag * cosf(ang); api[d * 64 + p] = mag * sinf(ang); }
        const float ar = apr[64 + p], ai = api[64 + p], nr = ar - 1.0f, den = lr * lr + li * li;
        const float fr = (nr * lr + ai * li) / den, fi = (ai * lr - nr * li) / den;
        float* bb = (float*)(F.ws + WS_BBAR) + ((size_t)(l * 64 + g) * 64 + p) * 32;
        for (int c = 0; c < 16; ++c) { const float br = a.in[I_BRE][((size_t)(l * 64 + g) * 64 + p) * 16 + c], bi = a.in[I_BIM][((size_t)(l * 64 + g) * 64 + p) * 16 + c];
            const float xr = fr * br - fi * bi, xi = fr * bi + fi * br; bbr[p * 16 + c] = xr; bbi[p * 16 + c] = xi; bb[c] = xr; bb[16 + c] = xi; }
        float* a16 = (float*)(F.ws + WS_A16) + ((size_t)(l * 64 + g) * 64 + p) * 2;
        a16[0] = apr[16 * 64 + p]; a16[1] = api[16 * 64 + p];
    }
    for (int i = tid; i < 1024; i += 512) { cre[i] = a.in[I_CRE][(size_t)(l * 64 + g) * 1024 + i]; cim[i] = a.in[I_CIM][(size_t)(l * 64 + g) * 1024 + i]; }
    __syncthreads();
    for (int e = tid; e < 4096; e += 512) { const int d = e >> 8, c = (e >> 4) & 15, cc = e & 15; float s = 0.f;
        for (int p = 0; p < 64; ++p) { const float pr = apr[d * 64 + p], pi = api[d * 64 + p], br = bbr[p * 16 + cc], bi = bbi[p * 16 + cc];
            const float gr = pr * br - pi * bi, gi = pr * bi + pi * br; s += cre[c * 64 + p] * gr - cim[c * 64 + p] * gi; }
        if (d == 0 && c == cc) s += a.in[I_DS][l * 1024 + g * 16 + c];
        kt[e] = s; }
    __syncthreads();
    bf16_t* bty = (bf16_t*)(F.ws + WS_W0 + l * WS_WSTRIDE + WO_BTY) + (size_t)g * 256 * 384;
    for (int ch = tid; ch < 256 * 48; ch += 512) {
        const int row = ch / 48, c8 = (ch % 48) * 8, t = row >> 4, c = row & 15; float v[8];
#pragma unroll
        for (int j = 0; j < 8; ++j) { const int col = c8 + j;
            if (col < 256) { const int s = col >> 4, cc = col & 15; v[j] = (s <= t) ? kt[((t - s) * 16 + c) * 16 + cc] : 0.f; }
            else if (col < 320) { const int p = col - 256; v[j] = cre[c * 64 + p] * apr[(t + 1) * 64 + p] - cim[c * 64 + p] * api[(t + 1) * 64 + p]; }
            else { const int p = col - 320; v[j] = -(cre[c * 64 + p] * api[(t + 1) * 64 + p] + cim[c * 64 + p] * apr[(t + 1) * 64 + p]); } }
        u32x4 o; o.x = pk2(v[0], v[1]); o.y = pk2(v[2], v[3]); o.z = pk2(v[4], v[5]); o.w = pk2(v[6], v[7]);
        *(u32x4*)(bty + (size_t)row * 384 + c8) = o; }
    bf16_t* btl = (bf16_t*)(F.ws + WS_W0 + l * WS_WSTRIDE + WO_BTL) + (size_t)g * 256 * 256;
    for (int ch = tid; ch < 256 * 32; ch += 512) {
        const int row = ch >> 5, c8 = (ch & 31) * 8; float v[8];
#pragma unroll
        for (int j = 0; j < 8; ++j) { const int col = c8 + j, s = col >> 4, cc = col & 15;
            if (row < 128) { const int p = row & 63, d = 15 - s; const float pr = apr[d * 64 + p], pi = api[d * 64 + p], br = bbr[p * 16 + cc], bi = bbi[p * 16 + cc];
                v[j] = (row < 64) ? (pr * br - pi * bi) : (pr * bi + pi * br); }
            else v[j] = 0.f; }
        u32x4 o; o.x = pk2(v[0], v[1]); o.y = pk2(v[2], v[3]); o.z = pk2(v[4], v[5]); o.w = pk2(v[6], v[7]);
        *(u32x4*)(btl + (size_t)row * 256 + c8) = o; }
    __syncthreads();
}

constexpr int P0_I0 = 32 * 145, P0_I1 = 16 * 32, P0_I2 = 16 * 16, P0_I3 = 16 * 32, P0_I4 = 32 * 32, P0_I5 = 32 * 176, P0_I6 = 88 * 32, P0_IL = P0_I0 + P0_I1 + P0_I2 + P0_I3 + P0_I4 + P0_I5 + P0_I6;
__device__ __forceinline__ void p0_item(const Frame& F, const CArgs& a, int it, LAS float* scr) {
    const int l = it / P0_IL; int r = it % P0_IL;
    unsigned char* wb = F.ws + WS_W0 + l * WS_WSTRIDE;
    if (r < P0_I0) { const int kb = r / 145, nb = r % 145, n0 = nb * 64; int src, nv = 64;
        if (n0 < 4096) src = n0; else if (n0 < 9216) src = n0 + 16; else { src = 4096; nv = 16; }
        p0_transpose_item(a.in[I_WIN] + (size_t)l * D * IN_DIM, IN_DIM, src, nv, a.in[I_N1] + l * D, (bf16_t*)(wb + WO_IN), PK2, n0, kb * 64, scr, F.lane); return; } r -= P0_I0;
    if (r < P0_I1) { const int kb = r / 32, nb = r % 32; p0_transpose_item(a.in[I_WBRDN] + (size_t)l * 1024 * D, D, nb * 64, 64, nullptr, (bf16_t*)(wb + WO_BRDN), PK2, nb * 64, kb * 64, scr, F.lane); return; } r -= P0_I1;
    if (r < P0_I2) { const int kb = r / 16, nb = r % 16; p0_transpose_item(a.in[I_WGLU] + (size_t)l * 1024 * 1024, 1024, nb * 64, 64, nullptr, (bf16_t*)(wb + WO_GLU), PK1, nb * 64, kb * 64, scr, F.lane); return; } r -= P0_I2;
    if (r < P0_I3) { const int kb = r / 32, nb = r % 32; p0_transpose_item(a.in[I_WBRS5] + (size_t)l * 1024 * D, D, nb * 64, 64, nullptr, (bf16_t*)(wb + WO_BRDN) + 1024, PK2, nb * 64, kb * 64, scr, F.lane); return; } r -= P0_I3;
    if (r < P0_I4) { const int kb = r / 32, nb = r % 32; p0_transpose_item(a.in[I_WOUT] + (size_t)l * D * D, D, nb * 64, 64, nullptr, (bf16_t*)(wb + WO_OUT), PK2, nb * 64, kb * 64, scr, F.lane); return; } r -= P0_I4;
    if (r < P0_I5) { const int kb = r / 176, nb = r % 176, n0 = nb * 64, tile = n0 >> 8, j = n0 & 255;
        const float* W = (j < 128 ? a.in[I_WG] : a.in[I_WU]) + (size_t)l * D * FF;
        p0_transpose_item(W, FF, tile * 128 + (j & 127), 64, a.in[I_N2] + l * D, (bf16_t*)(wb + WO_GU), PK2, n0, kb * 64, scr, F.lane); return; } r -= P0_I5;
    { const int kb = r / 32, nb = r % 32; p0_transpose_item(a.in[I_WD] + (size_t)l * FF * D, D, nb * 64, 64, nullptr, (bf16_t*)(wb + WO_D), PK5, nb * 64, kb * 64, scr, F.lane); }
}
__device__ __forceinline__ void convert_pull(const Frame& F, const CArgs& a, int npulls) {
    volatile LAS unsigned* MISC = (volatile LAS unsigned*)(F.lds + MISC_OFF);
    LAS float* scr = (LAS float*)(F.lds + F.wave * 16640);
    unsigned* qhead = (unsigned*)(F.ws + WS_CTL) + 12288;
    for (int p = 0; p < npulls; ++p) {
        __syncthreads();
        if (F.tid == 0) MISC[16] = xb_add(qhead, 8u);
        __syncthreads();
        const int base = __builtin_amdgcn_readfirstlane((int)MISC[16]);
        if (base >= P0_IL) break;
        if (base + F.wave < P0_IL) p0_item(F, a, P0_IL + base + F.wave, scr);
    }
    __syncthreads();
}
__device__ __forceinline__ void p0_prologue(const Frame& F, const CArgs& a) {
    if (F.bx < 128) p0_s5_precompute(F, a, F.bx >> 6, F.bx & 63);
    __syncthreads();
    LAS float* scr = (LAS float*)(F.lds + F.wave * 16640);
    const int gw = F.bx * 8 + F.wave, NGW = F.G * 8;
    for (int it = gw; it < P0_IL; it += NGW) p0_item(F, a, it, scr);
    const int gt = F.bx * 512 + F.tid, NGT = F.G * 512;
    for (int l = 0; l < 2; ++l) { u32x4* z = (u32x4*)(F.ws + WS_W0 + l * WS_WSTRIDE + WO_IN + (size_t)9280 * PK2 * 2);
        for (int i = gt; i < 192 * PK2 * 2 / 16; i += NGT) z[i] = (u32x4){0u, 0u, 0u, 0u}; }
    { float* s = (float*)(F.ws + WS_SSQ) + MP; for (int i = gt; i < 4 * MP; i += NGT) s[i] = 0.f; }
    float* ssq0 = (float*)(F.ws + WS_SSQ); bf16_t* XB = (bf16_t*)(F.ws + WS_XB);
    for (int m = gw; m < MR; m += NGW) {
        const float* xr = (m < NPROMPT) ? a.in[I_XP] + (size_t)m * D : a.in[I_XS] + (size_t)(m - NPROMPT) * D;
        const f32x4* x4 = (const f32x4*)xr + F.lane; u32x2* o = (u32x2*)(XB + (size_t)m * PK2) + F.lane; float s = 0.f;
#pragma unroll
        for (int j = 0; j < 8; ++j) { const f32x4 v = x4[64 * j]; s += (v[0] * v[0] + v[1] * v[1]) + (v[2] * v[2] + v[3] * v[3]);
            u32x2 w; w.x = pk2(v[0], v[1]); w.y = pk2(v[2], v[3]); o[64 * j] = w; }
        s = wave_sum(s); if (F.lane == 0) ssq0[m] = s;
    }
}


__device__ __forceinline__ void conv_state_out(const Frame& F, const CArgs& a, int l) {
    const int gt = (F.bx - 128) * 512 + F.tid, NGT = 124 * 512;
    const bf16_t* QKV = (const bf16_t*)(F.ws + WS_QKV);
    float* pc = F.out + O_PCONV + (size_t)l * NB * 3 * CONVCH;
    for (int i = gt; i < NB * 3 * CONVCH; i += NGT) { const int ch = i % CONVCH, j = (i / CONVCH) % 3, b = i / (3 * CONVCH);
        pc[i] = bf2f(QKV[(size_t)(b * SEQ + SEQ - 3 + j) * CONVCH + ch]); }
    float* sc = F.out + O_SCONV + (size_t)l * NSAMP * 3 * CONVCH; const float* st = a.in[I_SCONV] + (size_t)l * NSAMP * 3 * CONVCH;
    constexpr int C4 = CONVCH / 4, TOT4 = NSAMP * 3 * C4;
    static_assert(TOT4 <= 5 * 124 * 512, "conv_state_out steps");
    u32x4 raw[5];
#pragma unroll
    for (int s = 0; s < 5; ++s) { const int i4 = gt + s * NGT; raw[s] = (u32x4){0u, 0u, 0u, 0u};
        if (i4 < TOT4) { const int c4 = i4 % C4, j = (i4 / C4) % 3, b = i4 / (3 * C4);
            if (j < 2) raw[s] = *(const u32x4*)(st + (size_t)i4 * 4 + CONVCH);
            else { const u32x2 w = *(const u32x2*)(QKV + (size_t)(NPROMPT + b) * CONVCH + 4 * c4); raw[s].x = w.x; raw[s].y = w.y; } } }
#pragma unroll
    for (int s = 0; s < 5; ++s) { const int i4 = gt + s * NGT;
        if (i4 < TOT4) { const int j = (i4 / C4) % 3;
            f32x4 v; if (j < 2) v = __builtin_bit_cast(f32x4, raw[s]); else v = (f32x4){bflo(raw[s].x), bfhi(raw[s].x), bflo(raw[s].y), bfhi(raw[s].y)};
            *(f32x4*)(sc + (size_t)i4 * 4) = v; } }
}


__device__ __forceinline__ void delta_seq(const Frame& F, const CArgs& a, int l, int h, int r0, int L, const float* conv0, const float* ssm0, float* ssm_out) {
    LAS float* raw = (LAS float*)F.lds;
    LAS float* qk = raw + 384;
    LAS float* part = qk + 256;
    LAS float* red = part + 512;
    const int tid = F.tid, lane = F.lane, wave = F.wave, dv = tid & 127, kg = tid >> 7;
    const bf16_t* QKV = (const bf16_t*)(F.ws + WS_QKV); const float* BA = (const float*)(F.ws + WS_BA); const bf16_t* ZS = (const bf16_t*)(F.ws + WS_ZS); bf16_t* ON = (bf16_t*)(F.ws + WS_ONG);
    const int ch = (tid < 384) ? ((tid >> 7) * 1024 + h * 128 + (tid & 127)) : 0;
    const float* cw = a.in[I_CONVW] + (size_t)l * 4 * CONVCH;
    const float cw0 = cw[ch], cw1 = cw[CONVCH + ch], cw2 = cw[2 * CONVCH + ch], cw3 = cw[3 * CONVCH + ch];
    float w0 = conv0 ? conv0[ch] : 0.f, w1 = conv0 ? conv0[CONVCH + ch] : 0.f, w2 = conv0 ? conv0[2 * CONVCH + ch] : 0.f;
    float s[32];
#pragma unroll
    for (int i = 0; i < 32; ++i) s[i] = ssm0 ? ssm0[(size_t)(kg * 32 + i) * 128 + dv] : 0.f;
    const float Aexp = expf(a.in[I_ALOG][l * NH + h]), dtb = a.in[I_DTB][l * NH + h], nw = a.in[I_DNNW][l * 128 + dv];
    __syncthreads();
    for (int t = 0; t < L; ++t) {
        const int r = r0 + t;
        if (tid < 384) { const float x = bf2f(QKV[(size_t)r * CONVCH + ch]); const float y = cw0 * w0 + cw1 * w1 + cw2 * w2 + cw3 * x; w0 = w1; w1 = w2; w2 = x; raw[tid] = siluf_(y); }
        __syncthreads();
        if (wave < 2) { const float v0 = raw[wave * 128 + lane], v1 = raw[wave * 128 + 64 + lane]; const float ss = wave_sum(v0 * v0 + v1 * v1);
            const float rs = (__builtin_amdgcn_rsqf(ss + 1e-6f)) * (wave == 0 ? 0.08838834764831845f : 1.0f); qk[wave * 128 + lane] = v0 * rs; qk[wave * 128 + 64 + lane] = v1 * rs; }
        __syncthreads();
        const float beta = sigmoidf_(BA[(size_t)r * 16 + h]), gg = -Aexp * softplusf_(BA[(size_t)r * 16 + 8 + h] + dtb), dec = expf(gg);
        float ks = 0.f;
#pragma unroll
        for (int i = 0; i < 32; ++i) { s[i] *= dec; ks += qk[128 + kg * 32 + i] * s[i]; }
        part[kg * 128 + dv] = ks;
        __syncthreads();
        const float vnew = (raw[256 + dv] - ((part[dv] + part[128 + dv]) + (part[256 + dv] + part[384 + dv]))) * beta;
        __syncthreads();
        float op = 0.f;
#pragma unroll
        for (int i = 0; i < 32; ++i) { s[i] += qk[128 + kg * 32 + i] * vnew; op += qk[kg * 32 + i] * s[i]; }
        part[kg * 128 + dv] = op;
        __syncthreads();
        const float o = (part[dv] + part[128 + dv]) + (part[256 + dv] + part[384 + dv]);
        const float ss = wave_sum(o * o); if (lane == 0) red[wave] = ss;
        __syncthreads();
        if (tid < 128) { const float rstd = __builtin_amdgcn_rsqf((red[0] + red[1]) * (1.0f / 128.0f) + NORM_EPS);
            const float z = bf2f(ZS[(size_t)r * 1024 + h * 128 + dv]); ON[(size_t)r * PK2 + h * 128 + dv] = (bf16_t)f2bf(o * rstd * nw * z); }
    }
#pragma unroll
    for (int i = 0; i < 32; ++i) ssm_out[(size_t)(kg * 32 + i) * 128 + dv] = s[i];
    __syncthreads();
}
__device__ __forceinline__ void s5_seq(const Frame& F, const CArgs& a, int l, int g, int b, bool sample, int L, const float* x0re, const float* x0im, float* ore, float* oim) {
    const int p = F.lane;
    const float dt = expf(a.in[I_LDT][l * 64 + g]);
    const float lr = a.in[I_LRE][(l * 64 + g) * 64 + p], li = a.in[I_LIM][(l * 64 + g) * 64 + p];
    const float mag = expf(lr * dt), ar = mag * cosf(li * dt), ai = mag * sinf(li * dt);
    const float* bb = (const float*)(F.ws + WS_BBAR) + ((size_t)(l * 64 + g) * 64 + p) * 32;
    float br[16], bi[16], cr[16], ci[16];
#pragma unroll
    for (int c = 0; c < 16; ++c) { br[c] = bb[c]; bi[c] = bb[16 + c]; cr[c] = a.in[I_CRE][((size_t)(l * 64 + g) * 16 + c) * 64 + p]; ci[c] = a.in[I_CIM][((size_t)(l * 64 + g) * 16 + c) * 64 + p]; }
    const float dsk = a.in[I_DS][l * 1024 + g * 16 + (p & 15)];
    float xr = x0re ? x0re[p] : 0.f, xi = x0im ? x0im[p] : 0.f;
    const bf16_t* S5A = (const bf16_t*)(F.ws + WS_S5A); const bf16_t* S5US = (const bf16_t*)(F.ws + WS_S5US); bf16_t* G5 = (bf16_t*)(F.ws + WS_G5);
    for (int t = 0; t < L; ++t) {
        const bf16_t* up = sample ? S5US + (size_t)b * 1024 + g * 16 : S5A + ((size_t)(g * 512 + b * 128 + (t >> 4)) * 384 + (t & 15) * 16);
        const u32x4 u0 = *(const u32x4*)up, u1 = *(const u32x4*)(up + 8);
        const float u[16] = {bflo(u0.x), bfhi(u0.x), bflo(u0.y), bfhi(u0.y), bflo(u0.z), bfhi(u0.z), bflo(u0.w), bfhi(u0.w), bflo(u1.x), bfhi(u1.x), bflo(u1.y), bfhi(u1.y), bflo(u1.z), bfhi(u1.z), bflo(u1.w), bfhi(u1.w)};
        float bur = 0.f, bui = 0.f;
#pragma unroll
        for (int c = 0; c < 16; ++c) { bur += br[c] * u[c]; bui += bi[c] * u[c]; }
        const float nxr = ar * xr - ai * xi + bur, nxi = ar * xi + ai * xr + bui; xr = nxr; xi = nxi;
        float y = 0.f, um = 0.f;
#pragma unroll
        for (int c = 0; c < 16; ++c) { const float v = wave_sum(cr[c] * xr - ci[c] * xi); if (p == c) { y = v; um = u[c]; } }
        if (p < 16) { y += dsk * um; const size_t row = sample ? (size_t)(NPROMPT + b) : (size_t)(b * SEQ + t); G5[row * PK1 + g * 16 + p] = (bf16_t)f2bf(geluf_(y)); }
    }
    ore[p] = xr; oim[p] = xi;
}


__device__ __forceinline__ void s5_sample_wave(const Frame& F, const CArgs& a, int l, int g, int b0) {
    const int p = F.lane;
    const float dt = expf(a.in[I_LDT][l * 64 + g]);
    const float lr = a.in[I_LRE][(l * 64 + g) * 64 + p], li = a.in[I_LIM][(l * 64 + g) * 64 + p];
    const float mag = expf(lr * dt), ar = mag * cosf(li * dt), ai = mag * sinf(li * dt);
    const float* bb = (const float*)(F.ws + WS_BBAR) + ((size_t)(l * 64 + g) * 64 + p) * 32;
    float br[16], bi[16], cr[16], ci[16];
#pragma unroll
    for (int c = 0; c < 16; ++c) { br[c] = bb[c]; bi[c] = bb[16 + c]; cr[c] = a.in[I_CRE][((size_t)(l * 64 + g) * 16 + c) * 64 + p]; ci[c] = a.in[I_CIM][((size_t)(l * 64 + g) * 16 + c) * 64 + p]; }
    const float dsk = a.in[I_DS][l * 1024 + g * 16 + (p & 15)];
    const bf16_t* S5US = (const bf16_t*)(F.ws + WS_S5US); bf16_t* G5 = (bf16_t*)(F.ws + WS_G5);
    float x0r[4], x0i[4]; u32x4 uu[4][2];
#pragma unroll
    for (int k = 0; k < 4; ++k) { const int b = b0 + 32 * k; const size_t so = ((size_t)(l * NSAMP + b) * 64 + g) * 64;
        x0r[k] = a.in[I_S5RE][so + p]; x0i[k] = a.in[I_S5IM][so + p];
        const bf16_t* up = S5US + (size_t)b * 1024 + g * 16; uu[k][0] = *(const u32x4*)up; uu[k][1] = *(const u32x4*)(up + 8); }
#pragma unroll
    for (int k = 0; k < 4; ++k) { const int b = b0 + 32 * k; const size_t so = ((size_t)(l * NSAMP + b) * 64 + g) * 64;
        const u32x4 u0 = uu[k][0], u1 = uu[k][1];
        const float u[16] = {bflo(u0.x), bfhi(u0.x), bflo(u0.y), bfhi(u0.y), bflo(u0.z), bfhi(u0.z), bflo(u0.w), bfhi(u0.w), bflo(u1.x), bfhi(u1.x), bflo(u1.y), bfhi(u1.y), bflo(u1.z), bfhi(u1.z), bflo(u1.w), bfhi(u1.w)};
        float bur = 0.f, bui = 0.f;
#pragma unroll
        for (int c = 0; c < 16; ++c) { bur += br[c] * u[c]; bui += bi[c] * u[c]; }
        const float xr = ar * x0r[k] - ai * x0i[k] + bur, xi = ar * x0i[k] + ai * x0r[k] + bui;
        float y = 0.f, um = 0.f;
#pragma unroll
        for (int c = 0; c < 16; ++c) { const float v = wave_sum(cr[c] * xr - ci[c] * xi); if (p == c) { y = v; um = u[c]; } }
        if (p < 16) { y += dsk * um; G5[(size_t)(NPROMPT + b) * PK1 + g * 16 + p] = (bf16_t)f2bf(geluf_(y)); }
        F.out[O_SS5RE + so + p] = xr; F.out[O_SS5IM + so + p] = xi; }
}
__device__ __forceinline__ void s5_chunk_scan(const Frame& F, int l, int g, int b) {
    const int p = F.lane;
    const float* a16 = (const float*)(F.ws + WS_A16) + ((size_t)(l * 64 + g) * 64 + p) * 2; const float ar = a16[0], ai = a16[1];
    const float* L = (const float*)(F.ws + WS_S5L) + (size_t)(g * 512 + b * 128) * 128;
    bf16_t* A = (bf16_t*)(F.ws + WS_S5A) + (size_t)(g * 512 + b * 128) * 384 + 256;
    float xr = 0.f, xi = 0.f;
    for (int k0 = 0; k0 < 128; k0 += 16) {
        float lr[16], li[16];
#pragma unroll
        for (int j = 0; j < 16; ++j) { lr[j] = L[(size_t)(k0 + j) * 128 + p]; li[j] = L[(size_t)(k0 + j) * 128 + 64 + p]; }
#pragma unroll
        for (int j = 0; j < 16; ++j) { A[(size_t)(k0 + j) * 384 + p] = (bf16_t)f2bf(xr); A[(size_t)(k0 + j) * 384 + 64 + p] = (bf16_t)f2bf(xi);
            const float nxr = ar * xr - ai * xi + lr[j], nxi = ar * xi + ai * xr + li[j]; xr = nxr; xi = nxi; }
    }
    F.out[O_PS5RE + ((size_t)(l * NB + b) * 64 + g) * 64 + p] = xr; F.out[O_PS5IM + ((size_t)(l * NB + b) * 64 + g) * 64 + p] = xi;
}

constexpr int PH_KT = 0, PH_QT = 17408, PH_VB = 34816, PH_KBG = 52224, PH_MISC = 69632, PH_HALF = 73728, PP = 136, TP = 72;
typedef short v4i16_t __attribute__((ext_vector_type(4)));
__device__ __forceinline__ s16x4 lds_tr16(const LAS bf16_t* p) { return __builtin_bit_cast(s16x4, __builtin_amdgcn_ds_read_tr16_b64_v4i16((LAS v4i16_t*)p)); }
__device__ __forceinline__ bf16x8 cat8(s16x4 a, s16x4 b) { return (bf16x8){a[0], a[1], a[2], a[3], b[0], b[1], b[2], b[3]}; }
__device__ __forceinline__ bf16x8 pack8(f32x4 a, f32x4 b) { u32x4 w; w.x = cvt_pk_bf16(a[0], a[1]); w.y = cvt_pk_bf16(a[2], a[3]); w.z = cvt_pk_bf16(b[0], b[1]); w.w = cvt_pk_bf16(b[2], b[3]); return __builtin_bit_cast(bf16x8, w); }
#define MFMA16(A, B, C) __builtin_amdgcn_mfma_f32_16x16x32_bf16((A), (B), (C), 0, 0, 0)

__device__ __forceinline__ void delta_prep_item(const Frame& F, const CArgs& a, int l, int b, int c, int hp) {
    const int half = F.wave >> 2, w4 = F.wave & 3, lane = F.lane, q = lane >> 4, c16 = lane & 15, h = 2 * hp + half;
    LAS unsigned char* hb = F.lds + half * PH_HALF;
    LAS bf16_t* Kt = (LAS bf16_t*)(hb + PH_KT); LAS bf16_t* Qt = (LAS bf16_t*)(hb + PH_QT); LAS bf16_t* Vb = (LAS bf16_t*)(hb + PH_VB); LAS bf16_t* Kbg = (LAS bf16_t*)(hb + PH_KBG);
    LAS float* Af = (LAS float*)(hb + PH_QT); LAS bf16_t* Tm = (LAS bf16_t*)(hb + PH_QT); LAS float* gcs = (LAS float*)(hb + PH_MISC);
    const int row0 = b * SEQ + c * 64;
    bf16_t* item = (bf16_t*)(F.ws + WS_PREP) + (size_t)((b * NH + h) * NCHUNK + c) * 36864;
    bf16_t* gW = item; bf16_t* gQD = item + 8192; bf16_t* gKD = item + 16384; bf16_t* gQK = item + 24576; bf16_t* gUT = item + 28672;
    if (w4 == 0) {
        const float* BA = (const float*)(F.ws + WS_BA) + (size_t)(row0 + lane) * 16;
        const float beta = sigmoidf_(BA[h]);
        float gc = -expf(a.in[I_ALOG][l * NH + h]) * softplusf_(BA[8 + h] + a.in[I_DTB][l * NH + h]);
#pragma unroll
        for (int o = 1; o < 64; o <<= 1) { const float t = __shfl_up(gc, o); if (lane >= o) gc += t; }
        const float glast = __shfl(gc, 63);
        gcs[lane] = gc; gcs[64 + lane] = beta; gcs[128 + lane] = expf(gc); gcs[192 + lane] = expf(glast - gc);
        if (lane == 0) ((float*)(F.ws + WS_DEC))[(b * NH + h) * NCHUNK + c] = expf(glast);
    }
    LDS_BAR();
    {
        const bf16_t* QKV = (const bf16_t*)(F.ws + WS_QKV); const int chq = h * 128 + 2 * lane;
        const float* cwp = a.in[I_CONVW] + (size_t)l * 4 * CONVCH;
        float cw[4][6];
#pragma unroll
        for (int i = 0; i < 4; ++i)
#pragma unroll
            for (int s = 0; s < 3; ++s) { const f32x2 v = *(const f32x2*)(cwp + (size_t)i * CONVCH + s * 1024 + chq); cw[i][2 * s] = v[0]; cw[i][2 * s + 1] = v[1]; }
#pragma unroll 1
        for (int hh = 0; hh < 2; ++hh) {
            unsigned pre[11][3];
#pragma unroll
            for (int i = 0; i < 11; ++i) { const int tok = 16 * w4 + 8 * hh - 3 + i; const bool ok = (c > 0) || (tok >= 0);
#pragma unroll
                for (int s = 0; s < 3; ++s) pre[i][s] = ok ? *(const unsigned*)(QKV + (size_t)(row0 + tok) * CONVCH + s * 1024 + chq) : 0u; }
#pragma unroll
            for (int tt = 0; tt < 8; ++tt) {
                const int t = 16 * w4 + 8 * hh + tt; float y[6];
#pragma unroll
                for (int s = 0; s < 3; ++s) {
                    float y0 = 0.f, y1 = 0.f;
#pragma unroll
                    for (int i = 0; i < 4; ++i) { y0 += cw[i][2 * s] * bflo(pre[tt + i][s]); y1 += cw[i][2 * s + 1] * bfhi(pre[tt + i][s]); }
                    y[2 * s] = siluf_(y0); y[2 * s + 1] = siluf_(y1);
                }
                const float ssq = wave_sum(y[0] * y[0] + y[1] * y[1]), ssk = wave_sum(y[2] * y[2] + y[3] * y[3]);
                const float rq = (__builtin_amdgcn_rsqf(ssq + 1e-6f)) * 0.08838834764831845f, rk = __builtin_amdgcn_rsqf(ssk + 1e-6f);
                const float beta = gcs[64 + t], egc = gcs[128 + t], ekd = gcs[192 + t];
                const float q0 = y[0] * rq, q1 = y[1] * rq, k0 = y[2] * rk, k1 = y[3] * rk;
                *(LAS unsigned*)(Kt + t * PP + 2 * lane) = pk2(k0, k1);
                *(LAS unsigned*)(Qt + t * PP + 2 * lane) = pk2(q0, q1);
                *(LAS unsigned*)(Vb + t * PP + 2 * lane) = pk2(y[4] * beta, y[5] * beta);
                *(LAS unsigned*)(Kbg + t * PP + 2 * lane) = pk2(k0 * beta * egc, k1 * beta * egc);
                *(unsigned*)(gQD + t * 128 + 2 * lane) = pk2(q0 * egc, q1 * egc);
                *(unsigned*)(gKD + t * 128 + 2 * lane) = pk2(k0 * ekd, k1 * ekd);
            }
        }
    }
    LDS_BAR();
    f32x4 kk[4];
    {
        bf16x8 kf[4], qf[4];
#pragma unroll
        for (int ks = 0; ks < 4; ++ks) { kf[ks] = *(const LAS bf16x8*)(Kt + (16 * w4 + c16) * PP + 32 * ks + 8 * q); qf[ks] = *(const LAS bf16x8*)(Qt + (16 * w4 + c16) * PP + 32 * ks + 8 * q); }
        const float gci = gcs[16 * w4 + c16];
#pragma unroll
        for (int mt = 0; mt < 4; ++mt) {
            f32x4 pq = (f32x4){0.f, 0.f, 0.f, 0.f}, pk = (f32x4){0.f, 0.f, 0.f, 0.f};
#pragma unroll
            for (int ks = 0; ks < 4; ++ks) { const bf16x8 kr = *(const LAS bf16x8*)(Kt + (16 * mt + c16) * PP + 32 * ks + 8 * q);
                pq = MFMA16(kr, qf[ks], pq);
                pk = MFMA16(kf[ks], kr, pk); }
            {   const int i = 16 * w4 + c16; float v[4];
#pragma unroll
                for (int r = 0; r < 4; ++r) { const int j = 16 * mt + 4 * q + r; v[r] = (i >= j) ? pq[r] * __expf(gci - gcs[j]) : 0.f; }
                u32x2 w; w.x = pk2(v[0], v[1]); w.y = pk2(v[2], v[3]); *(u32x2*)(gQK + i * 64 + 16 * mt + 4 * q) = w; }
            {   const int j = 16 * mt + c16; const float gcj = gcs[j];
#pragma unroll
                for (int r = 0; r < 4; ++r) { const int i = 16 * w4 + 4 * q + r; kk[mt][r] = (i > j) ? gcs[64 + i] * pk[r] * __expf(gcs[i] - gcj) : 0.f; } }
        }
    }
    LDS_BAR();
    constexpr int AP = 68;
#pragma unroll
    for (int mt = 0; mt < 4; ++mt)
#pragma unroll
        for (int r = 0; r < 4; ++r) Af[(16 * w4 + 4 * q + r) * AP + 16 * mt + c16] = kk[mt][r];
    LDS_BAR();
    LAS float* Tf = (LAS float*)(hb + PH_KT);
#define MM16(x, P, Q) do { const LAS float* P_ = (P) + (lane >> 2) * AP; const LAS float* Q_ = (Q) + 4 * (lane & 3); \
        _Pragma("unroll") for (int k4 = 0; k4 < 4; ++k4) { const f32x4 pv = *(const LAS f32x4*)(P_ + 4 * k4); \
            _Pragma("unroll") for (int e = 0; e < 4; ++e) (x) = (x) + pv[e] * *(const LAS f32x4*)(Q_ + (4 * k4 + e) * AP); } } while (0)
#define BLK(M, bi, bj) ((M) + (16 * (bi)) * AP + 16 * (bj))
    if (w4 == 0) {
        const int bk = lane >> 4, cc = lane & 15; const LAS float* Ab = BLK(Af, bk, bk); float t[16];
#pragma unroll
        for (int i = 0; i < 16; ++i) {
            float sp[4] = {(i == cc) ? 1.0f : 0.0f, 0.f, 0.f, 0.f};
#pragma unroll
            for (int j4 = 0; j4 < (i + 3) / 4; ++j4) { const f32x4 av = *(const LAS f32x4*)(Ab + i * AP + 4 * j4);
#pragma unroll
                for (int e = 0; e < 4; ++e) if (4 * j4 + e < i) sp[e] -= av[e] * t[4 * j4 + e]; }
            t[i] = (sp[0] + sp[1]) + (sp[2] + sp[3]);
        }
#pragma unroll
        for (int i = 0; i < 16; ++i) BLK(Tf, bk, bk)[i * AP + cc] = t[i];
    }
    LDS_BAR();
    {
#pragma unroll
        for (int lv = 1; lv <= 3; ++lv) {
            if (w4 < 4 - lv) {
                const int bi = w4 + lv, bj = w4; f32x4 x = (f32x4){0.f, 0.f, 0.f, 0.f};
#pragma unroll
                for (int kb = 0; kb < 3; ++kb) if (kb < lv) MM16(x, BLK(Af, bi, bj + kb), BLK(Tf, bj + kb, bj));
                LAS float* xo = BLK(Tf, bi, bj) + (lane >> 2) * AP + 4 * (lane & 3);
                *(LAS f32x4*)xo = x;
                LDS_WAIT();
                f32x4 y = (f32x4){0.f, 0.f, 0.f, 0.f};
                MM16(y, BLK(Tf, bi, bi), BLK(Tf, bi, bj));
                LDS_WAIT();
                *(LAS f32x4*)xo = (f32x4){-y[0], -y[1], -y[2], -y[3]};
            }
            LDS_BAR();
        }
    }
#undef MM16
#pragma unroll
    for (int e = 0; e < 4; ++e) { const int idx = (F.tid & 255) + 256 * e, i = idx >> 4, j4 = (idx & 15) * 4;
        f32x4 v = *(const LAS f32x4*)(Tf + i * AP + j4); if ((j4 >> 4) > (i >> 4)) v = (f32x4){0.f, 0.f, 0.f, 0.f};
        u32x2 w; w.x = pk2(v[0], v[1]); w.y = pk2(v[2], v[3]); *(LAS u32x2*)(Tm + i * TP + j4) = w; }
#undef BLK
    LDS_BAR();
    {
        bf16x8 tf[4][2];
#pragma unroll
        for (int mt = 0; mt < 4; ++mt)
#pragma unroll
            for (int ks = 0; ks < 2; ++ks) tf[mt][ks] = *(const LAS bf16x8*)(Tm + (16 * mt + c16) * TP + 32 * ks + 8 * q);
#pragma unroll
        for (int n2 = 0; n2 < 2; ++n2) {
            const int nt = 2 * w4 + n2;
            bf16x8 vf[2], gf[2];
#pragma unroll
            for (int ks = 0; ks < 2; ++ks) {
                const int rr = 32 * ks + 8 * q + (c16 >> 2), cc = 16 * nt + 4 * (c16 & 3);
                vf[ks] = cat8(lds_tr16(Vb + rr * PP + cc), lds_tr16(Vb + (rr + 4) * PP + cc));
                gf[ks] = cat8(lds_tr16(Kbg + rr * PP + cc), lds_tr16(Kbg + (rr + 4) * PP + cc));
            }
#pragma unroll
            for (int mt = 0; mt < 4; ++mt) {
                f32x4 u = (f32x4){0.f, 0.f, 0.f, 0.f}, w = (f32x4){0.f, 0.f, 0.f, 0.f};
#pragma unroll
                for (int ks = 0; ks < 2; ++ks) { u = MFMA16(tf[mt][ks], vf[ks], u);
                                                 w = MFMA16(gf[ks], tf[mt][ks], w); }
                u32x2 uw; uw.x = pk2_sw(u[0], u[1]); uw.y = pk2_sw(u[2], u[3]); *(u32x2*)(gUT + (16 * nt + c16) * 64 + 16 * mt + 4 * q) = uw;
                u32x2 ww; ww.x = pk2_sw(-w[0], -w[1]); ww.y = pk2_sw(-w[2], -w[3]); *(u32x2*)(gW + (16 * mt + c16) * 128 + 16 * nt + 4 * q) = ww;
            }
        }
    }
    LDS_BAR();
}

constexpr int SC_OPS = 61440, SC_W = 0, SC_QD = 17408, SC_KD = 34816, SC_QK = 52224, SC_XS = 2 * SC_OPS, SC_XV = SC_XS + 16384, SC_OTW = SC_XV + 8192;
static_assert(SC_OTW + 4096 <= MISC_OFF, "scan LDS map");
__device__ __forceinline__ bf16x8 frag2(const LAS bf16_t* p) { const u32x2 a = *(const LAS u32x2*)p, b = *(const LAS u32x2*)(p + 16); return __builtin_bit_cast(bf16x8, (u32x4){a.x, a.y, b.x, b.y}); }
__device__ __forceinline__ bf16x8 pack8_after_mfma(f32x4 a, f32x4 b) {
    u32x4 w; asm volatile("s_nop 7\n\ts_nop 7\n\tv_cvt_pk_bf16_f32 %0, %1, %2" : "=v"(w.x) : "v"(a[0]), "v"(a[1]));
    w.y = cvt_pk_bf16(a[2], a[3]); w.z = cvt_pk_bf16(b[0], b[1]); w.w = cvt_pk_bf16(b[2], b[3]); return __builtin_bit_cast(bf16x8, w); }
__device__ __forceinline__ void delta_scan(const Frame& F, const CArgs& a, int l, int b, int h, int sl) {
    const int wave = F.wave, lane = F.lane, q = lane >> 4, c16 = lane & 15;
    const bf16_t* items = (const bf16_t*)(F.ws + WS_PREP) + (size_t)((b * NH + h) * NCHUNK) * 36864;
    LAS unsigned char* lds = F.lds;
    __syncthreads();
    if (wave >= 4) {
        const int t2 = F.tid - 256;
        u32x4 stA[14], stB[14], stC[14], qkp[2];
        qkp[0] = (u32x4){0u, 0u, 0u, 0u}; qkp[1] = qkp[0];
#pragma unroll
        for (int i = 0; i < 14; ++i) { stA[i] = *(const u32x4*)(items + (size_t)(t2 + 256 * i) * 8); stB[i] = *(const u32x4*)(items + (size_t)36864 + (size_t)(t2 + 256 * i) * 8); }
#pragma unroll
        for (int i = 0; i < 14; ++i) stC[i] = *(const u32x4*)(items + (size_t)2 * 36864 + (size_t)(t2 + 256 * i) * 8);
        const unsigned t2x16 = (unsigned)t2 * 16u;
        const int qo0 = SC_QK + (t2 >> 3) * 144 + (t2 & 7) * 16, qo1 = SC_QK + ((t2 + 256) >> 3) * 144 + (t2 & 7) * 16;
#define SCAN_LOADER_STEP(s, ST) do { \
            { LAS unsigned char* ob = lds + ((s) & 1) * SC_OPS; LAS unsigned char* oq = lds + (((s) + 1) & 1) * SC_OPS; \
              _Pragma("unroll") for (int i = 0; i < 12; ++i) { const int idx = t2 + 256 * i; \
                  const int off = (idx >> 10) * 17408 + ((idx & 1023) >> 4) * 272 + (idx & 15) * 16; \
                  *(LAS u32x4*)(ob + off) = ST[i]; } \
              *(LAS u32x4*)(oq + qo0) = qkp[0]; *(LAS u32x4*)(oq + qo1) = qkp[1];     \
              qkp[0] = ST[12]; qkp[1] = ST[13]; } \
            LDS_BAR();                                         \
            { const int cn = ((s) + 3 < NCHUNK) ? (s) + 3 : NCHUNK - 1; \
              const char* cbp = (const char*)items + (size_t)cn * 73728; \
              _Pragma("unroll") for (int i = 0; i < 14; ++i) ST[i] = *(const u32x4*)(cbp + i * 4096 + t2x16); } } while (0)
#pragma unroll 1
        for (int s = 0; s < NCHUNK - 2; s += 3) { SCAN_LOADER_STEP(s, stA); SCAN_LOADER_STEP(s + 1, stB); SCAN_LOADER_STEP(s + 2, stC); }
        SCAN_LOADER_STEP(NCHUNK - 2, stA); SCAN_LOADER_STEP(NCHUNK - 1, stB);
        static_assert((NCHUNK - 2) % 3 == 0, "loader rotation");
#undef SCAN_LOADER_STEP
        { LAS unsigned char* oq = lds + ((NCHUNK - 1) & 1) * SC_OPS; *(LAS u32x4*)(oq + qo0) = qkp[0]; *(LAS u32x4*)(oq + qo1) = qkp[1]; }
        LDS_BAR();
    } else if (wave >= 2) {
        const int w = wave - 2;
        bf16_t* ON = (bf16_t*)(F.ws + WS_ONG); float* SSQP = (float*)(F.ws + WS_SSQP);
        const int fo = c16 * PP + 4 * q, fk = c16 * TP + 4 * q;
        LAS bf16_t* otw = (LAS bf16_t*)(lds + SC_OTW + w * 2048);
        f32x4 oprev[4];
#pragma unroll
        for (int mt = 0; mt < 4; ++mt) oprev[mt] = (f32x4){0.f, 0.f, 0.f, 0.f};
        for (int c = 0; c <= NCHUNK; ++c) {
            LDS_BAR();
            if (c >= 1) {
                const LAS bf16_t* QKl = (const LAS bf16_t*)(lds + ((c - 1) & 1) * SC_OPS + SC_QK);
                const LAS unsigned char* xv = lds + SC_XV + ((((c - 1) & 1) * 2 + w) * 2) * 1024 + lane * 16;
                const bf16x8 v0 = *(const LAS bf16x8*)xv, v1 = *(const LAS bf16x8*)(xv + 1024);
#pragma unroll
                for (int j = 0; j < 8; ++j) { const bf16x8 f = frag2(QKl + (16 * (j & 3)) * TP + 32 * (j >> 2) + fk); oprev[j & 3] = MFMA16(f, (j >> 2) ? v1 : v0, oprev[j & 3]); }
            }
            f32x4 onew[4];
#pragma unroll
            for (int mt = 0; mt < 4; ++mt) onew[mt] = (f32x4){0.f, 0.f, 0.f, 0.f};
            if (c < NCHUNK) {
                const LAS bf16_t* QDl = (const LAS bf16_t*)(lds + (c & 1) * SC_OPS + SC_QD);
                const LAS unsigned char* xs = lds + SC_XS + (((c & 1) * 2 + w) * 4) * 1024 + lane * 16;
                bf16x8 sbl[4];
#pragma unroll
                for (int ks = 0; ks < 4; ++ks) sbl[ks] = *(const LAS bf16x8*)(xs + ks * 1024);
#pragma unroll
                for (int ks = 0; ks < 4; ++ks)
#pragma unroll
                    for (int mt = 0; mt < 4; ++mt) { const bf16x8 f = frag2(QDl + (16 * mt) * PP + 32 * ks + fo); onew[mt] = MFMA16(f, sbl[ks], onew[mt]); }
            }
            if (c >= 1) {
                const int cc = c - 1;
#pragma unroll
                for (int mt = 0; mt < 4; ++mt) { const unsigned p01 = pk2_sw(oprev[mt][0], oprev[mt][1]), p23 = pk2_sw(oprev[mt][2], oprev[mt][3]); const int tok = 16 * mt + 4 * q;
                    otw[(tok + 0) * 16 + c16] = (bf16_t)(p01 & 0xffffu); otw[(tok + 1) * 16 + c16] = (bf16_t)(p01 >> 16); otw[(tok + 2) * 16 + c16] = (bf16_t)(p23 & 0xffffu); otw[(tok + 3) * 16 + c16] = (bf16_t)(p23 >> 16); }
                LDS_WAIT();
                const u32x4 o0 = *(const LAS u32x4*)(otw + lane * 16), o1 = *(const LAS u32x4*)(otw + lane * 16 + 8);
                const unsigned ow[8] = {o0.x, o0.y, o0.z, o0.w, o1.x, o1.y, o1.z, o1.w};
                float ss = 0.f;
#pragma unroll
                for (int j = 0; j < 8; ++j) { const float x0 = bflo(ow[j]), x1 = bfhi(ow[j]); ss += x0 * x0 + x1 * x1; }
                const size_t gr = (size_t)(b * SEQ + cc * 64 + lane);
                bf16_t* op = ON + gr * PK2 + h * 128 + 32 * sl + 16 * w;
                *(u32x4*)op = o0; *(u32x4*)(op + 8) = o1;
                SSQP[(gr * NH + h) * 8 + 2 * sl + w] = ss;
                LDS_WAIT();
            }
#pragma unroll
            for (int mt = 0; mt < 4; ++mt) oprev[mt] = onew[mt];
        }
    } else if (wave == 1) {
        for (int c = 0; c <= NCHUNK; ++c) LDS_BAR();
    } else {
        const int cb = 32 * sl;
        const float* DEC = (const float*)(F.ws + WS_DEC) + (b * NH + h) * NCHUNK;
        f32x4 S[8][2];
#pragma unroll
        for (int i = 0; i < 8; ++i) { S[i][0] = (f32x4){0.f, 0.f, 0.f, 0.f}; S[i][1] = S[i][0]; }
        u32x2 unA[2][4];
#pragma unroll
        for (int n = 0; n < 2; ++n)
#pragma unroll
            for (int mt = 0; mt < 4; ++mt) unA[n][mt] = *(const u32x2*)(items + 28672 + (cb + 16 * n + c16) * 64 + 16 * mt + 4 * q);
        float dnA = DEC[0];
        const int fo = c16 * PP + 4 * q;
        const int ft = (4 * q + (c16 >> 2)) * PP + 4 * (c16 & 3);
        bf16x8 sb[4][2];
#pragma unroll
        for (int ks = 0; ks < 4; ++ks)
#pragma unroll
            for (int n = 0; n < 2; ++n) { sb[ks][n] = pack8(S[2 * ks][n], S[2 * ks + 1][n]); *(LAS bf16x8*)(lds + SC_XS + ((0 * 2 + n) * 4 + ks) * 1024 + lane * 16) = sb[ks][n]; }
        auto chunk = [&](const int c, u32x2 (&un)[2][4], float& dn) __attribute__((always_inline)) {
            const LAS bf16_t* Wl = (const LAS bf16_t*)(lds + (c & 1) * SC_OPS + SC_W); const LAS bf16_t* KDl = (const LAS bf16_t*)(lds + (c & 1) * SC_OPS + SC_KD);
#define LDF_W(i) frag2(Wl + (16 * ((i) & 3)) * PP + 32 * ((i) >> 2) + fo)
#define LDF_KD(j) cat8(lds_tr16(KDl + (32 * ((j) >> 3)) * PP + 16 * ((j) & 7) + ft), lds_tr16(KDl + (32 * ((j) >> 3) + 16) * PP + 16 * ((j) & 7) + ft))
            bf16x8 fr[8];
#pragma unroll
            for (int i = 0; i < 8; ++i) fr[i] = LDF_W(i);
            f32x4 vacc[4][2];
#pragma unroll
            for (int n = 0; n < 2; ++n)
#pragma unroll
                for (int mt = 0; mt < 4; ++mt) { const u32x2 u = un[n][mt]; vacc[mt][n] = (f32x4){bflo(u.x), bfhi(u.x), bflo(u.y), bfhi(u.y)}; }
            const float d = dn;
            { const int c2 = (c + 1 < NCHUNK) ? c + 1 : NCHUNK - 1; dn = DEC[c2];
#pragma unroll
                for (int n = 0; n < 2; ++n)
#pragma unroll
                    for (int mt = 0; mt < 4; ++mt) un[n][mt] = *(const u32x2*)(items + (size_t)c2 * 36864 + 28672 + (cb + 16 * n + c16) * 64 + 16 * mt + 4 * q); }
            bf16x8 vb[2][2];
            __builtin_amdgcn_sched_barrier(0);
#pragma unroll
            for (int i = 0; i < 8; ++i) {
                const bf16x8 f = fr[i & 7]; fr[i & 7] = LDF_W(i + 8);
                vacc[i & 3][0] = MFMA16(f, sb[i >> 2][0], vacc[i & 3][0]); vacc[i & 3][1] = MFMA16(f, sb[i >> 2][1], vacc[i & 3][1]);
                __builtin_amdgcn_sched_barrier(0);
            }
#pragma unroll
            for (int i = 8; i < 16; ++i) {
                const bf16x8 f = fr[i & 7]; fr[i & 7] = LDF_KD(i - 8);
                vacc[i & 3][0] = MFMA16(f, sb[i >> 2][0], vacc[i & 3][0]); vacc[i & 3][1] = MFMA16(f, sb[i >> 2][1], vacc[i & 3][1]);
                __builtin_amdgcn_sched_barrier(0);
            }
            vb[0][0] = pack8(vacc[0][0], vacc[1][0]); vb[0][1] = pack8(vacc[0][1], vacc[1][1]); vb[1][0] = pack8_after_mfma(vacc[2][0], vacc[3][0]); vb[1][1] = pack8_after_mfma(vacc[2][1], vacc[3][1]);
#pragma unroll
            for (int n = 0; n < 2; ++n) { LAS unsigned char* xv = lds + SC_XV + (((c & 1) * 2 + n) * 2) * 1024 + lane * 16; *(LAS bf16x8*)xv = vb[0][n]; *(LAS bf16x8*)(xv + 1024) = vb[1][n]; }
            __builtin_amdgcn_sched_barrier(0);
#pragma unroll
            for (int m8 = 0; m8 < 8; ++m8) { S[m8][0] = S[m8][0] * d; S[m8][1] = S[m8][1] * d; }
            __builtin_amdgcn_sched_barrier(0);
#pragma unroll
            for (int j = 0; j < 16; ++j) {
                const bf16x8 f = fr[j & 7]; if (j + 8 < 16) fr[j & 7] = LDF_KD(j + 8);
                const int m8 = j & 7;
                S[m8][0] = MFMA16(f, vb[j >> 3][0], S[m8][0]); S[m8][1] = MFMA16(f, vb[j >> 3][1], S[m8][1]);
                __builtin_amdgcn_sched_barrier(0);
            }
#undef LDF_W
#undef LDF_KD
#pragma unroll
            for (int ks = 0; ks < 4; ++ks)
#pragma unroll
                for (int n = 0; n < 2; ++n) { sb[ks][n] = (ks < 3) ? pack8(S[2 * ks][n], S[2 * ks + 1][n]) : pack8_after_mfma(S[6][n], S[7][n]);
                    *(LAS bf16x8*)(lds + SC_XS + ((((c + 1) & 1) * 2 + n) * 4 + ks) * 1024 + lane * 16) = sb[ks][n]; }
        };
#pragma unroll 1
        for (int c = 0; c < NCHUNK; ++c) { LDS_BAR(); chunk(c, unA, dnA); }
        LDS_BAR();
        float* so = F.out + O_PSSM + ((size_t)(l * NB + b) * NH + h) * 16384;
#pragma unroll
        for (int m8 = 0; m8 < 8; ++m8)
#pragma unroll
            for (int n = 0; n < 2; ++n)
#pragma unroll
                for (int r = 0; r < 4; ++r) so[(16 * m8 + 4 * q + r) * 128 + cb + 16 * n + c16] = S[m8][n][r];
    }
    __syncthreads();
}

__device__ __forceinline__ void mixer_reference(const Frame& F, const CArgs& a, int l) {
#if !S5_FAST
    if (F.wave == 0) { const int it = F.bx; if (it < 256) { const int b = it >> 6, g = it & 63;
            s5_seq(F, a, l, g, b, false, SEQ, nullptr, nullptr, F.out + O_PS5RE + ((size_t)(l * NB + b) * 64 + g) * 64, F.out + O_PS5IM + ((size_t)(l * NB + b) * 64 + g) * 64); } }
    else { for (int it = F.bx * 7 + (F.wave - 1); it < NSAMP * 64; it += F.G * 7) { const int b = it >> 6, g = it & 63; const size_t so = ((size_t)(l * NSAMP + b) * 64 + g) * 64;
            s5_seq(F, a, l, g, b, true, 1, a.in[I_S5RE] + so, a.in[I_S5IM] + so, F.out + O_SS5RE + so, F.out + O_SS5IM + so); } }
#else
    { const int it = F.bx * 8 + F.wave; s5_sample_wave(F, a, l, it & 63, it >> 6); }
#endif
    __syncthreads();
#if DELTA_FAST
    for (int it = F.bx; it < NB * NCHUNK * 4; it += F.G) delta_prep_item(F, a, l, it >> 7, (it >> 2) & 31, it & 3);
    if (0) { for (int it = F.bx; it < NSAMP * NH; it += F.G) {
#else
    if (F.bx < 32) { const int b = F.bx >> 3, h = F.bx & 7; delta_seq(F, a, l, h, b * SEQ, SEQ, nullptr, nullptr, F.out + O_PSSM + ((size_t)(l * NB + b) * NH + h) * 16384); }
    else { for (int it = F.bx - 32; it < NSAMP * NH; it += F.G - 32) {
#endif
            const int b = it >> 3, h = it & 7; const size_t so = ((size_t)(l * NSAMP + b) * NH + h) * 16384;
            delta_seq(F, a, l, h, NPROMPT + b, 1, a.in[I_SCONV] + (size_t)(l * NSAMP + b) * 3 * CONVCH, a.in[I_SSSM] + so, F.out + O_SSSM + so); } }
}


__device__ __forceinline__ void sample_delta_pair(const Frame& F, const CArgs& a, int l, int it0, int it1) {
    const int tid = F.tid, half = tid >> 8, t2 = tid & 255, lane = F.lane, w4 = F.wave & 3, dv = t2 & 127, rg = t2 >> 5, c4 = t2 & 31;
    const int it = half ? it1 : it0; const bool act = it >= 0;
    const int b = act ? (it >> 3) : 0, h = it & 7; const int r = NPROMPT + b;
    LAS float* raw = (LAS float*)F.lds + half * 2048;
    LAS float* qk = raw + 384;
    LAS float* part = qk + 256;
    LAS float* red = part + 1024;
    const size_t so = ((size_t)(l * NSAMP + b) * NH + h) * 16384;
    const float* ssm0 = a.in[I_SSSM] + so; float* ssm_out = F.out + O_SSSM + so;
    f32x4 s[16];
#pragma unroll
    for (int i = 0; i < 16; ++i) s[i] = act ? *(const f32x4*)(ssm0 + (size_t)(rg * 16 + i) * 128 + 4 * c4) : (f32x4){0.f, 0.f, 0.f, 0.f};
    const bf16_t* QKV = (const bf16_t*)(F.ws + WS_QKV); const float* BA = (const float*)(F.ws + WS_BA); const bf16_t* ZS = (const bf16_t*)(F.ws + WS_ZS); bf16_t* ON = (bf16_t*)(F.ws + WS_ONG);
    const float* cw = a.in[I_CONVW] + (size_t)l * 4 * CONVCH; const float* c0 = a.in[I_SCONV] + (size_t)(l * NSAMP + b) * 3 * CONVCH;
#pragma unroll
    for (int ps = 0; ps < 2; ++ps) { const int ci = t2 + 256 * ps;
        if (ci < 384 && act) { const int ch = (ci >> 7) * 1024 + h * 128 + (ci & 127);
            const float y = cw[ch] * c0[ch] + cw[CONVCH + ch] * c0[CONVCH + ch] + cw[2 * CONVCH + ch] * c0[2 * CONVCH + ch] + cw[3 * CONVCH + ch] * bf2f(QKV[(size_t)r * CONVCH + ch]);
            raw[ci] = siluf_(y); } }
    LDS_BAR();
    if (w4 < 2) { const float v0 = raw[w4 * 128 + lane], v1 = raw[w4 * 128 + 64 + lane]; const float ss = wave_sum(v0 * v0 + v1 * v1);
        const float rs = (__builtin_amdgcn_rsqf(ss + 1e-6f)) * (w4 == 0 ? 0.08838834764831845f : 1.0f); qk[w4 * 128 + lane] = v0 * rs; qk[w4 * 128 + 64 + lane] = v1 * rs; }
    LDS_BAR();
    const float beta = sigmoidf_(BA[(size_t)r * 16 + h]), dec = expf(-expf(a.in[I_ALOG][l * NH + h]) * softplusf_(BA[(size_t)r * 16 + 8 + h] + a.in[I_DTB][l * NH + h]));
    f32x4 ks = (f32x4){0.f, 0.f, 0.f, 0.f};
#pragma unroll
    for (int i = 0; i < 16; ++i) { s[i] = s[i] * dec; ks = ks + s[i] * qk[128 + rg * 16 + i]; }
    *(LAS f32x4*)(part + rg * 128 + 4 * c4) = ks;
    LDS_BAR();
    f32x4 vnew = *(const LAS f32x4*)(raw + 256 + 4 * c4);
#pragma unroll
    for (int g = 0; g < 8; ++g) vnew = vnew - *(const LAS f32x4*)(part + g * 128 + 4 * c4);
    vnew = vnew * beta;
    LDS_BAR();
    f32x4 op = (f32x4){0.f, 0.f, 0.f, 0.f};
#pragma unroll
    for (int i = 0; i < 16; ++i) { s[i] = s[i] + vnew * qk[128 + rg * 16 + i]; op = op + s[i] * qk[rg * 16 + i]; }
    *(LAS f32x4*)(part + rg * 128 + 4 * c4) = op;
    LDS_BAR();
    float o = 0.f;
#pragma unroll
    for (int g = 0; g < 8; ++g) o += part[g * 128 + dv];
    const float ss = wave_sum(o * o); if (lane == 0) red[w4] = ss;
    LDS_BAR();
    if (t2 < 128 && act) { const float rstd = __builtin_amdgcn_rsqf((red[0] + red[1]) * (1.0f / 128.0f) + NORM_EPS);
        const float z = bf2f(ZS[(size_t)r * 1024 + h * 128 + dv]); ON[(size_t)r * PK2 + h * 128 + dv] = (bf16_t)f2bf(o * rstd * a.in[I_DNNW][l * 128 + dv] * z); }
    if (act) {
#pragma unroll
        for (int i = 0; i < 16; ++i) *(f32x4*)(ssm_out + (size_t)(rg * 16 + i) * 128 + 4 * c4) = s[i]; }
    LDS_BAR();
}
__device__ __forceinline__ void sample_delta(const Frame& F, const CArgs& a, int l) {
    if (F.bx >= F.G - 4) return;
    if (F.bx >= 128) { const int i0 = F.bx - 128;
        sample_delta_pair(F, a, l, i0, i0 + 124); sample_delta_pair(F, a, l, i0 + 248, i0 + 372); sample_delta_pair(F, a, l, i0 + 496, i0 + 620); sample_delta_pair(F, a, l, i0 + 744, i0 + 868);
        if (i0 < 32) sample_delta_pair(F, a, l, i0 + 992, -1); }
}
__device__ __forceinline__ void on_finish(const Frame& F, const CArgs& a, int l, int b0, int nb) {
    const bf16_t* ZS = (const bf16_t*)(F.ws + WS_ZS); bf16_t* ON = (bf16_t*)(F.ws + WS_ONG); const float* SSQP = (const float*)(F.ws + WS_SSQP);
    const int pcn = F.tid & 15; const f32x4 n0 = *(const f32x4*)(a.in[I_DNNW] + l * 128 + pcn * 8), n1 = *(const f32x4*)(a.in[I_DNNW] + l * 128 + pcn * 8 + 4);
    for (int p = (F.bx - b0) * 512 + F.tid; p < NPROMPT * 128; p += nb * 512) {
        const int row = p >> 7, pc = p & 127, h = pc >> 4;
        const f32x4 s4 = *(const f32x4*)(SSQP + ((size_t)row * NH + h) * 8) + *(const f32x4*)(SSQP + ((size_t)row * NH + h) * 8 + 4);
        const u32x4 z = *(const u32x4*)(ZS + (size_t)row * 1024 + pc * 8);
        bf16_t* op = ON + (size_t)row * PK2 + pc * 8; const u32x4 o = *(const u32x4*)op;
        const float rstd = __builtin_amdgcn_rsqf(((s4[0] + s4[1]) + (s4[2] + s4[3])) * (1.0f / 128.0f) + NORM_EPS);
        u32x4 wv;
        wv.x = cvt_pk_bf16(bflo(o.x) * rstd * n0[0] * bflo(z.x), bfhi(o.x) * rstd * n0[1] * bfhi(z.x));
        wv.y = cvt_pk_bf16(bflo(o.y) * rstd * n0[2] * bflo(z.y), bfhi(o.y) * rstd * n0[3] * bfhi(z.y));
        wv.z = cvt_pk_bf16(bflo(o.z) * rstd * n1[0] * bflo(z.z), bfhi(o.z) * rstd * n1[1] * bfhi(z.z));
        wv.w = cvt_pk_bf16(bflo(o.w) * rstd * n1[2] * bflo(z.w), bfhi(o.w) * rstd * n1[3] * bfhi(z.w));
        *(u32x4*)op = wv;
    }
}


__device__ __forceinline__ void sample_fixup_w(const Frame& F, const CArgs& a, int l, int r) {
    const float* xo = (l == 0 ? a.in[I_XS] : F.out + (size_t)NPROMPT * D) + (size_t)r * D; const float* PART = (const float*)(F.ws + WS_PART) + (size_t)r * D;
    LAS float* red = (LAS float*)F.lds;
    f32x4 v = ((const f32x4*)xo)[F.tid];
#pragma unroll
    for (int s = 0; s < 8; ++s) v = v + ((const f32x4*)(PART + (size_t)s * NSAMP * D))[F.tid];
    ((f32x4*)(F.out + (size_t)(NPROMPT + r) * D))[F.tid] = v;
    u32x2 w; w.x = cvt_pk_bf16(v[0], v[1]); w.y = cvt_pk_bf16(v[2], v[3]); ((u32x2*)((bf16_t*)(F.ws + WS_XB) + (size_t)(NPROMPT + r) * PK2))[F.tid] = w;
    const float ss = wave_sum((v[0] * v[0] + v[1] * v[1]) + (v[2] * v[2] + v[3] * v[3]));
    __syncthreads();
    if (F.lane == 0) red[F.wave] = ss;
    __syncthreads();
    if (F.tid == 0) ((float*)(F.ws + WS_SSQ))[(size_t)(2 * l + 1) * MP + NPROMPT + r] = ((red[0] + red[1]) + (red[2] + red[3])) + ((red[4] + red[5]) + (red[6] + red[7]));
    __syncthreads();
}

__device__ __forceinline__ void sample_fixup(const Frame& F, int l) {
    const int gw = F.bx * 8 + F.wave, NGW = F.G * 8;
    const float* PART = (const float*)(F.ws + WS_PART); float* ssq = (float*)(F.ws + WS_SSQ) + (size_t)(2 * l + 2) * MP; bf16_t* XB = (bf16_t*)(F.ws + WS_XB);
    for (int r = gw; r < NSAMP; r += NGW) {
        f32x4* x4 = (f32x4*)(F.out + (size_t)(NPROMPT + r) * D) + F.lane; u32x2* o = (u32x2*)(XB + (size_t)(NPROMPT + r) * PK2) + F.lane; float s = 0.f;
#pragma unroll
        for (int j = 0; j < 8; ++j) { f32x4 v = x4[64 * j];
#pragma unroll 2
            for (int sp = 0; sp < NSPLIT; ++sp) v = v + ((const f32x4*)(PART + ((size_t)sp * NSAMP + r) * D) + F.lane)[64 * j];
            x4[64 * j] = v; s += (v[0] * v[0] + v[1] * v[1]) + (v[2] * v[2] + v[3] * v[3]);
            u32x2 w; w.x = cvt_pk_bf16(v[0], v[1]); w.y = cvt_pk_bf16(v[2], v[3]); o[64 * j] = w; }
        s = wave_sum(s); if (F.lane == 0) ssq[NPROMPT + r] = s;
    }
}

__device__ __forceinline__ void final_norm(const Frame& F, const CArgs& a) {
    const int gw = F.bx * 8 + F.wave, NGW = F.G * 8; const float* ssq = (const float*)(F.ws + WS_SSQ) + 4 * MP; const f32x4* nf = (const f32x4*)a.in[I_NF] + F.lane;
    const float* PART = (const float*)(F.ws + WS_PART);
    for (int m = gw; m < MR; m += NGW) {
        f32x4* x4 = (f32x4*)(F.out + (size_t)m * D) + F.lane;
        if (m < NPROMPT) {
            const float rstd = __builtin_amdgcn_rsqf(ssq[m] * (1.0f / D) + NORM_EPS);
#pragma unroll
            for (int j = 0; j < 8; ++j) { f32x4 v = x4[64 * j]; const f32x4 w = nf[64 * j]; v = v * rstd * w; x4[64 * j] = v; }
        } else {
            const int r = m - NPROMPT; f32x4 v[8]; float s = 0.f;
#pragma unroll
            for (int j = 0; j < 8; ++j) { v[j] = x4[64 * j];
#pragma unroll 2
                for (int sp = 0; sp < NSPLIT; ++sp) v[j] = v[j] + ((const f32x4*)(PART + ((size_t)sp * NSAMP + r) * D) + F.lane)[64 * j];
                s += (v[j][0] * v[j][0] + v[j][1] * v[j][1]) + (v[j][2] * v[j][2] + v[j][3] * v[j][3]); }
            s = wave_sum(s); const float rstd = __builtin_amdgcn_rsqf(s * (1.0f / D) + NORM_EPS);
#pragma unroll
            for (int j = 0; j < 8; ++j) x4[64 * j] = v[j] * rstd * nf[64 * j];
        }
    }
}

template <int L, int SP> __device__ __forceinline__ void layer_phase(Frame& F, const CArgs& a) {
    constexpr int l = L;
    unsigned char* ws = F.ws; unsigned char* wb = ws + WS_W0 + l * WS_WSTRIDE;
    float* SSQ = (float*)(ws + WS_SSQ); bf16_t* XB = (bf16_t*)(ws + WS_XB);
    if constexpr (SP == 0) {
        pg8::Gemm g{XB, (const bf16_t*)(wb + WO_IN), D, PK2, PK2}; pg8::StaticOrder S; S.init(MP / 256, NIN / 256, F.G, F.vb);
        pg8::EpiProj E{(bf16_t*)(ws + WS_QKV), (bf16_t*)(ws + WS_ZS), (bf16_t*)(ws + WS_S5A), (bf16_t*)(ws + WS_S5US), (bf16_t*)(ws + WS_SGD), (bf16_t*)(ws + WS_SGS), (float*)(ws + WS_BA), SSQ + (size_t)(2 * l) * MP};
        pg8::gemm_phase(F.lds, F.tid, g, S, E);
        if constexpr (L == 0) { pg8::Unit t_; if (!S.next(4, t_)) convert_pull(F, a, 5); }
    } else if constexpr (SP == 1) {
#if S5_FAST
        { pg8::Gemm g{(const bf16_t*)(ws + WS_S5A), (const bf16_t*)(wb + WO_BTL), 256, 384, 256}; pg8::S5Order S{F.G, F.bx, 128};
          pg8::EpiS5L E{(float*)(ws + WS_S5L)}; pg8::gemm_phase(F.lds, F.tid, g, S, E); }
        __syncthreads();
#endif
        mixer_reference(F, a, l);
    } else if constexpr (SP == 2) {
#if DELTA_FAST
        if (F.bx < 128) delta_scan(F, a, l, (F.bx & 31) >> 3, F.bx & 7, F.bx >> 5);
#endif
        sample_delta(F, a, l);
        if (F.bx >= 128 && F.bx < 252) conv_state_out(F, a, l);
        __syncthreads();
        { pg8::Gemm g{(const bf16_t*)(ws + WS_G5), (const bf16_t*)(wb + WO_GLU), 1024, PK1, PK1, 1}; pg8::SampleOrder S{F.bx, 252, 4};
          pg8::EpiGlu E{(const bf16_t*)(ws + WS_G5), (bf16_t*)(ws + WS_ONG)}; pg8::gemm_phase(F.lds, F.tid, g, S, E); }
    } else if constexpr (SP == 3) {
#if S5_FAST
        if (F.bx < 128 && F.wave < 2) s5_chunk_scan(F, l, F.bx >> 1, 2 * (F.bx & 1) + F.wave);
        __syncthreads();
        { pg8::Gemm g{(const bf16_t*)(ws + WS_S5A), (const bf16_t*)(wb + WO_BTY), 384, 384, 384}; pg8::S5Order S{F.G, F.bx, 0};
          pg8::EpiS5Y E{(bf16_t*)(ws + WS_G5)}; pg8::gemm_phase(F.lds, F.tid, g, S, E); }
#endif
        { const int hf = (F.bx >= 136) ? 1 : 0;
          pg8::Gemm g{(const bf16_t*)(ws + WS_ONG) + hf * 1024, (const bf16_t*)(wb + WO_BRDN) + hf * 1024, 1024, PK2, PK2, 1}; pg8::SampleOrder S{F.bx, 128 + 8 * hf, 8};
          pg8::EpiGate E{(const bf16_t*)(ws + (hf ? WS_SGS : WS_SGD)), hf ? (bf16_t*)(ws + WS_MB) - (size_t)NPROMPT * PK2 : (bf16_t*)(ws + WS_MERGED)};
          pg8::gemm_phase(F.lds, F.tid, g, S, E); }
        if (F.bx >= 144) on_finish(F, a, l, 144, 112);
        if constexpr (L == 0) { if (F.bx >= 144) convert_pull(F, a, 6); }
    } else if constexpr (SP == 4) {
        { pg8::Gemm g{(const bf16_t*)(ws + WS_G5), (const bf16_t*)(wb + WO_GLU), 1024, PK1, PK1}; pg8::StaticOrder S; S.init(32, 4, F.G, F.vb);
          pg8::EpiGlu E{(const bf16_t*)(ws + WS_G5), (bf16_t*)(ws + WS_ONG)};
          pg8::gemm_phase(F.lds, F.tid, g, S, E); }
        { const int c = F.bx - 128, s8 = (c >> 3) & 7, hf = s8 >> 2, ko = (s8 & 3) * 512;
          const bf16_t* Ab = hf ? (const bf16_t*)(ws + WS_MB) - (size_t)NPROMPT * PK2 : (const bf16_t*)(ws + WS_MERGED);
          pg8::Gemm g{Ab + ko, (const bf16_t*)(wb + WO_OUT) + ko, 512, PK2, PK2, 1}; pg8::SplitOrder S{c < 0 ? 1 << 20 : c, 64};
          pg8::EpiPart E{(float*)(ws + WS_PART) + (size_t)s8 * NSAMP * D};
          pg8::gemm_phase(F.lds, F.tid, g, S, E); }
        if constexpr (L == 0) { if (F.bx >= 192) convert_pull(F, a, 4); }
    } else if constexpr (SP == 5) {
        { pg8::Gemm g{(const bf16_t*)(ws + WS_ONG), (const bf16_t*)(wb + WO_BRDN), D, PK2, PK2}; pg8::StaticOrder S; S.init(32, 8, F.G, F.vb);
          pg8::EpiBrM E{(const bf16_t*)(ws + WS_SGD), (const bf16_t*)(ws + WS_SGS), (bf16_t*)(ws + WS_MERGED)}; pg8::gemm_phase(F.lds, F.tid, g, S, E); }
        if (F.bx < NSAMP) sample_fixup_w(F, a, l, F.bx);
    } else if constexpr (SP == 6) {
        pg8::Gemm g{(const bf16_t*)(ws + WS_MERGED), (const bf16_t*)(wb + WO_OUT), D, PK2, PK2}; pg8::StaticOrder S; S.init(32, 8, F.G, F.vb);
        pg8::EpiRes E{l == 0 ? a.in[I_XP] : F.out, l == 0 ? a.in[I_XS] : F.out + (size_t)NPROMPT * D, F.out, XB, SSQ + (size_t)(2 * l + 1) * MP};
        pg8::gemm_phase(F.lds, F.tid, g, S, E);
    } else if constexpr (SP == 7) {
        pg8::Gemm g{XB, (const bf16_t*)(wb + WO_GU), D, PK2, PK2}; pg8::StaticOrder S; S.init(MP / 256, 44, F.G, F.vb);
        pg8::EpiGU E{(bf16_t*)(ws + WS_ACT), SSQ + (size_t)(2 * l + 1) * MP};
        pg8::gemm_phase(F.lds, F.tid, g, S, E);
        if constexpr (L == 0) { pg8::Unit t_; if (!S.next(5, t_)) convert_pull(F, a, 5); }
    } else if constexpr (SP == 8) {
        { pg8::Gemm g{(const bf16_t*)(ws + WS_ACT), (const bf16_t*)(wb + WO_D), FF, PK5, PK5}; pg8::StaticOrder S; S.init(32, 8, F.G, F.vb);
          pg8::EpiRes E{F.out, F.out + (size_t)NPROMPT * D, F.out, XB, SSQ + (size_t)(2 * l + 2) * MP};
          pg8::gemm_phase(F.lds, F.tid, g, S, E); }
        { const int sp = F.bx >> 3;
          pg8::Gemm g{(const bf16_t*)(ws + WS_ACT) + sp * 256, (const bf16_t*)(wb + WO_D) + sp * 256, 256, PK5, PK5, 1}; pg8::SplitOrder S{F.bx, 8 * NSPLIT};
          pg8::EpiPart E{(float*)(ws + WS_PART) + (size_t)sp * NSAMP * D};
          pg8::gemm_phase(F.lds, F.tid, g, S, E); }
    } else {
        sample_fixup(F, l);
        if constexpr (L == 0) convert_pull(F, a, 1 << 20);
    }
}

__global__ void __launch_bounds__(512, 2) fwd(Args a_unused) {
    extern __shared__ __attribute__((aligned(16))) unsigned char lds_raw[];
    CArgs* ap0 = (CArgs*)__builtin_amdgcn_kernarg_segment_ptr();
    Frame F;
    F.lds = (LAS unsigned char*)lds_raw; F.tid = threadIdx.x; F.lane = F.tid & 63; F.wave = __builtin_amdgcn_readfirstlane(F.tid >> 6);
    F.G = gridDim.x; F.bx = blockIdx.x; F.ws = ap0->ws; F.out = ap0->out;
    volatile LAS unsigned* MISC = (volatile LAS unsigned*)(F.lds + MISC_OFF);
    if (F.tid < 64) MISC[F.tid] = 0u;
    __syncthreads();
    const int lo = ap0->ph_lo, hi = ap0->ph_hi, use_bar = ap0->use_bar;
    if (F.tid == 0) MISC[13] = (blockIdx.x % 8) * (gridDim.x / 8) + blockIdx.x / 8;
    XcdBarrier bar; bar.bar = (unsigned*)(F.ws + WS_CTL) + 1024; bar.x = 0; bar.st = nullptr;
    if (use_bar) bar = xcd_barrier_post((unsigned*)(F.ws + WS_CTL) + 1024, MISC + 8);
    if (use_bar && F.tid == 0) MISC[12] = xb_add((unsigned*)(F.ws + WS_CTL) + 8192 + 64 * xb_xcc_id(), 1u);
    F.vb = 0;
#define PHASE_ENTER() CArgs* ap = ap0; asm volatile("" : "+s"(ap)); const CArgs& a = *ap; \
        { int t_ = threadIdx.x; asm volatile("" : "+v"(t_)); F.tid = t_; F.lane = t_ & 63; F.wave = __builtin_amdgcn_readfirstlane(t_ >> 6); } \
        { int b_ = blockIdx.x; asm volatile("" : "+s"(b_)); F.bx = b_; int g_ = gridDim.x; asm volatile("" : "+s"(g_)); F.G = g_; F.vb = __builtin_amdgcn_readfirstlane((int)MISC[13]); } \
        { long z_ = 0; asm volatile("" : "+s"(z_)); F.ws = a.ws + z_; F.out = a.out + z_; }
#define SEAM() do { if (use_bar) { xcd_barrier(bar); \
        if (false && F.tid == 0 && MISC[14] == 0u) { unsigned off_ = 0u; const unsigned x_ = xb_xcc_id(); \
            for (unsigned j_ = 0; j_ < 16; ++j_) { const unsigned c_ = xb_ld(&bar.bar[XB_XCNT(j_)]); if (j_ < x_) off_ += c_; } \
            MISC[13] = off_ + MISC[12]; MISC[14] = 1u; } \
        __syncthreads(); } else __syncthreads(); } while (0)
#define RUN(k, stmt) if (((PHMASK >> (k)) & 1u) && lo <= (k) && (k) < hi) { { PHASE_ENTER(); stmt; } if ((DUPMASK >> (k)) & 1u) { SEAM(); PHASE_ENTER(); stmt; } if ((k) + 1 < hi) SEAM(); }
    RUN(0, p0_prologue(F, a));
    RUN(1, (layer_phase<0, 0>(F, a))); RUN(2, (layer_phase<0, 1>(F, a))); RUN(3, (layer_phase<0, 2>(F, a))); RUN(4, (layer_phase<0, 3>(F, a))); RUN(5, (layer_phase<0, 4>(F, a)));
    RUN(6, (layer_phase<0, 5>(F, a))); RUN(7, (layer_phase<0, 6>(F, a))); RUN(8, (layer_phase<0, 7>(F, a))); RUN(9, (layer_phase<0, 8>(F, a))); RUN(10, (layer_phase<0, 9>(F, a)));
    RUN(11, (layer_phase<1, 0>(F, a))); RUN(12, (layer_phase<1, 1>(F, a))); RUN(13, (layer_phase<1, 2>(F, a))); RUN(14, (layer_phase<1, 3>(F, a))); RUN(15, (layer_phase<1, 4>(F, a)));
    RUN(16, (layer_phase<1, 5>(F, a))); RUN(17, (layer_phase<1, 6>(F, a))); RUN(18, (layer_phase<1, 7>(F, a))); RUN(19, (layer_phase<1, 8>(F, a)));
    RUN(20, final_norm(F, a));
#undef RUN
#undef PHASE_ENTER
}

extern "C" void kernel_launch(void* const* d_in, const int* in_sizes, int n_in, void* d_out, int out_size, void* d_ws, size_t ws_size, hipStream_t stream) {
    static int grid = 0;
    if (grid == 0) {
        if (n_in != 29 || (size_t)out_size != O_END || ws_size < WS_END) { fprintf(stderr, "kernel_launch: unexpected problem: n_in %d out %d ws %zu (need %zu)\n", n_in, out_size, ws_size, (size_t)WS_END); grid = -1; return; }
        int dev = 0, cus = 0, per_cu = 0;
        if (hipGetDevice(&dev) != hipSuccess || hipDeviceGetAttribute(&cus, hipDeviceAttributeMultiprocessorCount, dev) != hipSuccess) { grid = -1; return; }
        if (hipFuncSetAttribute((const void*)fwd, hipFuncAttributeMaxDynamicSharedMemorySize, LDS_BYTES) != hipSuccess) { fprintf(stderr, "kernel_launch: hipFuncSetAttribute failed\n"); grid = -1; return; }
        if (hipOccupancyMaxActiveBlocksPerMultiprocessor(&per_cu, (const void*)fwd, 512, LDS_BYTES) != hipSuccess || per_cu < 1) { fprintf(stderr, "kernel_launch: occupancy query says %d\n", per_cu); }
        (void)hipGetLastError();
        grid = cus;
    }
    if (grid < 0) return;
    (void)hipMemsetAsync((char*)d_ws + WS_CTL, 0, CTL_ZERO_BYTES, stream);
    Args a{};
    for (int i = 0; i < 29; ++i) a.in[i] = (const float*)d_in[i];
    a.out = (float*)d_out; a.ws = (unsigned char*)d_ws;
#ifndef MK_MULTI
#define MK_MULTI 0
#endif
#if MK_MULTI
    for (int ph = 0; ph < NPHASE; ++ph) { a.ph_lo = ph; a.ph_hi = ph + 1; a.use_bar = 0; hipLaunchKernelGGL(fwd, dim3(grid), dim3(512), LDS_BYTES, stream, a); }
#else
    a.ph_lo = 0; a.ph_hi = NPHASE; a.use_bar = 1;
    hipLaunchKernelGGL(fwd, dim3(grid), dim3(512), LDS_BYTES, stream, a);
#endif
}
```

```cpp
#include <hip/hip_runtime.h>
#include <stdint.h>
#include <stdio.h>

#define LAS __attribute__((address_space(3)))
#define GAS __attribute__((address_space(1)))
typedef unsigned short bf16_t;
typedef short bf16x8 __attribute__((ext_vector_type(8)));
typedef short s16x4 __attribute__((ext_vector_type(4)));
typedef float f32x4 __attribute__((ext_vector_type(4)));
typedef float f32x2 __attribute__((ext_vector_type(2)));
typedef unsigned u32x4 __attribute__((ext_vector_type(4)));
typedef unsigned u32x2 __attribute__((ext_vector_type(2)));

constexpr int D = 2048, NPROMPT = 8192, NSAMP = 128, MR = 8320, MP = 8448, SEQ = 2048, NB = 4;
constexpr int NH = 8, DK = 128, CONVCH = 3072, S5CH = 1024, S5G = 64, S5P = 64, FF = 5632, IN_DIM = 9232, NIN = 9472;
constexpr int NCHUNK = 32;
constexpr float NORM_EPS = 1e-6f;
constexpr int NPHASE = 21, NSPLIT = 22;
constexpr int LDS_BYTES = 163840, MISC_OFF = 163840 - 256;
#ifndef PADK
#define PADK 64
#endif
constexpr int PK2 = D + PADK, PK5 = FF + PADK, PK1 = S5CH + PADK;

constexpr size_t MiB = 1u << 20;
constexpr size_t WS_CTL = 0, CTL_ZERO_BYTES = 64 * 1024;
constexpr size_t WS_SSQ = 1 * MiB;
constexpr size_t WS_BA = 2 * MiB;
constexpr size_t WS_DEC = 3 * MiB;
constexpr size_t WS_A16 = 3 * MiB + 65536;
constexpr size_t WS_BBAR = 4 * MiB;
constexpr size_t WS_S5US = 5 * MiB;
constexpr size_t WS_MB_OLD = 7 * MiB;
constexpr size_t WS_SSQP = 6 * MiB;
constexpr size_t WS_W0 = 8 * MiB, WS_WSTRIDE = 149 * MiB;
constexpr size_t WO_IN = 0, WO_GU = 39 * MiB, WO_D = 85 * MiB, WO_OUT = 108 * MiB, WO_BRDN = 117 * MiB, WO_GLU = 126 * MiB, WO_BTY = 129 * MiB, WO_BTL = 141 * MiB;
constexpr size_t WS_XB = 306 * MiB, WS_ZS = 341 * MiB, WS_SGD = WS_ZS + 16 * MiB + 512 * 1024, WS_SGS = WS_SGD + 33 * MiB;
constexpr size_t WS_S5A = WS_SGS + 33 * MiB, WS_S5L = WS_S5A + 24 * MiB, WS_ONG = WS_S5L + 16 * MiB, WS_G5 = WS_ONG + 35 * MiB;
constexpr size_t WS_MERGED = WS_G5 + 18 * MiB, WS_MB = WS_MERGED + 35 * MiB, WS_QKV = WS_MB + 2 * MiB;
constexpr size_t WS_PREP = WS_QKV + 49 * MiB + 512 * 1024, WS_ACT = WS_QKV, WS_PART = WS_S5A, WS_END = WS_PREP + 72 * MiB;
constexpr size_t PREP_ITEM = 73728;
static_assert(WS_ACT + (size_t)MP * PK5 * 2 <= WS_END, "ACT overlay");
static_assert((size_t)NIN * PK2 * 2 <= 39 * MiB && (size_t)11264 * PK2 * 2 <= 46 * MiB && (size_t)D * PK5 * 2 <= 23 * MiB && (size_t)D * PK2 * 2 <= 9 * MiB && (size_t)1024 * PK1 * 2 <= 3 * MiB, "weights");
static_assert((size_t)MP * PK2 * 2 <= 35 * MiB && (size_t)MP * PK1 * 2 <= 18 * MiB && (size_t)256 * PK2 * 2 <= 2 * MiB && (size_t)NSPLIT * NSAMP * D * 4 <= 40 * MiB, "acts");
static_assert(WS_END <= 690 * MiB, "map");

__device__ __forceinline__ unsigned f2bf(float f) { unsigned u = __float_as_uint(f); return (u + 0x7fffu + ((u >> 16) & 1u)) >> 16; }
__device__ __forceinline__ unsigned pk2(float lo, float hi);
__device__ __forceinline__ float bflo(unsigned w) { return __uint_as_float(w << 16); }
__device__ __forceinline__ float bfhi(unsigned w) { return __uint_as_float(w & 0xffff0000u); }
__device__ __forceinline__ float bf2f(bf16_t b) { return __uint_as_float(((unsigned)b) << 16); }
__device__ __forceinline__ unsigned cvt_pk_bf16(float lo, float hi) { unsigned r; asm volatile("v_cvt_pk_bf16_f32 %0, %1, %2" : "=v"(r) : "v"(lo), "v"(hi)); return r; }
__device__ __forceinline__ unsigned pk2(float lo, float hi) { return cvt_pk_bf16(lo, hi); }
__device__ __forceinline__ unsigned pk2_sw(float lo, float hi) { return f2bf(lo) | (f2bf(hi) << 16); }
__device__ __forceinline__ float sigmoidf_(float x) { return __builtin_amdgcn_rcpf(1.0f + __expf(-x)); }
__device__ __forceinline__ float siluf_(float x) { return x * __builtin_amdgcn_rcpf(1.0f + __expf(-x)); }
__device__ __forceinline__ float softplusf_(float x) { return fmaxf(x, 0.f) + log1pf(__expf(-fabsf(x))); }
__device__ __forceinline__ float geluf_(float x) { const float u = 1.5957691216057308f * (x + 0.044715f * x * x * x); return x * __builtin_amdgcn_rcpf(1.0f + __expf(-u)); }
__device__ __forceinline__ float dpp_f(float v, int) { return v; }
#define WS_DPP(v, ctrl) __builtin_bit_cast(float, __builtin_amdgcn_update_dpp(__builtin_bit_cast(int, (v)), __builtin_bit_cast(int, (v)), (ctrl), 0xF, 0xF, true))
__device__ __forceinline__ float wave_sum(float v) {
    v += WS_DPP(v, 0xB1);
    v += WS_DPP(v, 0x4E);
    v += WS_DPP(v, 0x141);
    v += WS_DPP(v, 0x140);
    v += __shfl_xor(v, 16); v += __shfl_xor(v, 32);
    return v;
}
#if defined(__HIP_DEVICE_COMPILE__)
#define ASSUME_GLOBAL(p) do { __builtin_assume(!__builtin_amdgcn_is_shared((const void*)(p))); __builtin_assume(!__builtin_amdgcn_is_private((const void*)(p))); } while (0)
#else
#define ASSUME_GLOBAL(p) do { } while (0)
#endif
#ifndef DUPMASK
#define DUPMASK 0x0u
#endif
#ifndef PHMASK
#define PHMASK 0x1FFFFFu
#endif
#ifndef DELTA_FAST
#define DELTA_FAST 1
#endif
#ifndef S5_FAST
#define S5_FAST 1
#endif
#define LDS_WAIT() asm volatile("s_waitcnt lgkmcnt(0)" ::: "memory")
#define VM_WAIT() asm volatile("s_waitcnt vmcnt(0)" ::: "memory")
#define LDS_BAR() do { asm volatile("s_waitcnt lgkmcnt(0)" ::: "memory"); __builtin_amdgcn_s_barrier(); asm volatile("" ::: "memory"); } while (0)

#define XB_TMO      128
#define XB_XCNT(j)  (256  + 64 * (j))
#define XB_XSUB(j)  (1280 + 64 * (j))
#define XB_XGEN(j)  (2304 + 64 * (j))
#define XB_TOP      3328
#define XB_TOPGEN   3392
#define XCD_BAR_WORDS 3456
#define XB_SPIN_CAP (1u << 20)
__device__ __forceinline__ unsigned xb_ld(unsigned* p)              { return __hip_atomic_load(p, __ATOMIC_RELAXED, __HIP_MEMORY_SCOPE_AGENT); }
__device__ __forceinline__ unsigned xb_add(unsigned* p, unsigned v) { return __hip_atomic_fetch_add(p, v, __ATOMIC_RELAXED, __HIP_MEMORY_SCOPE_AGENT); }
__device__ __forceinline__ unsigned xb_xcc_id() { return (unsigned)__builtin_amdgcn_s_getreg((3 << 11) | 20) & 0xFu; }
#define XB_SPIN(cond, bar) do { unsigned _sp = 0; while (cond) { __builtin_amdgcn_s_sleep(1); \
    if ((++_sp & 255u) == 0u) { if (xb_ld(&(bar)[XB_TMO])) break; if (_sp > XB_SPIN_CAP) { atomicAdd(&(bar)[XB_TMO], 1u); break; } } } } while (0)
struct XcdBarrier { unsigned* bar; unsigned x; volatile LAS unsigned* st; };
__device__ __forceinline__ XcdBarrier xcd_barrier_post(unsigned* bar, volatile LAS unsigned* st) {
    XcdBarrier b; b.bar = bar; b.x = xb_xcc_id(); b.st = st;
    if (threadIdx.x == 0) (void)xb_add(&bar[XB_XCNT(b.x)], 1u);
    return b;
}
__device__ __forceinline__ void xcd_barrier_complete(unsigned* bar, unsigned x, unsigned& nloc, unsigned& nx) {
    const unsigned G = gridDim.x * gridDim.y * gridDim.z;
    unsigned sum, cnt, mine, sp = 0u;
    for (;;) {
        sum = 0u; cnt = 0u; mine = 0u;
#pragma unroll
        for (unsigned j = 0; j < 16; ++j) { const unsigned c = xb_ld(&bar[XB_XCNT(j)]); sum += c; cnt += (c > 0u) ? 1u : 0u; mine = (j == x) ? c : mine; }
        if (sum == G) break;
        __builtin_amdgcn_s_sleep(1);
        if ((++sp & 255u) == 0u) { if (xb_ld(&bar[XB_TMO])) break; if (sp > XB_SPIN_CAP) { atomicAdd(&bar[XB_TMO], 1u); break; } }
    }
    nloc = mine > 0u ? mine : 1u; nx = cnt > 0u ? cnt : 1u;
}
__device__ __forceinline__ void xcd_barrier(const XcdBarrier& b) {
    asm volatile("s_waitcnt vmcnt(0)" ::: "memory");
    __syncthreads();
    if (threadIdx.x == 0) {
        unsigned* bar = b.bar;
        __builtin_amdgcn_s_waitcnt(0);
        unsigned nloc = b.st[0], nx = b.st[1];
        if (nloc == 0u) { xcd_barrier_complete(bar, b.x, nloc, nx); b.st[0] = nloc; b.st[1] = nx; }
        const unsigned old = xb_add(&bar[XB_XSUB(b.x)], 1u);
        const unsigned gen = old / nloc;
        if (old + 1u == (gen + 1u) * nloc) {
            __builtin_amdgcn_fence(__ATOMIC_RELEASE, "agent");
            asm volatile("s_waitcnt vmcnt(0)" ::: "memory");
            const unsigned og = xb_add(&bar[XB_TOP], 1u);
            const unsigned tg = og / nx;
            if (og + 1u == (tg + 1u) * nx) xb_add(&bar[XB_TOPGEN], 1u);
            else XB_SPIN(xb_ld(&bar[XB_TOPGEN]) == tg, bar);
            __builtin_amdgcn_fence(__ATOMIC_ACQUIRE, "agent");
            xb_add(&bar[XB_XGEN(b.x)], 1u);
            asm volatile("s_waitcnt vmcnt(0)" ::: "memory");
        } else {
            XB_SPIN(xb_ld(&bar[XB_XGEN(b.x)]) == gen, bar);
            __builtin_amdgcn_fence(__ATOMIC_ACQUIRE, "agent");
            asm volatile("s_waitcnt vmcnt(0)" ::: "memory");
        }
    }
    __syncthreads();
}

namespace pg8 {
constexpr int BM = 256, BK = 64, HALF = 128, HTB = HALF * BK * 2, STAGE_BYTES = 8 * HTB, NXCD = 8, WGM = 8;
__device__ __forceinline__ int lds_byte(int r, int c) { return r * 128 + ((((c >> 3) ^ (r >> 1)) & 7) << 4) + (c & 7) * 2; }
__device__ __forceinline__ void stage_rc(int b, int& R, int& C) { R = b >> 7; C = ((((b >> 4) ^ (R >> 1)) & 7) << 3); }
__device__ __forceinline__ int perm32(int rho) { const int n = rho >> 4, i = rho & 15; return 8 * (i >> 2) + 4 * n + (i & 3); }
struct Unit { int pm, pn; };
struct Gemm { const bf16_t* A; const bf16_t* Bt; int K, lda, ldb; int a_alias = 0; };
struct StaticOrder {
    int nM, nN, nwg, G, c;
    __device__ void init(int nM_, int nN_, int G_, int c_) { nM = nM_; nN = nN_; nwg = nM * nN; G = G_; c = c_; }
    __device__ bool next(int i, Unit& u) const {
        const int per = G / NXCD, xcd = c / per, off = i * per + c % per;
        const int q = nwg / NXCD, rem = nwg % NXCD, base = (xcd < rem ? xcd * (q + 1) : rem * (q + 1) + (xcd - rem) * q), cnt = (xcd < rem ? q + 1 : q);
        if (off >= cnt) return false;
        const int wgid = base + off;
        const int nig = WGM * nN, gid = wgid / nig, fm = gid * WGM, gsz = (nM - fm) < WGM ? (nM - fm) : WGM;
        u.pm = fm + ((wgid % nig) % gsz); u.pn = (wgid % nig) / gsz; return true;
    }
};
struct S5Order {
    int G, c, c0;
    __device__ bool next(int i, Unit& u) const { const int L = i * G + c - c0; if (c < c0 || L >= 128) return false; u.pm = L; u.pn = L >> 1; return true; }
};
struct SampleOrder {
    int c, c0, n;
    __device__ bool next(int i, Unit& u) const { if (i != 0 || c < c0 || c >= c0 + n) return false; u.pm = 32; u.pn = c - c0; return true; }
};
struct SplitOrder {
    int c, n;
    __device__ bool next(int i, Unit& u) const { if (i != 0 || c >= n) return false; u.pm = 32; u.pn = c & 7; return true; }
};
template <class E, class = void> struct has_mid { static constexpr bool value = false; };
template <class E> struct has_mid<E, decltype((void)E::HAS_MID)> { static constexpr bool value = true; };
template <class Epi, class Sched>
__device__ __forceinline__ void gemm_phase(LAS unsigned char* lds, const int tid_in, const Gemm g, const Sched& S, const Epi& E) {
    int tid = tid_in; asm volatile("" : "+v"(tid));
    const int wid = __builtin_amdgcn_readfirstlane(tid >> 6), lane = tid & 63, wr = wid >> 2, wc = wid & 3, fr = lane & 15, fq = lane >> 4;
    const int K = g.K, nt = K / BK;
    unsigned voffA[2], voffB[2];
#pragma unroll
    for (int i = 0; i < 2; ++i) { int R, C; stage_rc(tid * 16 + i * 8192, R, C); const int Rb = Epi::PERM ? ((R & ~31) + perm32(R & 31)) : R;
        voffA[i] = (unsigned)(R * g.lda + C) * 2u; voffB[i] = (unsigned)(Rb * g.ldb + C) * 2u; }
    const size_t kstep = (size_t)(BK * 2);
    const size_t hstepA = g.a_alias ? (size_t)0 : (size_t)HALF * g.lda * 2, hstepB = (size_t)HALF * g.ldb * 2;
    const size_t tstepA = (size_t)BM * g.lda * 2, tstepB = 2 * hstepB;
    const unsigned ldsw = (unsigned)wid * 1024u;
    const int aoff = lds_byte(wr * 64 + fr, fq * 8), boff = lds_byte(wc * 32 + fr, fq * 8);
    const int aoff1 = lds_byte(wr * 64 + fr, 32 + fq * 8), boff1 = lds_byte(wc * 32 + fr, 32 + fq * 8);
#define PG8_SA(b, h) (((b) * 2 + (h)) * HTB)
#define PG8_SB(b, h) ((4 + (b) * 2 + (h)) * HTB)
#define PG8_STAGE(bufoff, gbase, voff) do { _Pragma("unroll") for (int _i = 0; _i < 2; ++_i) \
        __builtin_amdgcn_global_load_lds((const unsigned*)((const char*)(gbase) + (voff)[_i]), (LAS unsigned*)(lds + (bufoff) + ldsw + _i * 8192), 16, 0, 0); } while (0)
#define PG8_LDA(dst, b, h) do { _Pragma("unroll") for (int m = 0; m < 4; ++m) _Pragma("unroll") for (int k = 0; k < 2; ++k) dst[m][k] = *(const LAS bf16x8*)(lds + PG8_SA(b, h) + (k ? aoff1 : aoff) + m * 2048); } while (0)
#define PG8_LDB(dst, b, h) do { _Pragma("unroll") for (int n = 0; n < 2; ++n) _Pragma("unroll") for (int k = 0; k < 2; ++k) dst[n][k] = *(const LAS bf16x8*)(lds + PG8_SB(b, h) + (k ? boff1 : boff) + n * 2048); } while (0)
#define PG8_MMA(ai, bj, At, Bt) do { __builtin_amdgcn_s_setprio(1); _Pragma("unroll") for (int m = 0; m < 4; ++m) _Pragma("unroll") for (int n = 0; n < 2; ++n) _Pragma("unroll") for (int k = 0; k < 2; ++k) \
        acc[ai][bj][m][n] = __builtin_amdgcn_mfma_f32_16x16x32_bf16(Bt[n][k], At[m][k], acc[ai][bj][m][n], 0, 0, 0); __builtin_amdgcn_s_setprio(0); } while (0)
#define PG8_WAIT_V(n) asm volatile("s_waitcnt vmcnt(" #n ")" ::: "memory")
#define PG8_WAIT_L(n) asm volatile("s_waitcnt lgkmcnt(" #n ")" ::: "memory")
#define PG8_BAR __builtin_amdgcn_s_barrier()
#define PG8_SCHED __builtin_amdgcn_sched_barrier(0)
    Unit cur, nxt; int ui = 0;
    if (!S.next(0, cur)) return;
    f32x4 acc[2][2][4][2];
#pragma unroll
    for (int a = 0; a < 2; ++a)
#pragma unroll
        for (int b = 0; b < 2; ++b)
#pragma unroll
            for (int m = 0; m < 4; ++m)
#pragma unroll
                for (int n = 0; n < 2; ++n) acc[a][b][m][n] = (f32x4){0.f, 0.f, 0.f, 0.f};
    bf16x8 At[4][2], B0[2][2], B1[2][2];
    const char* cA = (const char*)g.A + (size_t)cur.pm * tstepA; const char* cB = (const char*)g.Bt + (size_t)cur.pn * tstepB;
    PG8_STAGE(PG8_SB(0, 0), cB, voffB); PG8_STAGE(PG8_SB(0, 1), cB + hstepB, voffB); PG8_STAGE(PG8_SA(0, 0), cA, voffA); PG8_STAGE(PG8_SA(0, 1), cA + hstepA, voffA);
    if (wr == 1) PG8_BAR;
    PG8_WAIT_V(2); PG8_BAR;
    PG8_STAGE(PG8_SB(1, 0), cB + kstep, voffB); PG8_STAGE(PG8_SA(1, 0), cA + kstep, voffA); PG8_STAGE(PG8_SB(1, 1), cB + hstepB + kstep, voffB);
    PG8_WAIT_V(6); PG8_BAR;
    for (;;) {
        const bool has_next = S.next(ui + 1, nxt);
        const char* nA = has_next ? (const char*)g.A + (size_t)nxt.pm * tstepA : cA; const char* nB = has_next ? (const char*)g.Bt + (size_t)nxt.pn * tstepB : cB;
#pragma unroll 1
        for (int t = 0; t < nt; t += 2) {
            if constexpr (has_mid<Epi>::value) { if (2 * t == nt) E.mid(acc, cur, wr, wc, fr, fq); }
            const bool last = (t == nt - 2);
            const char* a1 = cA + (size_t)(t + 1) * kstep;
            const char* a2 = last ? nA : cA + (size_t)(t + 2) * kstep; const char* b2 = last ? nB : cB + (size_t)(t + 2) * kstep;
            const char* a3 = a2 + kstep; const char* b3 = b2 + kstep;
            PG8_LDB(B0, 0, 0); PG8_LDB(B1, 0, 1); PG8_SCHED; PG8_LDA(At, 0, 0); PG8_STAGE(PG8_SA(1, 1), a1 + hstepA, voffA);
            PG8_WAIT_V(8); PG8_WAIT_L(0); PG8_BAR; PG8_MMA(0, 0, At, B0); PG8_MMA(0, 1, At, B1); PG8_BAR; PG8_SCHED;
            PG8_LDA(At, 0, 1); PG8_STAGE(PG8_SB(0, 0), b2, voffB); PG8_STAGE(PG8_SB(0, 1), b2 + hstepB, voffB); PG8_STAGE(PG8_SA(0, 0), a2, voffA);
            PG8_WAIT_V(8); PG8_WAIT_L(0); PG8_BAR; PG8_MMA(1, 0, At, B0); PG8_MMA(1, 1, At, B1); PG8_BAR; PG8_SCHED;
            PG8_LDB(B0, 1, 0); PG8_LDB(B1, 1, 1); PG8_SCHED; PG8_LDA(At, 1, 0); PG8_STAGE(PG8_SA(0, 1), a2 + hstepA, voffA);
            PG8_WAIT_V(8); PG8_WAIT_L(0); PG8_BAR; PG8_MMA(0, 0, At, B0); PG8_MMA(0, 1, At, B1); PG8_BAR; PG8_SCHED;
            PG8_LDA(At, 1, 1); PG8_STAGE(PG8_SB(1, 0), b3, voffB); PG8_STAGE(PG8_SB(1, 1), b3 + hstepB, voffB); PG8_STAGE(PG8_SA(1, 0), a3, voffA);
            PG8_WAIT_V(8); PG8_WAIT_L(0); PG8_BAR; PG8_MMA(1, 0, At, B0); PG8_MMA(1, 1, At, B1); PG8_BAR; PG8_SCHED;
        }
        if (wr == 0) PG8_BAR;
        E(acc, cur, wr, wc, fr, fq);
        if (!has_next) break;
#pragma unroll
        for (int a = 0; a < 2; ++a)
#pragma unroll
            for (int b = 0; b < 2; ++b)
#pragma unroll
                for (int m = 0; m < 4; ++m)
#pragma unroll
                    for (int n = 0; n < 2; ++n) acc[a][b][m][n] = (f32x4){0.f, 0.f, 0.f, 0.f};
        cur = nxt; cA = nA; cB = nB; ++ui;
        if (wr == 1) PG8_BAR;
    }
    PG8_WAIT_V(0);
    PG8_BAR;
#undef PG8_SA
#undef PG8_SB
#undef PG8_STAGE
#undef PG8_LDA
#undef PG8_LDB
#undef PG8_MMA
#undef PG8_WAIT_V
#undef PG8_WAIT_L
#undef PG8_BAR
#undef PG8_SCHED
}

struct EpiProj {
    static constexpr bool PERM = true;
    bf16_t *QKV, *ZS, *S5A, *S5US, *SGD, *SGS; float* BA; const float* SSQ;
    __device__ __forceinline__ void operator()(const f32x4 (&acc)[2][2][4][2], const Unit& u, int wr, int wc, int fr, int fq) const {
        const int row0 = u.pm * BM + wr * 64 + fr, pn = u.pn, cw = wc * 32 + 8 * fq;
#pragma unroll
        for (int ai = 0; ai < 2; ++ai)
#pragma unroll
            for (int m = 0; m < 4; ++m) {
                const int row = row0 + ai * HALF + m * 16;
                const float rstd = __builtin_amdgcn_rsqf(SSQ[row] * (1.0f / D) + NORM_EPS);
#pragma unroll
                for (int bj = 0; bj < 2; ++bj) {
                    f32x4 v0 = acc[ai][bj][m][0] * rstd, v1 = acc[ai][bj][m][1] * rstd;
                    const int col = pn * BM + bj * HALF + cw;
                    if (pn == 36) {
                        if (col < 9216 + 16) { float* p = BA + (size_t)row * 16 + (col - 9216); *(f32x4*)p = v0; *(f32x4*)(p + 4) = v1; }
                        continue;
                    }
                    bf16_t* dst;
                    if (pn < 12) dst = QKV + (size_t)row * CONVCH + col;
                    else if (pn < 16) { dst = ZS + (size_t)row * 1024 + (col - 3072);
#pragma unroll
                        for (int j = 0; j < 4; ++j) { v0[j] = siluf_(v0[j]); v1[j] = siluf_(v1[j]); } }
                    else if (pn < 20) { const int c = col - 4096, g = c >> 4, cc = c & 15;
                        if (row < NPROMPT) { const int b = row >> 11, t = row & 2047; dst = S5A + ((size_t)(g * 512 + b * 128 + (t >> 4)) * 384 + (t & 15) * 16 + cc); }
                        else dst = S5US + (size_t)(row - NPROMPT) * 1024 + c; }
                    else { dst = (pn < 28) ? SGD + (size_t)row * D + (col - 5120) : SGS + (size_t)row * D + (col - 7168);
#pragma unroll
                        for (int j = 0; j < 4; ++j) { v0[j] = sigmoidf_(v0[j]); v1[j] = sigmoidf_(v1[j]); } }
                    u32x4 w; w.x = cvt_pk_bf16(v0[0], v0[1]); w.y = cvt_pk_bf16(v0[2], v0[3]); w.z = cvt_pk_bf16(v1[0], v1[1]); w.w = cvt_pk_bf16(v1[2], v1[3]);
                    *(u32x4*)dst = w;
                }
            }
    }
};
struct EpiGlu {
    static constexpr bool PERM = true;
    const bf16_t* G5; bf16_t* G5G;
    __device__ __forceinline__ void operator()(const f32x4 (&acc)[2][2][4][2], const Unit& u, int wr, int wc, int fr, int fq) const {
        const int row0 = u.pm * BM + wr * 64 + fr, col0 = u.pn * BM + wc * 32 + 8 * fq;
#pragma unroll
        for (int ai = 0; ai < 2; ++ai)
#pragma unroll
            for (int m = 0; m < 4; ++m) {
                const size_t ro = (size_t)(row0 + ai * HALF + m * 16) * PK1 + col0;
#pragma unroll
                for (int bj = 0; bj < 2; ++bj) {
                    const u32x4 g = *(const u32x4*)(G5 + ro + bj * HALF);
                    const f32x4 a0 = acc[ai][bj][m][0], a1 = acc[ai][bj][m][1];
                    u32x4 w;
                    w.x = cvt_pk_bf16(bflo(g.x) * sigmoidf_(a0[0]), bfhi(g.x) * sigmoidf_(a0[1]));
                    w.y = cvt_pk_bf16(bflo(g.y) * sigmoidf_(a0[2]), bfhi(g.y) * sigmoidf_(a0[3]));
                    w.z = cvt_pk_bf16(bflo(g.z) * sigmoidf_(a1[0]), bfhi(g.z) * sigmoidf_(a1[1]));
                    w.w = cvt_pk_bf16(bflo(g.w) * sigmoidf_(a1[2]), bfhi(g.w) * sigmoidf_(a1[3]));
                    *(u32x4*)(G5G + (size_t)(row0 + ai * HALF + m * 16) * PK2 + 1024 + col0 + bj * HALF) = w;
                }
            }
    }
};
struct EpiBrM {
    static constexpr bool PERM = true, HAS_MID = true;
    const bf16_t *SGD, *SGS; bf16_t* MERGED;
    __device__ __forceinline__ void mid(f32x4 (&acc)[2][2][4][2], const Unit& u, int wr, int wc, int fr, int fq) const {
        int row0 = u.pm * BM + wr * 64 + fr, col0 = u.pn * BM + wc * 32 + 8 * fq;
        asm volatile("" : "+v"(row0), "+v"(col0));
#pragma unroll
        for (int ai = 0; ai < 2; ++ai)
#pragma unroll
            for (int m2 = 0; m2 < 2; ++m2) {
                u32x4 gdv[2][2], gsv[2][2];
#pragma unroll
                for (int mm = 0; mm < 2; ++mm) { const size_t ro = (size_t)(row0 + ai * HALF + (2 * m2 + mm) * 16) * D + col0;
#pragma unroll
                    for (int bj = 0; bj < 2; ++bj) { gdv[mm][bj] = *(const u32x4*)(SGD + ro + bj * HALF); gsv[mm][bj] = *(const u32x4*)(SGS + ro + bj * HALF); } }
#pragma unroll
                for (int mm = 0; mm < 2; ++mm) { const int m = 2 * m2 + mm;
#pragma unroll
                    for (int bj = 0; bj < 2; ++bj) {
                        const u32x4 gd = gdv[mm][bj], gs = gsv[mm][bj];
                        const unsigned dw[4] = {gd.x, gd.y, gd.z, gd.w}, sw[4] = {gs.x, gs.y, gs.z, gs.w};
#pragma unroll
                        for (int j = 0; j < 4; ++j) {
                            const float r0 = bflo(dw[j]) * __builtin_amdgcn_rcpf(fmaxf(bflo(sw[j]), 9.5367431640625e-07f)), r1 = bfhi(dw[j]) * __builtin_amdgcn_rcpf(fmaxf(bfhi(sw[j]), 9.5367431640625e-07f));
                            acc[ai][bj][m][j >> 1][2 * (j & 1)] *= r0; acc[ai][bj][m][j >> 1][2 * (j & 1) + 1] *= r1; }
                    } }
                asm volatile("" ::: "memory");
            }
    }
    __device__ __forceinline__ void operator()(const f32x4 (&acc)[2][2][4][2], const Unit& u, int wr, int wc, int fr, int fq) const {
        const int row0 = u.pm * BM + wr * 64 + fr, col0 = u.pn * BM + wc * 32 + 8 * fq;
#pragma unroll
        for (int ai = 0; ai < 2; ++ai) {
            u32x4 gv[4][2];
#pragma unroll
            for (int m = 0; m < 4; ++m)
#pragma unroll
                for (int bj = 0; bj < 2; ++bj) gv[m][bj] = *(const u32x4*)(SGS + (size_t)(row0 + ai * HALF + m * 16) * D + col0 + bj * HALF);
#pragma unroll
            for (int m = 0; m < 4; ++m) {
                const size_t ro = (size_t)(row0 + ai * HALF + m * 16) * PK2 + col0;
#pragma unroll
                for (int bj = 0; bj < 2; ++bj) {
                    const u32x4 g = gv[m][bj];
                    const f32x4 a0 = acc[ai][bj][m][0], a1 = acc[ai][bj][m][1];
                    const float c = 9.5367431640625e-07f;
                    u32x4 w; w.x = cvt_pk_bf16(fmaxf(bflo(g.x), c) * a0[0], fmaxf(bfhi(g.x), c) * a0[1]); w.y = cvt_pk_bf16(fmaxf(bflo(g.y), c) * a0[2], fmaxf(bfhi(g.y), c) * a0[3]);
                    w.z = cvt_pk_bf16(fmaxf(bflo(g.z), c) * a1[0], fmaxf(bfhi(g.z), c) * a1[1]); w.w = cvt_pk_bf16(fmaxf(bflo(g.w), c) * a1[2], fmaxf(bfhi(g.w), c) * a1[3]);
                    *(u32x4*)(MERGED + ro + bj * HALF) = w;
                }
            }
            asm volatile("" ::: "memory");
        }
    }
};
struct EpiGate {
    static constexpr bool PERM = true;
    const bf16_t* GATE; bf16_t* OUT;
    __device__ __forceinline__ void operator()(const f32x4 (&acc)[2][2][4][2], const Unit& u, int wr, int wc, int fr, int fq) const {
        const int row0 = u.pm * BM + wr * 64 + fr, col0 = u.pn * BM + wc * 32 + 8 * fq;
#pragma unroll
        for (int ai = 0; ai < 2; ++ai)
#pragma unroll
            for (int m = 0; m < 4; ++m) {
                const size_t ro = (size_t)(row0 + ai * HALF + m * 16) * D + col0, rp = (size_t)(row0 + ai * HALF + m * 16) * PK2 + col0;
#pragma unroll
                for (int bj = 0; bj < 2; ++bj) {
                    const u32x4 g = *(const u32x4*)(GATE + ro + bj * HALF);
                    const f32x4 a0 = acc[ai][bj][m][0], a1 = acc[ai][bj][m][1];
                    u32x4 w; w.x = cvt_pk_bf16(bflo(g.x) * a0[0], bfhi(g.x) * a0[1]); w.y = cvt_pk_bf16(bflo(g.y) * a0[2], bfhi(g.y) * a0[3]);
                    w.z = cvt_pk_bf16(bflo(g.z) * a1[0], bfhi(g.z) * a1[1]); w.w = cvt_pk_bf16(bflo(g.w) * a1[2], bfhi(g.w) * a1[3]);
                    *(u32x4*)(OUT + rp + bj * HALF) = w;
                }
                asm volatile("" ::: "memory");
            }
    }
};
struct EpiRes {
    static constexpr bool PERM = false;
    const float* XP; const float* XS;
    float* X; bf16_t* XB; float* SSQ;
    __device__ __forceinline__ void operator()(const f32x4 (&acc)[2][2][4][2], const Unit& u, int wr, int wc, int fr, int fq) const {
        const int row0 = u.pm * BM + wr * 64 + fr, col0 = u.pn * BM + wc * 32 + 4 * fq;
#pragma unroll
        for (int ai = 0; ai < 2; ++ai) {
            f32x4 xv[4][2][2];
#pragma unroll
            for (int m = 0; m < 4; ++m) { const int row = row0 + ai * HALF + m * 16;
                const float* xo = (row < NPROMPT ? XP + (size_t)row * D : XS + (size_t)(row - NPROMPT) * D) + col0;
#pragma unroll
                for (int bj = 0; bj < 2; ++bj)
#pragma unroll
                    for (int n = 0; n < 2; ++n) xv[m][bj][n] = (row < MR) ? *(const f32x4*)(xo + bj * HALF + n * 16) : (f32x4){0.f, 0.f, 0.f, 0.f}; }
#pragma unroll
            for (int m = 0; m < 4; ++m) {
                const int row = row0 + ai * HALF + m * 16;
                float ss = 0.f;
                if (row < MR) {
                    float* xn = X + (size_t)row * D + col0; bf16_t* xb = XB + (size_t)row * PK2 + col0;
#pragma unroll
                    for (int bj = 0; bj < 2; ++bj)
#pragma unroll
                        for (int n = 0; n < 2; ++n) {
                            const f32x4 v = xv[m][bj][n] + acc[ai][bj][m][n];
                            *(f32x4*)(xn + bj * HALF + n * 16) = v;
                            u32x2 w; w.x = cvt_pk_bf16(v[0], v[1]); w.y = cvt_pk_bf16(v[2], v[3]);
                            *(u32x2*)(xb + bj * HALF + n * 16) = w;
                            ss += (v[0] * v[0] + v[1] * v[1]) + (v[2] * v[2] + v[3] * v[3]);
                        }
                }
                ss += __shfl_xor(ss, 16); ss += __shfl_xor(ss, 32);
                if (fq == 0 && row < MR) atomicAdd(SSQ + row, ss);
            }
            asm volatile("" ::: "memory");
        }
    }
};
struct EpiGU {
    static constexpr bool PERM = true;
    bf16_t* ACT; const float* SSQ;
    __device__ __forceinline__ void operator()(const f32x4 (&acc)[2][2][4][2], const Unit& u, int wr, int wc, int fr, int fq) const {
        const int row0 = u.pm * BM + wr * 64 + fr, col0 = u.pn * HALF + wc * 32 + 8 * fq;
#pragma unroll
        for (int ai = 0; ai < 2; ++ai)
#pragma unroll
            for (int m = 0; m < 4; ++m) {
                const int row = row0 + ai * HALF + m * 16;
                const float rstd = __builtin_amdgcn_rsqf(SSQ[row] * (1.0f / D) + NORM_EPS);
                float r[8];
#pragma unroll
                for (int n = 0; n < 2; ++n)
#pragma unroll
                    for (int j = 0; j < 4; ++j) r[n * 4 + j] = siluf_(acc[ai][0][m][n][j] * rstd) * (acc[ai][1][m][n][j] * rstd);
                u32x4 w; w.x = cvt_pk_bf16(r[0], r[1]); w.y = cvt_pk_bf16(r[2], r[3]); w.z = cvt_pk_bf16(r[4], r[5]); w.w = cvt_pk_bf16(r[6], r[7]);
                *(u32x4*)(ACT + (size_t)row * PK5 + col0) = w;
            }
    }
};
struct EpiPart {
    static constexpr bool PERM = false;
    float* P;
    __device__ __forceinline__ void operator()(const f32x4 (&acc)[2][2][4][2], const Unit& u, int wr, int wc, int fr, int fq) const {
        const int row0 = wr * 64 + fr, col0 = u.pn * BM + wc * 32 + 4 * fq;
#pragma unroll
        for (int m = 0; m < 4; ++m) { float* p = P + (size_t)(row0 + m * 16) * D + col0;
#pragma unroll
            for (int bj = 0; bj < 2; ++bj)
#pragma unroll
                for (int n = 0; n < 2; ++n) *(f32x4*)(p + bj * HALF + n * 16) = acc[0][bj][m][n]; }
    }
};
struct EpiS5L {
    static constexpr bool PERM = false;
    float* L;
    __device__ __forceinline__ void operator()(const f32x4 (&acc)[2][2][4][2], const Unit& u, int wr, int wc, int fr, int fq) const {
        const int row0 = u.pm * BM + wr * 64 + fr, col0 = wc * 32 + 4 * fq;
#pragma unroll
        for (int ai = 0; ai < 2; ++ai)
#pragma unroll
            for (int m = 0; m < 4; ++m) { float* p = L + (size_t)(row0 + ai * HALF + m * 16) * 128 + col0;
#pragma unroll
                for (int n = 0; n < 2; ++n) *(f32x4*)(p + n * 16) = acc[ai][0][m][n]; }
    }
};
struct EpiS5Y {
    static constexpr bool PERM = true;
    bf16_t* G5;
    __device__ __forceinline__ void operator()(const f32x4 (&acc)[2][2][4][2], const Unit& u, int wr, int wc, int fr, int fq) const {
        const int g = u.pm >> 1, cbase = 64 * wr + fr, t0 = 2 * wc + (fq >> 1), c0 = 8 * (fq & 1);
#pragma unroll
        for (int ai = 0; ai < 2; ++ai) {
            const int b = 2 * (u.pm & 1) + ai;
#pragma unroll
            for (int m = 0; m < 4; ++m) {
                bf16_t* p = G5 + (size_t)(b * SEQ + (cbase + 16 * m) * 16 + t0) * PK1 + g * 16 + c0;
#pragma unroll
                for (int bj = 0; bj < 2; ++bj) {
                    const f32x4 a0 = acc[ai][bj][m][0], a1 = acc[ai][bj][m][1];
                    u32x4 w; w.x = cvt_pk_bf16(geluf_(a0[0]), geluf_(a0[1])); w.y = cvt_pk_bf16(geluf_(a0[2]), geluf_(a0[3]));
                    w.z = cvt_pk_bf16(geluf_(a1[0]), geluf_(a1[1])); w.w = cvt_pk_bf16(geluf_(a1[2]), geluf_(a1[3]));
                    *(u32x4*)(p + (size_t)(8 * bj) * PK1) = w;
                }
                asm volatile("" ::: "memory");
            }
        }
    }
};
}

struct Args {
    const float* in[29];
    float* out; unsigned char* ws;
    int ph_lo, ph_hi, use_bar, pad;
};
enum { I_XP = 0, I_XS, I_SCONV, I_SSSM, I_S5RE, I_S5IM, I_N1, I_WIN, I_CONVW, I_ALOG, I_DTB, I_DNNW, I_WBRDN, I_LRE, I_LIM, I_LDT, I_BRE, I_BIM, I_CRE, I_CIM, I_DS, I_WGLU, I_WBRS5, I_WOUT, I_N2, I_WG, I_WU, I_WD, I_NF };
constexpr size_t O_YP = 0, O_YS = 16777216, O_PCONV = 17039360, O_PSSM = 17113088, O_PS5RE = 18161664, O_PS5IM = 18194432, O_SCONV = 18227200, O_SSSM = 20586496, O_SS5RE = 54140928, O_SS5IM = 55189504, O_END = 56238080;

typedef const __attribute__((address_space(4))) Args CArgs;
struct Frame {
    LAS unsigned char* lds;
    int tid, lane, wave, G, bx, vb;
    unsigned char* ws; float* out;
};

__device__ __forceinline__ void p0_transpose_item(const float* W, int ldw, int src, int nvalid, const float* scale, bf16_t* WT, int ldt, int nrow0, int k0, LAS float* scr, int lane) {
    const int l16 = lane & 15, r4 = lane >> 4;
    f32x4 v[16];
    const bool ok = (4 * l16 < nvalid);
#pragma unroll
    for (int i = 0; i < 16; ++i) v[i] = ok ? __builtin_nontemporal_load((const f32x4*)(W + (size_t)(k0 + 4 * i + r4) * ldw + src + 4 * l16)) : (f32x4){0.f, 0.f, 0.f, 0.f};
#pragma unroll
    for (int i = 0; i < 16; ++i) { const int kk = 4 * i + r4; f32x4 x = v[i]; if (scale) x = x * scale[k0 + kk];
        LAS float* s = scr + kk * 65 + 4 * l16; s[0] = x[0]; s[1] = x[1]; s[2] = x[2]; s[3] = x[3]; }
    LDS_WAIT(); asm volatile("" ::: "memory");
    const int c = lane & 7;
#pragma unroll
    for (int j = 0; j < 8; ++j) { const int n = (lane >> 3) + 8 * j; const LAS float* s = scr + (8 * c) * 65 + n;
        u32x4 o; o.x = cvt_pk_bf16(s[0 * 65], s[1 * 65]); o.y = cvt_pk_bf16(s[2 * 65], s[3 * 65]); o.z = cvt_pk_bf16(s[4 * 65], s[5 * 65]); o.w = cvt_pk_bf16(s[6 * 65], s[7 * 65]);
        *(u32x4*)(WT + (size_t)(nrow0 + n) * ldt + k0 + 8 * c) = o; }
    LDS_WAIT(); asm volatile("" ::: "memory");
}

__device__ __forceinline__ void p0_s5_precompute(const Frame& F, const CArgs& a, int l, int g) {
    LAS float* apr = (LAS float*)F.lds;
    LAS float* api = apr + 17 * 64;
    LAS float* bbr = api + 17 * 64;
    LAS float* bbi = bbr + 1024;
    LAS float* cre = bbi + 1024;
    LAS float* cim = cre + 1024;
    LAS float* kt = cim + 1024;
    const int tid = F.tid;
    __syncthreads();
    if (tid < 64) {
        const int p = tid;
        const float dt = expf(a.in[I_LDT][l * 64 + g]);
        const float lr = a.in[I_LRE][(l * 64 + g) * 64 + p], li = a.in[I_LIM][(l * 64 + g) * 64 + p];
        for (int d = 0; d <= 16; ++d) { const float mag = expf(lr * dt * (float)d), ang = li * dt * (float)d; apr[d * 64 + p] = mag * cosf(ang); api[d * 64 + p] = mag * sinf(ang); }
        const float ar = apr[64 + p], ai = api[64 + p], nr = ar - 1.0f, den = lr * lr + li * li;
        const float fr = (nr * lr + ai * li) / den, fi = (ai * lr - nr * li) / den;
        float* bb = (float*)(F.ws + WS_BBAR) + ((size_t)(l * 64 + g) * 64 + p) * 32;
        for (int c = 0; c < 16; ++c) { const float br = a.in[I_BRE][((size_t)(l * 64 + g) * 64 + p) * 16 + c], bi = a.in[I_BIM][((size_t)(l * 64 + g) * 64 + p) * 16 + c];
            const float xr = fr * br - fi * bi, xi = fr * bi + fi * br; bbr[p * 16 + c] = xr; bbi[p * 16 + c] = xi; bb[c] = xr; bb[16 + c] = xi; }
        float* a16 = (float*)(F.ws + WS_A16) + ((size_t)(l * 64 + g) * 64 + p) * 2;
        a16[0] = apr[16 * 64 + p]; a16[1] = api[16 * 64 + p];
    }
    for (int i = tid; i < 1024; i += 512) { cre[i] = a.in[I_CRE][(size_t)(l * 64 + g) * 1024 + i]; cim[i] = a.in[I_CIM][(size_t)(l * 64 + g) * 1024 + i]; }
    __syncthreads();
    for (int e = tid; e < 4096; e += 512) { const int d = e >> 8, c = (e >> 4) & 15, cc = e & 15; float s = 0.f;
        for (int p = 0; p < 64; ++p) { const float pr = apr[d * 64 + p], pi = api[d * 64 + p], br = bbr[p * 16 + cc], bi = bbi[p * 16 + cc];
            const float gr = pr * br - pi * bi, gi = pr * bi + pi * br; s += cre[c * 64 + p] * gr - cim[c * 64 + p] * gi; }
        if (d == 0 && c == cc) s += a.in[I_DS][l * 1024 + g * 16 + c];
        kt[e] = s; }
    __syncthreads();
    bf16_t* bty = (bf16_t*)(F.ws + WS_W0 + l * WS_WSTRIDE + WO_BTY) + (size_t)g * 256 * 384;
    for (int ch = tid; ch < 256 * 48; ch += 512) {
        const int row = ch / 48, c8 = (ch % 48) * 8, t = row >> 4, c = row & 15; float v[8];
#pragma unroll
        for (int j = 0; j < 8; ++j) { const int col = c8 + j;
            if (col < 256) { const int s = col >> 4, cc = col & 15; v[j] = (s <= t) ? kt[((t - s) * 16 + c) * 16 + cc] : 0.f; }
            else if (col < 320) { const int p = col - 256; v[j] = cre[c * 64 + p] * apr[(t + 1) * 64 + p] - cim[c * 64 + p] * api[(t + 1) * 64 + p]; }
            else { const int p = col - 320; v[j] = -(cre[c * 64 + p] * api[(t + 1) * 64 + p] + cim[c * 64 + p] * apr[(t + 1) * 64 + p]); } }
        u32x4 o; o.x = pk2(v[0], v[1]); o.y = pk2(v[2], v[3]); o.z = pk2(v[4], v[5]); o.w = pk2(v[6], v[7]);
        *(u32x4*)(bty + (size_t)row * 384 + c8) = o; }
    bf16_t* btl = (bf16_t*)(F.ws + WS_W0 + l * WS_WSTRIDE + WO_BTL) + (size_t)g * 256 * 256;
    for (int ch = tid; ch < 256 * 32; ch += 512) {
        const int row = ch >> 5, c8 = (ch & 31) * 8; float v[8];
#pragma unroll
        for (int j = 0; j < 8; ++j) { const int col = c8 + j, s = col >> 4, cc = col & 15;
            if (row < 128) { const int p = row & 63, d = 15 - s; const float pr = apr[d * 64 + p], pi = api[d * 64 + p], br = bbr[p * 16 + cc], bi = bbi[p * 16 + cc];
                v[j] = (row < 64) ? (pr * br - pi * bi) : (pr * bi + pi * br); }
            else v[j] = 0.f; }
        u32x4 o; o.x = pk2(v[0], v[1]); o.y = pk2(v[2], v[3]); o.z = pk2(v[4], v[5]); o.w = pk2(v[6], v[7]);
        *(u32x4*)(btl + (size_t)row * 256 + c8) = o; }
    __syncthreads();
}

constexpr int P0_I0 = 32 * 145, P0_I1 = 16 * 32, P0_I2 = 16 * 16, P0_I3 = 16 * 32, P0_I4 = 32 * 32, P0_I5 = 32 * 176, P0_I6 = 88 * 32, P0_IL = P0_I0 + P0_I1 + P0_I2 + P0_I3 + P0_I4 + P0_I5 + P0_I6;
__device__ __forceinline__ void p0_item(const Frame& F, const CArgs& a, int it, LAS float* scr) {
    const int l = it / P0_IL; int r = it % P0_IL;
    unsigned char* wb = F.ws + WS_W0 + l * WS_WSTRIDE;
    if (r < P0_I0) { const int kb = r / 145, nb = r % 145, n0 = nb * 64; int src, nv = 64;
        if (n0 < 4096) src = n0; else if (n0 < 9216) src = n0 + 16; else { src = 4096; nv = 16; }
        p0_transpose_item(a.in[I_WIN] + (size_t)l * D * IN_DIM, IN_DIM, src, nv, a.in[I_N1] + l * D, (bf16_t*)(wb + WO_IN), PK2, n0, kb * 64, scr, F.lane); return; } r -= P0_I0;
    if (r < P0_I1) { const int kb = r / 32, nb = r % 32; p0_transpose_item(a.in[I_WBRDN] + (size_t)l * 1024 * D, D, nb * 64, 64, nullptr, (bf16_t*)(wb + WO_BRDN), PK2, nb * 64, kb * 64, scr, F.lane); return; } r -= P0_I1;
    if (r < P0_I2) { const int kb = r / 16, nb = r % 16; p0_transpose_item(a.in[I_WGLU] + (size_t)l * 1024 * 1024, 1024, nb * 64, 64, nullptr, (bf16_t*)(wb + WO_GLU), PK1, nb * 64, kb * 64, scr, F.lane); return; } r -= P0_I2;
    if (r < P0_I3) { const int kb = r / 32, nb = r % 32; p0_transpose_item(a.in[I_WBRS5] + (size_t)l * 1024 * D, D, nb * 64, 64, nullptr, (bf16_t*)(wb + WO_BRDN) + 1024, PK2, nb * 64, kb * 64, scr, F.lane); return; } r -= P0_I3;
    if (r < P0_I4) { const int kb = r / 32, nb = r % 32; p0_transpose_item(a.in[I_WOUT] + (size_t)l * D * D, D, nb * 64, 64, nullptr, (bf16_t*)(wb + WO_OUT), PK2, nb * 64, kb * 64, scr, F.lane); return; } r -= P0_I4;
    if (r < P0_I5) { const int kb = r / 176, nb = r % 176, n0 = nb * 64, tile = n0 >> 8, j = n0 & 255;
        const float* W = (j < 128 ? a.in[I_WG] : a.in[I_WU]) + (size_t)l * D * FF;
        p0_transpose_item(W, FF, tile * 128 + (j & 127), 64, a.in[I_N2] + l * D, (bf16_t*)(wb + WO_GU), PK2, n0, kb * 64, scr, F.lane); return; } r -= P0_I5;
    { const int kb = r / 32, nb = r % 32; p0_transpose_item(a.in[I_WD] + (size_t)l * FF * D, D, nb * 64, 64, nullptr, (bf16_t*)(wb + WO_D), PK5, nb * 64, kb * 64, scr, F.lane); }
}
__device__ __forceinline__ void convert_pull(const Frame& F, const CArgs& a, int npulls) {
    volatile LAS unsigned* MISC = (volatile LAS unsigned*)(F.lds + MISC_OFF);
    LAS float* scr = (LAS float*)(F.lds + F.wave * 16640);
    unsigned* qhead = (unsigned*)(F.ws + WS_CTL) + 12288;
    for (int p = 0; p < npulls; ++p) {
        __syncthreads();
        if (F.tid == 0) MISC[16] = xb_add(qhead, 8u);
        __syncthreads();
        const int base = __builtin_amdgcn_readfirstlane((int)MISC[16]);
        if (base >= P0_IL) break;
        if (base + F.wave < P0_IL) p0_item(F, a, P0_IL + base + F.wave, scr);
    }
    __syncthreads();
}
__device__ __forceinline__ void p0_prologue(const Frame& F, const CArgs& a) {
    if (F.bx < 128) p0_s5_precompute(F, a, F.bx >> 6, F.bx & 63);
    __syncthreads();
    LAS float* scr = (LAS float*)(F.lds + F.wave * 16640);
    const int gw = F.bx * 8 + F.wave, NGW = F.G * 8;
    for (int it = gw; it < P0_IL; it += NGW) p0_item(F, a, it, scr);
    const int gt = F.bx * 512 + F.tid, NGT = F.G * 512;
    for (int l = 0; l < 2; ++l) { u32x4* z = (u32x4*)(F.ws + WS_W0 + l * WS_WSTRIDE + WO_IN + (size_t)9280 * PK2 * 2);
        for (int i = gt; i < 192 * PK2 * 2 / 16; i += NGT) z[i] = (u32x4){0u, 0u, 0u, 0u}; }
    { float* s = (float*)(F.ws + WS_SSQ) + MP; for (int i = gt; i < 4 * MP; i += NGT) s[i] = 0.f; }
    float* ssq0 = (float*)(F.ws + WS_SSQ); bf16_t* XB = (bf16_t*)(F.ws + WS_XB);
    for (int m = gw; m < MR; m += NGW) {
        const float* xr = (m < NPROMPT) ? a.in[I_XP] + (size_t)m * D : a.in[I_XS] + (size_t)(m - NPROMPT) * D;
        const f32x4* x4 = (const f32x4*)xr + F.lane; u32x2* o = (u32x2*)(XB + (size_t)m * PK2) + F.lane; float s = 0.f;
#pragma unroll
        for (int j = 0; j < 8; ++j) { const f32x4 v = x4[64 * j]; s += (v[0] * v[0] + v[1] * v[1]) + (v[2] * v[2] + v[3] * v[3]);
            u32x2 w; w.x = pk2(v[0], v[1]); w.y = pk2(v[2], v[3]); o[64 * j] = w; }
        s = wave_sum(s); if (F.lane == 0) ssq0[m] = s;
    }
}


__device__ __forceinline__ void conv_state_out(const Frame& F, const CArgs& a, int l) {
    const int gt = (F.bx - 128) * 512 + F.tid, NGT = 124 * 512;
    const bf16_t* QKV = (const bf16_t*)(F.ws + WS_QKV);
    float* pc = F.out + O_PCONV + (size_t)l * NB * 3 * CONVCH;
    for (int i = gt; i < NB * 3 * CONVCH; i += NGT) { const int ch = i % CONVCH, j = (i / CONVCH) % 3, b = i / (3 * CONVCH);
        pc[i] = bf2f(QKV[(size_t)(b * SEQ + SEQ - 3 + j) * CONVCH + ch]); }
    float* sc = F.out + O_SCONV + (size_t)l * NSAMP * 3 * CONVCH; const float* st = a.in[I_SCONV] + (size_t)l * NSAMP * 3 * CONVCH;
    for (int i = gt; i < NSAMP * 3 * CONVCH; i += NGT) { const int ch = i % CONVCH, j = (i / CONVCH) % 3, b = i / (3 * CONVCH);
        sc[i] = (j < 2) ? st[i + CONVCH] : bf2f(QKV[(size_t)(NPROMPT + b) * CONVCH + ch]); }
}


__device__ __forceinline__ void delta_seq(const Frame& F, const CArgs& a, int l, int h, int r0, int L, const float* conv0, const float* ssm0, float* ssm_out) {
    LAS float* raw = (LAS float*)F.lds;
    LAS float* qk = raw + 384;
    LAS float* part = qk + 256;
    LAS float* red = part + 512;
    const int tid = F.tid, lane = F.lane, wave = F.wave, dv = tid & 127, kg = tid >> 7;
    const bf16_t* QKV = (const bf16_t*)(F.ws + WS_QKV); const float* BA = (const float*)(F.ws + WS_BA); const bf16_t* ZS = (const bf16_t*)(F.ws + WS_ZS); bf16_t* ON = (bf16_t*)(F.ws + WS_ONG);
    const int ch = (tid < 384) ? ((tid >> 7) * 1024 + h * 128 + (tid & 127)) : 0;
    const float* cw = a.in[I_CONVW] + (size_t)l * 4 * CONVCH;
    const float cw0 = cw[ch], cw1 = cw[CONVCH + ch], cw2 = cw[2 * CONVCH + ch], cw3 = cw[3 * CONVCH + ch];
    float w0 = conv0 ? conv0[ch] : 0.f, w1 = conv0 ? conv0[CONVCH + ch] : 0.f, w2 = conv0 ? conv0[2 * CONVCH + ch] : 0.f;
    float s[32];
#pragma unroll
    for (int i = 0; i < 32; ++i) s[i] = ssm0 ? ssm0[(size_t)(kg * 32 + i) * 128 + dv] : 0.f;
    const float Aexp = expf(a.in[I_ALOG][l * NH + h]), dtb = a.in[I_DTB][l * NH + h], nw = a.in[I_DNNW][l * 128 + dv];
    __syncthreads();
    for (int t = 0; t < L; ++t) {
        const int r = r0 + t;
        if (tid < 384) { const float x = bf2f(QKV[(size_t)r * CONVCH + ch]); const float y = cw0 * w0 + cw1 * w1 + cw2 * w2 + cw3 * x; w0 = w1; w1 = w2; w2 = x; raw[tid] = siluf_(y); }
        __syncthreads();
        if (wave < 2) { const float v0 = raw[wave * 128 + lane], v1 = raw[wave * 128 + 64 + lane]; const float ss = wave_sum(v0 * v0 + v1 * v1);
            const float rs = (__builtin_amdgcn_rsqf(ss + 1e-6f)) * (wave == 0 ? 0.08838834764831845f : 1.0f); qk[wave * 128 + lane] = v0 * rs; qk[wave * 128 + 64 + lane] = v1 * rs; }
        __syncthreads();
        const float beta = sigmoidf_(BA[(size_t)r * 16 + h]), gg = -Aexp * softplusf_(BA[(size_t)r * 16 + 8 + h] + dtb), dec = expf(gg);
        float ks = 0.f;
#pragma unroll
        for (int i = 0; i < 32; ++i) { s[i] *= dec; ks += qk[128 + kg * 32 + i] * s[i]; }
        part[kg * 128 + dv] = ks;
        __syncthreads();
        const float vnew = (raw[256 + dv] - ((part[dv] + part[128 + dv]) + (part[256 + dv] + part[384 + dv]))) * beta;
        __syncthreads();
        float op = 0.f;
#pragma unroll
        for (int i = 0; i < 32; ++i) { s[i] += qk[128 + kg * 32 + i] * vnew; op += qk[kg * 32 + i] * s[i]; }
        part[kg * 128 + dv] = op;
        __syncthreads();
        const float o = (part[dv] + part[128 + dv]) + (part[256 + dv] + part[384 + dv]);
        const float ss = wave_sum(o * o); if (lane == 0) red[wave] = ss;
        __syncthreads();
        if (tid < 128) { const float rstd = __builtin_amdgcn_rsqf((red[0] + red[1]) * (1.0f / 128.0f) + NORM_EPS);
            const float z = bf2f(ZS[(size_t)r * 1024 + h * 128 + dv]); ON[(size_t)r * PK2 + h * 128 + dv] = (bf16_t)f2bf(o * rstd * nw * z); }
    }
#pragma unroll
    for (int i = 0; i < 32; ++i) ssm_out[(size_t)(kg * 32 + i) * 128 + dv] = s[i];
    __syncthreads();
}
__device__ __forceinline__ void s5_seq(const Frame& F, const CArgs& a, int l, int g, int b, bool sample, int L, const float* x0re, const float* x0im, float* ore, float* oim) {
    const int p = F.lane;
    const float dt = expf(a.in[I_LDT][l * 64 + g]);
    const float lr = a.in[I_LRE][(l * 64 + g) * 64 + p], li = a.in[I_LIM][(l * 64 + g) * 64 + p];
    const float mag = expf(lr * dt), ar = mag * cosf(li * dt), ai = mag * sinf(li * dt);
    const float* bb = (const float*)(F.ws + WS_BBAR) + ((size_t)(l * 64 + g) * 64 + p) * 32;
    float br[16], bi[16], cr[16], ci[16];
#pragma unroll
    for (int c = 0; c < 16; ++c) { br[c] = bb[c]; bi[c] = bb[16 + c]; cr[c] = a.in[I_CRE][((size_t)(l * 64 + g) * 16 + c) * 64 + p]; ci[c] = a.in[I_CIM][((size_t)(l * 64 + g) * 16 + c) * 64 + p]; }
    const float dsk = a.in[I_DS][l * 1024 + g * 16 + (p & 15)];
    float xr = x0re ? x0re[p] : 0.f, xi = x0im ? x0im[p] : 0.f;
    const bf16_t* S5A = (const bf16_t*)(F.ws + WS_S5A); const bf16_t* S5US = (const bf16_t*)(F.ws + WS_S5US); bf16_t* G5 = (bf16_t*)(F.ws + WS_G5);
    for (int t = 0; t < L; ++t) {
        const bf16_t* up = sample ? S5US + (size_t)b * 1024 + g * 16 : S5A + ((size_t)(g * 512 + b * 128 + (t >> 4)) * 384 + (t & 15) * 16);
        const u32x4 u0 = *(const u32x4*)up, u1 = *(const u32x4*)(up + 8);
        const float u[16] = {bflo(u0.x), bfhi(u0.x), bflo(u0.y), bfhi(u0.y), bflo(u0.z), bfhi(u0.z), bflo(u0.w), bfhi(u0.w), bflo(u1.x), bfhi(u1.x), bflo(u1.y), bfhi(u1.y), bflo(u1.z), bfhi(u1.z), bflo(u1.w), bfhi(u1.w)};
        float bur = 0.f, bui = 0.f;
#pragma unroll
        for (int c = 0; c < 16; ++c) { bur += br[c] * u[c]; bui += bi[c] * u[c]; }
        const float nxr = ar * xr - ai * xi + bur, nxi = ar * xi + ai * xr + bui; xr = nxr; xi = nxi;
        float y = 0.f, um = 0.f;
#pragma unroll
        for (int c = 0; c < 16; ++c) { const float v = wave_sum(cr[c] * xr - ci[c] * xi); if (p == c) { y = v; um = u[c]; } }
        if (p < 16) { y += dsk * um; const size_t row = sample ? (size_t)(NPROMPT + b) : (size_t)(b * SEQ + t); G5[row * PK1 + g * 16 + p] = (bf16_t)f2bf(geluf_(y)); }
    }
    ore[p] = xr; oim[p] = xi;
}


__device__ __forceinline__ void s5_sample_wave(const Frame& F, const CArgs& a, int l, int g, int b0) {
    const int p = F.lane;
    const float dt = expf(a.in[I_LDT][l * 64 + g]);
    const float lr = a.in[I_LRE][(l * 64 + g) * 64 + p], li = a.in[I_LIM][(l * 64 + g) * 64 + p];
    const float mag = expf(lr * dt), ar = mag * cosf(li * dt), ai = mag * sinf(li * dt);
    const float* bb = (const float*)(F.ws + WS_BBAR) + ((size_t)(l * 64 + g) * 64 + p) * 32;
    float br[16], bi[16], cr[16], ci[16];
#pragma unroll
    for (int c = 0; c < 16; ++c) { br[c] = bb[c]; bi[c] = bb[16 + c]; cr[c] = a.in[I_CRE][((size_t)(l * 64 + g) * 16 + c) * 64 + p]; ci[c] = a.in[I_CIM][((size_t)(l * 64 + g) * 16 + c) * 64 + p]; }
    const float dsk = a.in[I_DS][l * 1024 + g * 16 + (p & 15)];
    const bf16_t* S5US = (const bf16_t*)(F.ws + WS_S5US); bf16_t* G5 = (bf16_t*)(F.ws + WS_G5);
    float x0r[4], x0i[4]; u32x4 uu[4][2];
#pragma unroll
    for (int k = 0; k < 4; ++k) { const int b = b0 + 32 * k; const size_t so = ((size_t)(l * NSAMP + b) * 64 + g) * 64;
        x0r[k] = a.in[I_S5RE][so + p]; x0i[k] = a.in[I_S5IM][so + p];
        const bf16_t* up = S5US + (size_t)b * 1024 + g * 16; uu[k][0] = *(const u32x4*)up; uu[k][1] = *(const u32x4*)(up + 8); }
#pragma unroll
    for (int k = 0; k < 4; ++k) { const int b = b0 + 32 * k; const size_t so = ((size_t)(l * NSAMP + b) * 64 + g) * 64;
        const u32x4 u0 = uu[k][0], u1 = uu[k][1];
        const float u[16] = {bflo(u0.x), bfhi(u0.x), bflo(u0.y), bfhi(u0.y), bflo(u0.z), bfhi(u0.z), bflo(u0.w), bfhi(u0.w), bflo(u1.x), bfhi(u1.x), bflo(u1.y), bfhi(u1.y), bflo(u1.z), bfhi(u1.z), bflo(u1.w), bfhi(u1.w)};
        float bur = 0.f, bui = 0.f;
#pragma unroll
        for (int c = 0; c < 16; ++c) { bur += br[c] * u[c]; bui += bi[c] * u[c]; }
        const float xr = ar * x0r[k] - ai * x0i[k] + bur, xi = ar * x0i[k] + ai * x0r[k] + bui;
        float y = 0.f, um = 0.f;
#pragma unroll
        for (int c = 0; c < 16; ++c) { const float v = wave_sum(cr[c] * xr - ci[c] * xi); if (p == c) { y = v; um = u[c]; } }
        if (p < 16) { y += dsk * um; G5[(size_t)(NPROMPT + b) * PK1 + g * 16 + p] = (bf16_t)f2bf(geluf_(y)); }
        F.out[O_SS5RE + so + p] = xr; F.out[O_SS5IM + so + p] = xi; }
}
__device__ __forceinline__ void s5_chunk_scan(const Frame& F, int l, int g, int b) {
    const int p = F.lane;
    const float* a16 = (const float*)(F.ws + WS_A16) + ((size_t)(l * 64 + g) * 64 + p) * 2; const float ar = a16[0], ai = a16[1];
    const float* L = (const float*)(F.ws + WS_S5L) + (size_t)(g * 512 + b * 128) * 128;
    bf16_t* A = (bf16_t*)(F.ws + WS_S5A) + (size_t)(g * 512 + b * 128) * 384 + 256;
    float xr = 0.f, xi = 0.f;
    for (int k0 = 0; k0 < 128; k0 += 16) {
        float lr[16], li[16];
#pragma unroll
        for (int j = 0; j < 16; ++j) { lr[j] = L[(size_t)(k0 + j) * 128 + p]; li[j] = L[(size_t)(k0 + j) * 128 + 64 + p]; }
#pragma unroll
        for (int j = 0; j < 16; ++j) { A[(size_t)(k0 + j) * 384 + p] = (bf16_t)f2bf(xr); A[(size_t)(k0 + j) * 384 + 64 + p] = (bf16_t)f2bf(xi);
            const float nxr = ar * xr - ai * xi + lr[j], nxi = ar * xi + ai * xr + li[j]; xr = nxr; xi = nxi; }
    }
    F.out[O_PS5RE + ((size_t)(l * NB + b) * 64 + g) * 64 + p] = xr; F.out[O_PS5IM + ((size_t)(l * NB + b) * 64 + g) * 64 + p] = xi;
}

constexpr int PH_KT = 0, PH_QT = 17408, PH_VB = 34816, PH_KBG = 52224, PH_MISC = 69632, PH_HALF = 73728, PP = 136, TP = 72;
typedef short v4i16_t __attribute__((ext_vector_type(4)));
__device__ __forceinline__ s16x4 lds_tr16(const LAS bf16_t* p) { return __builtin_bit_cast(s16x4, __builtin_amdgcn_ds_read_tr16_b64_v4i16((LAS v4i16_t*)p)); }
__device__ __forceinline__ bf16x8 cat8(s16x4 a, s16x4 b) { return (bf16x8){a[0], a[1], a[2], a[3], b[0], b[1], b[2], b[3]}; }
__device__ __forceinline__ bf16x8 pack8(f32x4 a, f32x4 b) { u32x4 w; w.x = cvt_pk_bf16(a[0], a[1]); w.y = cvt_pk_bf16(a[2], a[3]); w.z = cvt_pk_bf16(b[0], b[1]); w.w = cvt_pk_bf16(b[2], b[3]); return __builtin_bit_cast(bf16x8, w); }
#define MFMA16(A, B, C) __builtin_amdgcn_mfma_f32_16x16x32_bf16((A), (B), (C), 0, 0, 0)

__device__ __forceinline__ void delta_prep_item(const Frame& F, const CArgs& a, int l, int b, int c, int hp) {
    const int half = F.wave >> 2, w4 = F.wave & 3, lane = F.lane, q = lane >> 4, c16 = lane & 15, h = 2 * hp + half;
    LAS unsigned char* hb = F.lds + half * PH_HALF;
    LAS bf16_t* Kt = (LAS bf16_t*)(hb + PH_KT); LAS bf16_t* Qt = (LAS bf16_t*)(hb + PH_QT); LAS bf16_t* Vb = (LAS bf16_t*)(hb + PH_VB); LAS bf16_t* Kbg = (LAS bf16_t*)(hb + PH_KBG);
    LAS float* Af = (LAS float*)(hb + PH_QT); LAS bf16_t* Tm = (LAS bf16_t*)(hb + PH_QT); LAS float* gcs = (LAS float*)(hb + PH_MISC);
    const int row0 = b * SEQ + c * 64;
    bf16_t* item = (bf16_t*)(F.ws + WS_PREP) + (size_t)((b * NH + h) * NCHUNK + c) * 36864;
    bf16_t* gW = item; bf16_t* gQD = item + 8192; bf16_t* gKD = item + 16384; bf16_t* gQK = item + 24576; bf16_t* gUT = item + 28672;
    if (w4 == 0) {
        const float* BA = (const float*)(F.ws + WS_BA) + (size_t)(row0 + lane) * 16;
        const float beta = sigmoidf_(BA[h]);
        float gc = -expf(a.in[I_ALOG][l * NH + h]) * softplusf_(BA[8 + h] + a.in[I_DTB][l * NH + h]);
#pragma unroll
        for (int o = 1; o < 64; o <<= 1) { const float t = __shfl_up(gc, o); if (lane >= o) gc += t; }
        const float glast = __shfl(gc, 63);
        gcs[lane] = gc; gcs[64 + lane] = beta; gcs[128 + lane] = expf(gc); gcs[192 + lane] = expf(glast - gc);
        if (lane == 0) ((float*)(F.ws + WS_DEC))[(b * NH + h) * NCHUNK + c] = expf(glast);
    }
    LDS_BAR();
    {
        const bf16_t* QKV = (const bf16_t*)(F.ws + WS_QKV); const int chq = h * 128 + 2 * lane;
        const float* cwp = a.in[I_CONVW] + (size_t)l * 4 * CONVCH;
        float cw[4][6];
#pragma unroll
        for (int i = 0; i < 4; ++i)
#pragma unroll
            for (int s = 0; s < 3; ++s) { const f32x2 v = *(const f32x2*)(cwp + (size_t)i * CONVCH + s * 1024 + chq); cw[i][2 * s] = v[0]; cw[i][2 * s + 1] = v[1]; }
#pragma unroll 1
        for (int hh = 0; hh < 2; ++hh) {
            unsigned pre[11][3];
#pragma unroll
            for (int i = 0; i < 11; ++i) { const int tok = 16 * w4 + 8 * hh - 3 + i; const bool ok = (c > 0) || (tok >= 0);
#pragma unroll
                for (int s = 0; s < 3; ++s) pre[i][s] = ok ? *(const unsigned*)(QKV + (size_t)(row0 + tok) * CONVCH + s * 1024 + chq) : 0u; }
#pragma unroll
            for (int tt = 0; tt < 8; ++tt) {
                const int t = 16 * w4 + 8 * hh + tt; float y[6];
#pragma unroll
                for (int s = 0; s < 3; ++s) {
                    float y0 = 0.f, y1 = 0.f;
#pragma unroll
                    for (int i = 0; i < 4; ++i) { y0 += cw[i][2 * s] * bflo(pre[tt + i][s]); y1 += cw[i][2 * s + 1] * bfhi(pre[tt + i][s]); }
                    y[2 * s] = siluf_(y0); y[2 * s + 1] = siluf_(y1);
                }
                const float ssq = wave_sum(y[0] * y[0] + y[1] * y[1]), ssk = wave_sum(y[2] * y[2] + y[3] * y[3]);
                const float rq = (__builtin_amdgcn_rsqf(ssq + 1e-6f)) * 0.08838834764831845f, rk = __builtin_amdgcn_rsqf(ssk + 1e-6f);
                const float beta = gcs[64 + t], egc = gcs[128 + t], ekd = gcs[192 + t];
                const float q0 = y[0] * rq, q1 = y[1] * rq, k0 = y[2] * rk, k1 = y[3] * rk;
                *(LAS unsigned*)(Kt + t * PP + 2 * lane) = pk2(k0, k1);
                *(LAS unsigned*)(Qt + t * PP + 2 * lane) = pk2(q0, q1);
                *(LAS unsigned*)(Vb + t * PP + 2 * lane) = pk2(y[4] * beta, y[5] * beta);
                *(LAS unsigned*)(Kbg + t * PP + 2 * lane) = pk2(k0 * beta * egc, k1 * beta * egc);
                *(unsigned*)(gQD + t * 128 + 2 * lane) = pk2(q0 * egc, q1 * egc);
                *(unsigned*)(gKD + t * 128 + 2 * lane) = pk2(k0 * ekd, k1 * ekd);
            }
        }
    }
    LDS_BAR();
    f32x4 kk[4];
    {
        bf16x8 kf[4], qf[4];
#pragma unroll
        for (int ks = 0; ks < 4; ++ks) { kf[ks] = *(const LAS bf16x8*)(Kt + (16 * w4 + c16) * PP + 32 * ks + 8 * q); qf[ks] = *(const LAS bf16x8*)(Qt + (16 * w4 + c16) * PP + 32 * ks + 8 * q); }
        const float gci = gcs[16 * w4 + c16];
#pragma unroll
        for (int mt = 0; mt < 4; ++mt) {
            f32x4 pq = (f32x4){0.f, 0.f, 0.f, 0.f}, pk = (f32x4){0.f, 0.f, 0.f, 0.f};
#pragma unroll
            for (int ks = 0; ks < 4; ++ks) { const bf16x8 kr = *(const LAS bf16x8*)(Kt + (16 * mt + c16) * PP + 32 * ks + 8 * q);
                pq = MFMA16(kr, qf[ks], pq);
                pk = MFMA16(kf[ks], kr, pk); }
            {   const int i = 16 * w4 + c16; float v[4];
#pragma unroll
                for (int r = 0; r < 4; ++r) { const int j = 16 * mt + 4 * q + r; v[r] = (i >= j) ? pq[r] * __expf(gci - gcs[j]) : 0.f; }
                u32x2 w; w.x = pk2(v[0], v[1]); w.y = pk2(v[2], v[3]); *(u32x2*)(gQK + i * 64 + 16 * mt + 4 * q) = w; }
            {   const int j = 16 * mt + c16; const float gcj = gcs[j];
#pragma unroll
                for (int r = 0; r < 4; ++r) { const int i = 16 * w4 + 4 * q + r; kk[mt][r] = (i > j) ? gcs[64 + i] * pk[r] * __expf(gcs[i] - gcj) : 0.f; } }
        }
    }
    LDS_BAR();
    constexpr int AP = 68;
#pragma unroll
    for (int mt = 0; mt < 4; ++mt)
#pragma unroll
        for (int r = 0; r < 4; ++r) Af[(16 * w4 + 4 * q + r) * AP + 16 * mt + c16] = kk[mt][r];
    LDS_BAR();
    LAS float* Tf = (LAS float*)(hb + PH_KT);
#define MM16(x, P, Q) do { const LAS float* P_ = (P) + (lane >> 2) * AP; const LAS float* Q_ = (Q) + 4 * (lane & 3); \
        _Pragma("unroll") for (int k4 = 0; k4 < 4; ++k4) { const f32x4 pv = *(const LAS f32x4*)(P_ + 4 * k4); \
            _Pragma("unroll") for (int e = 0; e < 4; ++e) (x) = (x) + pv[e] * *(const LAS f32x4*)(Q_ + (4 * k4 + e) * AP); } } while (0)
#define BLK(M, bi, bj) ((M) + (16 * (bi)) * AP + 16 * (bj))
    if (w4 == 0) {
        const int bk = lane >> 4, cc = lane & 15; const LAS float* Ab = BLK(Af, bk, bk); float t[16];
#pragma unroll
        for (int i = 0; i < 16; ++i) {
            float sp[4] = {(i == cc) ? 1.0f : 0.0f, 0.f, 0.f, 0.f};
#pragma unroll
            for (int j4 = 0; j4 < (i + 3) / 4; ++j4) { const f32x4 av = *(const LAS f32x4*)(Ab + i * AP + 4 * j4);
#pragma unroll
                for (int e = 0; e < 4; ++e) if (4 * j4 + e < i) sp[e] -= av[e] * t[4 * j4 + e]; }
            t[i] = (sp[0] + sp[1]) + (sp[2] + sp[3]);
        }
#pragma unroll
        for (int i = 0; i < 16; ++i) BLK(Tf, bk, bk)[i * AP + cc] = t[i];
    }
    LDS_BAR();
    {
#pragma unroll
        for (int lv = 1; lv <= 3; ++lv) {
            if (w4 < 4 - lv) {
                const int bi = w4 + lv, bj = w4; f32x4 x = (f32x4){0.f, 0.f, 0.f, 0.f};
#pragma unroll
                for (int kb = 0; kb < 3; ++kb) if (kb < lv) MM16(x, BLK(Af, bi, bj + kb), BLK(Tf, bj + kb, bj));
                LAS float* xo = BLK(Tf, bi, bj) + (lane >> 2) * AP + 4 * (lane & 3);
                *(LAS f32x4*)xo = x;
                LDS_WAIT();
                f32x4 y = (f32x4){0.f, 0.f, 0.f, 0.f};
                MM16(y, BLK(Tf, bi, bi), BLK(Tf, bi, bj));
                LDS_WAIT();
                *(LAS f32x4*)xo = (f32x4){-y[0], -y[1], -y[2], -y[3]};
            }
            LDS_BAR();
        }
    }
#undef MM16
#pragma unroll
    for (int e = 0; e < 4; ++e) { const int idx = (F.tid & 255) + 256 * e, i = idx >> 4, j4 = (idx & 15) * 4;
        f32x4 v = *(const LAS f32x4*)(Tf + i * AP + j4); if ((j4 >> 4) > (i >> 4)) v = (f32x4){0.f, 0.f, 0.f, 0.f};
        u32x2 w; w.x = pk2(v[0], v[1]); w.y = pk2(v[2], v[3]); *(LAS u32x2*)(Tm + i * TP + j4) = w; }
#undef BLK
    LDS_BAR();
    {
        bf16x8 tf[4][2];
#pragma unroll
        for (int mt = 0; mt < 4; ++mt)
#pragma unroll
            for (int ks = 0; ks < 2; ++ks) tf[mt][ks] = *(const LAS bf16x8*)(Tm + (16 * mt + c16) * TP + 32 * ks + 8 * q);
#pragma unroll
        for (int n2 = 0; n2 < 2; ++n2) {
            const int nt = 2 * w4 + n2;
            bf16x8 vf[2], gf[2];
#pragma unroll
            for (int ks = 0; ks < 2; ++ks) {
                const int rr = 32 * ks + 8 * q + (c16 >> 2), cc = 16 * nt + 4 * (c16 & 3);
                vf[ks] = cat8(lds_tr16(Vb + rr * PP + cc), lds_tr16(Vb + (rr + 4) * PP + cc));
                gf[ks] = cat8(lds_tr16(Kbg + rr * PP + cc), lds_tr16(Kbg + (rr + 4) * PP + cc));
            }
#pragma unroll
            for (int mt = 0; mt < 4; ++mt) {
                f32x4 u = (f32x4){0.f, 0.f, 0.f, 0.f}, w = (f32x4){0.f, 0.f, 0.f, 0.f};
#pragma unroll
                for (int ks = 0; ks < 2; ++ks) { u = MFMA16(tf[mt][ks], vf[ks], u);
                                                 w = MFMA16(gf[ks], tf[mt][ks], w); }
                u32x2 uw; uw.x = pk2_sw(u[0], u[1]); uw.y = pk2_sw(u[2], u[3]); *(u32x2*)(gUT + (16 * nt + c16) * 64 + 16 * mt + 4 * q) = uw;
                u32x2 ww; ww.x = pk2_sw(-w[0], -w[1]); ww.y = pk2_sw(-w[2], -w[3]); *(u32x2*)(gW + (16 * mt + c16) * 128 + 16 * nt + 4 * q) = ww;
            }
        }
    }
    LDS_BAR();
}

constexpr int SC_OPS = 61440, SC_W = 0, SC_QD = 17408, SC_KD = 34816, SC_QK = 52224, SC_OT = 2 * SC_OPS, SC_OTB = 17408;
static_assert(SC_OT + 2 * SC_OTB <= MISC_OFF, "scan LDS map");
__device__ __forceinline__ bf16x8 frag2(const LAS bf16_t* p) { const u32x2 a = *(const LAS u32x2*)p, b = *(const LAS u32x2*)(p + 16); return __builtin_bit_cast(bf16x8, (u32x4){a.x, a.y, b.x, b.y}); }
__device__ __forceinline__ void delta_scan(const Frame& F, const CArgs& a, int l, int b, int h, int sl) {
    const int wave = F.wave, lane = F.lane, q = lane >> 4, c16 = lane & 15;
    const bf16_t* items = (const bf16_t*)(F.ws + WS_PREP) + (size_t)((b * NH + h) * NCHUNK) * 36864;
    LAS unsigned char* lds = F.lds;
    __syncthreads();
    if (wave >= 4) {
        const int t2 = F.tid - 256;
        u32x4 stA[14], stB[14];
#pragma unroll
        for (int i = 0; i < 14; ++i) { stA[i] = *(const u32x4*)(items + (size_t)(t2 + 256 * i) * 8); stB[i] = *(const u32x4*)(items + (size_t)36864 + (size_t)(t2 + 256 * i) * 8); }
#define SCAN_LOADER_STEP(s, ST) do { \
            { LAS unsigned char* ob = lds + ((s) & 1) * SC_OPS; \
              _Pragma("unroll") for (int i = 0; i < 14; ++i) { const int idx = t2 + 256 * i; \
                  const int off = (i < 12) ? ((idx >> 10) * 17408 + ((idx & 1023) >> 4) * 272 + (idx & 15) * 16) : (SC_QK + ((idx - 3072) >> 3) * 144 + ((idx - 3072) & 7) * 16); \
                  *(LAS u32x4*)(ob + off) = ST[i]; } } \
            LDS_BAR();                                         \
            { const int cn = ((s) + 2 < NCHUNK) ? (s) + 2 : NCHUNK - 1; \
              _Pragma("unroll") for (int i = 0; i < 14; ++i) ST[i] = *(const u32x4*)(items + (size_t)cn * 36864 + (size_t)(t2 + 256 * i) * 8); } } while (0)
#pragma unroll 1
        for (int s = 0; s < NCHUNK; s += 2) { SCAN_LOADER_STEP(s, stA); SCAN_LOADER_STEP(s + 1, stB); }
#undef SCAN_LOADER_STEP
        LDS_BAR();
    } else if (wave >= 2) {
        const int t3 = F.tid - 128; bf16_t* ON = (bf16_t*)(F.ws + WS_ONG); float* SSQP = (float*)(F.ws + WS_SSQP);
        for (int s = 0; s <= NCHUNK; ++s) {
            LDS_BAR();
            if (s >= 1) { const int cc = s - 1, p = cc & 1;
#pragma unroll
                for (int i = 0; i < 2; ++i) { const int idx = t3 + 128 * i, row = idx >> 2, pc = idx & 3;
                    const size_t gr = (size_t)(b * SEQ + cc * 64 + row);
                    const u32x4 o = *(const LAS u32x4*)(lds + SC_OT + p * SC_OTB + row * 272 + pc * 16);
                    const float o0 = bflo(o.x), o1 = bfhi(o.x), o2 = bflo(o.y), o3 = bfhi(o.y), o4 = bflo(o.z), o5 = bfhi(o.z), o6 = bflo(o.w), o7 = bfhi(o.w);
                    float ss = ((o0 * o0 + o1 * o1) + (o2 * o2 + o3 * o3)) + ((o4 * o4 + o5 * o5) + (o6 * o6 + o7 * o7));
                    ss += WS_DPP(ss, 0xB1); ss += WS_DPP(ss, 0x4E);
                    *(u32x4*)(ON + gr * PK2 + h * 128 + 32 * sl + pc * 8) = o;
                    if (pc == 0) SSQP[(gr * NH + h) * 4 + sl] = ss; } }
        }
    } else {
        const int cb = 32 * sl + 16 * wave;
        const float* DEC = (const float*)(F.ws + WS_DEC) + (b * NH + h) * NCHUNK;
        f32x4 S[8];
#pragma unroll
        for (int i = 0; i < 8; ++i) S[i] = (f32x4){0.f, 0.f, 0.f, 0.f};
        u32x2 un[4], un1[4];
#pragma unroll
        for (int mt = 0; mt < 4; ++mt) { un[mt] = *(const u32x2*)(items + 28672 + (cb + c16) * 64 + 16 * mt + 4 * q); un1[mt] = *(const u32x2*)(items + (size_t)36864 + 28672 + (cb + c16) * 64 + 16 * mt + 4 * q); }
        float dn0 = DEC[0], dn1 = DEC[1];
        const int fo = c16 * PP + 4 * q;
        const int fk = c16 * TP + 4 * q;
        const int ft = (4 * q + (c16 >> 2)) * PP + 4 * (c16 & 3);
        for (int c = 0; c <= NCHUNK; ++c) {
            LDS_BAR();
            if (c == NCHUNK) break;
            const LAS bf16_t* Wl = (const LAS bf16_t*)(lds + (c & 1) * SC_OPS + SC_W); const LAS bf16_t* QDl = (const LAS bf16_t*)(lds + (c & 1) * SC_OPS + SC_QD);
            const LAS bf16_t* KDl = (const LAS bf16_t*)(lds + (c & 1) * SC_OPS + SC_KD); const LAS bf16_t* QKl = (const LAS bf16_t*)(lds + (c & 1) * SC_OPS + SC_QK);
#define LDF_WQ(i) frag2((((i) >> 2) & 1 ? QDl : Wl) + (16 * ((i) >> 3)) * PP + 32 * ((i) & 3) + fo)
#define LDF_QK(j) frag2(QKl + (16 * ((j) >> 1)) * TP + 32 * ((j) & 1) + fk)
#define LDF_KD(j) cat8(lds_tr16(KDl + (32 * ((j) & 1)) * PP + 16 * ((j) >> 1) + ft), lds_tr16(KDl + (32 * ((j) & 1) + 16) * PP + 16 * ((j) >> 1) + ft))
            bf16x8 fr[8];
#pragma unroll
            for (int i = 0; i < 8; ++i) fr[i] = LDF_WQ(i);
            f32x4 vacc[4], oacc[4];
#pragma unroll
            for (int mt = 0; mt < 4; ++mt) { const u32x2 u = un[mt]; vacc[mt] = (f32x4){bflo(u.x), bfhi(u.x), bflo(u.y), bfhi(u.y)}; oacc[mt] = (f32x4){0.f, 0.f, 0.f, 0.f}; }
            const float d = dn0; dn0 = dn1;
#pragma unroll
            for (int mt = 0; mt < 4; ++mt) un[mt] = un1[mt];
            if (c + 2 < NCHUNK) { dn1 = DEC[c + 2];
#pragma unroll
                for (int mt = 0; mt < 4; ++mt) un1[mt] = *(const u32x2*)(items + (size_t)(c + 2) * 36864 + 28672 + (cb + c16) * 64 + 16 * mt + 4 * q); }
            bf16x8 sb[4], vb[2];
#pragma unroll
            for (int ks = 0; ks < 4; ++ks) sb[ks] = pack8(S[2 * ks], S[2 * ks + 1]);
            __builtin_amdgcn_sched_barrier(0);
#pragma unroll
            for (int i = 0; i < 24; ++i) {
                const bf16x8 f = fr[i & 7]; fr[i & 7] = LDF_WQ(i + 8);
                const int mt = i >> 3, ks = i & 3;
                if ((i >> 2) & 1) oacc[mt] = MFMA16(f, sb[ks], oacc[mt]); else vacc[mt] = MFMA16(f, sb[ks], vacc[mt]);
                __builtin_amdgcn_sched_barrier(0);
            }
#pragma unroll
            for (int i = 24; i < 32; ++i) {
                const bf16x8 f = fr[i & 7]; fr[i & 7] = LDF_QK(i - 24);
                const int ks = i & 3;
                if ((i >> 2) & 1) oacc[3] = MFMA16(f, sb[ks], oacc[3]); else vacc[3] = MFMA16(f, sb[ks], vacc[3]);
                __builtin_amdgcn_sched_barrier(0);
            }
            vb[0] = pack8(vacc[0], vacc[1]); vb[1] = pack8(vacc[2], vacc[3]);
#pragma unroll
            for (int j = 0; j < 8; ++j) {
                const bf16x8 f = fr[j & 7]; fr[j & 7] = LDF_KD(j);
                oacc[j >> 1] = MFMA16(f, vb[j & 1], oacc[j >> 1]);
                __builtin_amdgcn_sched_barrier(0);
            }
#pragma unroll
            for (int j = 0; j < 16; ++j) {
                const bf16x8 f = fr[j & 7]; if (j + 8 < 16) fr[j & 7] = LDF_KD(j + 8);
                const int m8 = j >> 1;
                if ((j & 1) == 0) S[m8] = S[m8] * d;
                S[m8] = MFMA16(f, vb[j & 1], S[m8]);
                __builtin_amdgcn_sched_barrier(0);
                if (j == 3) {
                    LAS bf16_t* OT = (LAS bf16_t*)(lds + SC_OT + (c & 1) * SC_OTB) + 16 * wave + c16;
#pragma unroll
                    for (int mt = 0; mt < 4; ++mt) { const unsigned p01 = cvt_pk_bf16(oacc[mt][0], oacc[mt][1]), p23 = cvt_pk_bf16(oacc[mt][2], oacc[mt][3]); const int tok = 16 * mt + 4 * q;
                        OT[(tok + 0) * PP] = (bf16_t)(p01 & 0xffffu); OT[(tok + 1) * PP] = (bf16_t)(p01 >> 16); OT[(tok + 2) * PP] = (bf16_t)(p23 & 0xffffu); OT[(tok + 3) * PP] = (bf16_t)(p23 >> 16); } }
            }
#undef LDF_WQ
#undef LDF_QK
#undef LDF_KD
        }
        float* so = F.out + O_PSSM + ((size_t)(l * NB + b) * NH + h) * 16384;
#pragma unroll
        for (int m8 = 0; m8 < 8; ++m8)
#pragma unroll
            for (int r = 0; r < 4; ++r) so[(16 * m8 + 4 * q + r) * 128 + cb + c16] = S[m8][r];
    }
    __syncthreads();
}

__device__ __forceinline__ void mixer_reference(const Frame& F, const CArgs& a, int l) {
#if !S5_FAST
    if (F.wave == 0) { const int it = F.bx; if (it < 256) { const int b = it >> 6, g = it & 63;
            s5_seq(F, a, l, g, b, false, SEQ, nullptr, nullptr, F.out + O_PS5RE + ((size_t)(l * NB + b) * 64 + g) * 64, F.out + O_PS5IM + ((size_t)(l * NB + b) * 64 + g) * 64); } }
    else { for (int it = F.bx * 7 + (F.wave - 1); it < NSAMP * 64; it += F.G * 7) { const int b = it >> 6, g = it & 63; const size_t so = ((size_t)(l * NSAMP + b) * 64 + g) * 64;
            s5_seq(F, a, l, g, b, true, 1, a.in[I_S5RE] + so, a.in[I_S5IM] + so, F.out + O_SS5RE + so, F.out + O_SS5IM + so); } }
#else
    { const int it = F.bx * 8 + F.wave; s5_sample_wave(F, a, l, it & 63, it >> 6); }
#endif
    __syncthreads();
#if DELTA_FAST
    for (int it = F.bx; it < NB * NCHUNK * 4; it += F.G) delta_prep_item(F, a, l, it >> 7, (it >> 2) & 31, it & 3);
    if (0) { for (int it = F.bx; it < NSAMP * NH; it += F.G) {
#else
    if (F.bx < 32) { const int b = F.bx >> 3, h = F.bx & 7; delta_seq(F, a, l, h, b * SEQ, SEQ, nullptr, nullptr, F.out + O_PSSM + ((size_t)(l * NB + b) * NH + h) * 16384); }
    else { for (int it = F.bx - 32; it < NSAMP * NH; it += F.G - 32) {
#endif
            const int b = it >> 3, h = it & 7; const size_t so = ((size_t)(l * NSAMP + b) * NH + h) * 16384;
            delta_seq(F, a, l, h, NPROMPT + b, 1, a.in[I_SCONV] + (size_t)(l * NSAMP + b) * 3 * CONVCH, a.in[I_SSSM] + so, F.out + O_SSSM + so); } }
}


__device__ __forceinline__ void sample_delta_pair(const Frame& F, const CArgs& a, int l, int it0, int it1) {
    const int tid = F.tid, half = tid >> 8, t2 = tid & 255, lane = F.lane, w4 = F.wave & 3, dv = t2 & 127, kg = t2 >> 7;
    const int it = half ? it1 : it0; const bool act = it >= 0;
    const int b = act ? (it >> 3) : 0, h = it & 7; const int r = NPROMPT + b;
    LAS float* raw = (LAS float*)F.lds + half * 1024;
    LAS float* qk = raw + 384;
    LAS float* part = qk + 256;
    LAS float* red = part + 256;
    const size_t so = ((size_t)(l * NSAMP + b) * NH + h) * 16384;
    const float* ssm0 = a.in[I_SSSM] + so; float* ssm_out = F.out + O_SSSM + so;
    float s[64];
#pragma unroll
    for (int i = 0; i < 64; ++i) s[i] = act ? ssm0[(size_t)(kg * 64 + i) * 128 + dv] : 0.f;
    const bf16_t* QKV = (const bf16_t*)(F.ws + WS_QKV); const float* BA = (const float*)(F.ws + WS_BA); const bf16_t* ZS = (const bf16_t*)(F.ws + WS_ZS); bf16_t* ON = (bf16_t*)(F.ws + WS_ONG);
    const float* cw = a.in[I_CONVW] + (size_t)l * 4 * CONVCH; const float* c0 = a.in[I_SCONV] + (size_t)(l * NSAMP + b) * 3 * CONVCH;
#pragma unroll
    for (int ps = 0; ps < 2; ++ps) { const int ci = t2 + 256 * ps;
        if (ci < 384 && act) { const int ch = (ci >> 7) * 1024 + h * 128 + (ci & 127);
            const float y = cw[ch] * c0[ch] + cw[CONVCH + ch] * c0[CONVCH + ch] + cw[2 * CONVCH + ch] * c0[2 * CONVCH + ch] + cw[3 * CONVCH + ch] * bf2f(QKV[(size_t)r * CONVCH + ch]);
            raw[ci] = siluf_(y); } }
    LDS_BAR();
    if (w4 < 2) { const float v0 = raw[w4 * 128 + lane], v1 = raw[w4 * 128 + 64 + lane]; const float ss = wave_sum(v0 * v0 + v1 * v1);
        const float rs = (__builtin_amdgcn_rsqf(ss + 1e-6f)) * (w4 == 0 ? 0.08838834764831845f : 1.0f); qk[w4 * 128 + lane] = v0 * rs; qk[w4 * 128 + 64 + lane] = v1 * rs; }
    LDS_BAR();
    const float beta = sigmoidf_(BA[(size_t)r * 16 + h]), dec = expf(-expf(a.in[I_ALOG][l * NH + h]) * softplusf_(BA[(size_t)r * 16 + 8 + h] + a.in[I_DTB][l * NH + h]));
    float ks = 0.f;
#pragma unroll
    for (int i = 0; i < 64; ++i) { s[i] *= dec; ks += qk[128 + kg * 64 + i] * s[i]; }
    part[kg * 128 + dv] = ks;
    LDS_BAR();
    const float vnew = (raw[256 + dv] - (part[dv] + part[128 + dv])) * beta;
    LDS_BAR();
    float op = 0.f;
#pragma unroll
    for (int i = 0; i < 64; ++i) { s[i] += qk[128 + kg * 64 + i] * vnew; op += qk[kg * 64 + i] * s[i]; }
    part[kg * 128 + dv] = op;
    LDS_BAR();
    const float o = part[dv] + part[128 + dv];
    const float ss = wave_sum(o * o); if (lane == 0) red[w4] = ss;
    LDS_BAR();
    if (t2 < 128 && act) { const float rstd = __builtin_amdgcn_rsqf((red[0] + red[1]) * (1.0f / 128.0f) + NORM_EPS);
        const float z = bf2f(ZS[(size_t)r * 1024 + h * 128 + dv]); ON[(size_t)r * PK2 + h * 128 + dv] = (bf16_t)f2bf(o * rstd * a.in[I_DNNW][l * 128 + dv] * z); }
    if (act) {
#pragma unroll
        for (int i = 0; i < 64; ++i) ssm_out[(size_t)(kg * 64 + i) * 128 + dv] = s[i]; }
    LDS_BAR();
}
__device__ __forceinline__ void sample_delta(const Frame& F, const CArgs& a, int l) {
    if (F.bx >= F.G - 4) return;
    if (F.bx >= 128) { const int i0 = F.bx - 128;
        sample_delta_pair(F, a, l, i0, i0 + 124); sample_delta_pair(F, a, l, i0 + 248, i0 + 372); sample_delta_pair(F, a, l, i0 + 496, i0 + 620); sample_delta_pair(F, a, l, i0 + 744, -1); }
    else sample_delta_pair(F, a, l, 868 + F.bx, F.bx < 28 ? 996 + F.bx : -1);
}
__device__ __forceinline__ void on_finish(const Frame& F, const CArgs& a, int l, int b0, int nb) {
    const bf16_t* ZS = (const bf16_t*)(F.ws + WS_ZS); bf16_t* ON = (bf16_t*)(F.ws + WS_ONG); const float* SSQP = (const float*)(F.ws + WS_SSQP);
    const int pcn = F.tid & 15; const f32x4 n0 = *(const f32x4*)(a.in[I_DNNW] + l * 128 + pcn * 8), n1 = *(const f32x4*)(a.in[I_DNNW] + l * 128 + pcn * 8 + 4);
    for (int p = (F.bx - b0) * 512 + F.tid; p < NPROMPT * 128; p += nb * 512) {
        const int row = p >> 7, pc = p & 127, h = pc >> 4;
        const f32x4 s4 = *(const f32x4*)(SSQP + ((size_t)row * NH + h) * 4);
        const u32x4 z = *(const u32x4*)(ZS + (size_t)row * 1024 + pc * 8);
        bf16_t* op = ON + (size_t)row * PK2 + pc * 8; const u32x4 o = *(const u32x4*)op;
        const float rstd = __builtin_amdgcn_rsqf(((s4[0] + s4[1]) + (s4[2] + s4[3])) * (1.0f / 128.0f) + NORM_EPS);
        u32x4 wv;
        wv.x = cvt_pk_bf16(bflo(o.x) * rstd * n0[0] * bflo(z.x), bfhi(o.x) * rstd * n0[1] * bfhi(z.x));
        wv.y = cvt_pk_bf16(bflo(o.y) * rstd * n0[2] * bflo(z.y), bfhi(o.y) * rstd * n0[3] * bfhi(z.y));
        wv.z = cvt_pk_bf16(bflo(o.z) * rstd * n1[0] * bflo(z.z), bfhi(o.z) * rstd * n1[1] * bfhi(z.z));
        wv.w = cvt_pk_bf16(bflo(o.w) * rstd * n1[2] * bflo(z.w), bfhi(o.w) * rstd * n1[3] * bfhi(z.w));
        *(u32x4*)op = wv;
    }
}


__device__ __forceinline__ void sample_fixup_w(const Frame& F, const CArgs& a, int l, int r) {
    const float* xo = (l == 0 ? a.in[I_XS] : F.out + (size_t)NPROMPT * D) + (size_t)r * D; const float* PART = (const float*)(F.ws + WS_PART) + (size_t)r * D;
    LAS float* red = (LAS float*)F.lds;
    f32x4 v = ((const f32x4*)xo)[F.tid];
#pragma unroll
    for (int s = 0; s < 8; ++s) v = v + ((const f32x4*)(PART + (size_t)s * NSAMP * D))[F.tid];
    ((f32x4*)(F.out + (size_t)(NPROMPT + r) * D))[F.tid] = v;
    u32x2 w; w.x = cvt_pk_bf16(v[0], v[1]); w.y = cvt_pk_bf16(v[2], v[3]); ((u32x2*)((bf16_t*)(F.ws + WS_XB) + (size_t)(NPROMPT + r) * PK2))[F.tid] = w;
    const float ss = wave_sum((v[0] * v[0] + v[1] * v[1]) + (v[2] * v[2] + v[3] * v[3]));
    __syncthreads();
    if (F.lane == 0) red[F.wave] = ss;
    __syncthreads();
    if (F.tid == 0) ((float*)(F.ws + WS_SSQ))[(size_t)(2 * l + 1) * MP + NPROMPT + r] = ((red[0] + red[1]) + (red[2] + red[3])) + ((red[4] + red[5]) + (red[6] + red[7]));
    __syncthreads();
}

__device__ __forceinline__ void sample_fixup(const Frame& F, int l) {
    const int gw = F.bx * 8 + F.wave, NGW = F.G * 8;
    const float* PART = (const float*)(F.ws + WS_PART); float* ssq = (float*)(F.ws + WS_SSQ) + (size_t)(2 * l + 2) * MP; bf16_t* XB = (bf16_t*)(F.ws + WS_XB);
    for (int r = gw; r < NSAMP; r += NGW) {
        f32x4* x4 = (f32x4*)(F.out + (size_t)(NPROMPT + r) * D) + F.lane; u32x2* o = (u32x2*)(XB + (size_t)(NPROMPT + r) * PK2) + F.lane; float s = 0.f;
#pragma unroll
        for (int j = 0; j < 8; ++j) { f32x4 v = x4[64 * j];
#pragma unroll 2
            for (int sp = 0; sp < NSPLIT; ++sp) v = v + ((const f32x4*)(PART + ((size_t)sp * NSAMP + r) * D) + F.lane)[64 * j];
            x4[64 * j] = v; s += (v[0] * v[0] + v[1] * v[1]) + (v[2] * v[2] + v[3] * v[3]);
            u32x2 w; w.x = cvt_pk_bf16(v[0], v[1]); w.y = cvt_pk_bf16(v[2], v[3]); o[64 * j] = w; }
        s = wave_sum(s); if (F.lane == 0) ssq[NPROMPT + r] = s;
    }
}

__device__ __forceinline__ void final_norm(const Frame& F, const CArgs& a) {
    const int gw = F.bx * 8 + F.wave, NGW = F.G * 8; const float* ssq = (const float*)(F.ws + WS_SSQ) + 4 * MP; const f32x4* nf = (const f32x4*)a.in[I_NF] + F.lane;
    const float* PART = (const float*)(F.ws + WS_PART);
    for (int m = gw; m < MR; m += NGW) {
        f32x4* x4 = (f32x4*)(F.out + (size_t)m * D) + F.lane;
        if (m < NPROMPT) {
            const float rstd = __builtin_amdgcn_rsqf(ssq[m] * (1.0f / D) + NORM_EPS);
#pragma unroll
            for (int j = 0; j < 8; ++j) { f32x4 v = x4[64 * j]; const f32x4 w = nf[64 * j]; v = v * rstd * w; x4[64 * j] = v; }
        } else {
            const int r = m - NPROMPT; f32x4 v[8]; float s = 0.f;
#pragma unroll
            for (int j = 0; j < 8; ++j) { v[j] = x4[64 * j];
#pragma unroll 2
                for (int sp = 0; sp < NSPLIT; ++sp) v[j] = v[j] + ((const f32x4*)(PART + ((size_t)sp * NSAMP + r) * D) + F.lane)[64 * j];
                s += (v[j][0] * v[j][0] + v[j][1] * v[j][1]) + (v[j][2] * v[j][2] + v[j][3] * v[j][3]); }
            s = wave_sum(s); const float rstd = __builtin_amdgcn_rsqf(s * (1.0f / D) + NORM_EPS);
#pragma unroll
            for (int j = 0; j < 8; ++j) x4[64 * j] = v[j] * rstd * nf[64 * j];
        }
    }
}

template <int L, int SP> __device__ __forceinline__ void layer_phase(Frame& F, const CArgs& a) {
    constexpr int l = L;
    unsigned char* ws = F.ws; unsigned char* wb = ws + WS_W0 + l * WS_WSTRIDE;
    float* SSQ = (float*)(ws + WS_SSQ); bf16_t* XB = (bf16_t*)(ws + WS_XB);
    if constexpr (SP == 0) {
        pg8::Gemm g{XB, (const bf16_t*)(wb + WO_IN), D, PK2, PK2}; pg8::StaticOrder S; S.init(MP / 256, NIN / 256, F.G, F.vb);
        pg8::EpiProj E{(bf16_t*)(ws + WS_QKV), (bf16_t*)(ws + WS_ZS), (bf16_t*)(ws + WS_S5A), (bf16_t*)(ws + WS_S5US), (bf16_t*)(ws + WS_SGD), (bf16_t*)(ws + WS_SGS), (float*)(ws + WS_BA), SSQ + (size_t)(2 * l) * MP};
        pg8::gemm_phase(F.lds, F.tid, g, S, E);
        if constexpr (L == 0) { pg8::Unit t_; if (!S.next(4, t_)) convert_pull(F, a, 5); }
    } else if constexpr (SP == 1) {
#if S5_FAST
        { pg8::Gemm g{(const bf16_t*)(ws + WS_S5A), (const bf16_t*)(wb + WO_BTL), 256, 384, 256}; pg8::S5Order S{F.G, F.bx, 128};
          pg8::EpiS5L E{(float*)(ws + WS_S5L)}; pg8::gemm_phase(F.lds, F.tid, g, S, E); }
        __syncthreads();
#endif
        mixer_reference(F, a, l);
    } else if constexpr (SP == 2) {
#if DELTA_FAST
        if (F.bx < 128) delta_scan(F, a, l, (F.bx & 31) >> 3, F.bx & 7, F.bx >> 5);
#endif
        sample_delta(F, a, l);
        if (F.bx >= 128 && F.bx < 252) conv_state_out(F, a, l);
        __syncthreads();
        { pg8::Gemm g{(const bf16_t*)(ws + WS_G5), (const bf16_t*)(wb + WO_GLU), 1024, PK1, PK1, 1}; pg8::SampleOrder S{F.bx, 252, 4};
          pg8::EpiGlu E{(const bf16_t*)(ws + WS_G5), (bf16_t*)(ws + WS_ONG)}; pg8::gemm_phase(F.lds, F.tid, g, S, E); }
    } else if constexpr (SP == 3) {
#if S5_FAST
        if (F.bx < 128 && F.wave < 2) s5_chunk_scan(F, l, F.bx >> 1, 2 * (F.bx & 1) + F.wave);
        __syncthreads();
        { pg8::Gemm g{(const bf16_t*)(ws + WS_S5A), (const bf16_t*)(wb + WO_BTY), 384, 384, 384}; pg8::S5Order S{F.G, F.bx, 0};
          pg8::EpiS5Y E{(bf16_t*)(ws + WS_G5)}; pg8::gemm_phase(F.lds, F.tid, g, S, E); }
#endif
        { const int hf = (F.bx >= 136) ? 1 : 0;
          pg8::Gemm g{(const bf16_t*)(ws + WS_ONG) + hf * 1024, (const bf16_t*)(wb + WO_BRDN) + hf * 1024, 1024, PK2, PK2, 1}; pg8::SampleOrder S{F.bx, 128 + 8 * hf, 8};
          pg8::EpiGate E{(const bf16_t*)(ws + (hf ? WS_SGS : WS_SGD)), hf ? (bf16_t*)(ws + WS_MB) - (size_t)NPROMPT * PK2 : (bf16_t*)(ws + WS_MERGED)};
          pg8::gemm_phase(F.lds, F.tid, g, S, E); }
        if (F.bx >= 144) on_finish(F, a, l, 144, 112);
        if constexpr (L == 0) { if (F.bx >= 144) convert_pull(F, a, 6); }
    } else if constexpr (SP == 4) {
        { pg8::Gemm g{(const bf16_t*)(ws + WS_G5), (const bf16_t*)(wb + WO_GLU), 1024, PK1, PK1}; pg8::StaticOrder S; S.init(32, 4, F.G, F.vb);
          pg8::EpiGlu E{(const bf16_t*)(ws + WS_G5), (bf16_t*)(ws + WS_ONG)};
          pg8::gemm_phase(F.lds, F.tid, g, S, E); }
        { const int c = F.bx - 128, s8 = (c >> 3) & 7, hf = s8 >> 2, ko = (s8 & 3) * 512;
          const bf16_t* Ab = hf ? (const bf16_t*)(ws + WS_MB) - (size_t)NPROMPT * PK2 : (const bf16_t*)(ws + WS_MERGED);
          pg8::Gemm g{Ab + ko, (const bf16_t*)(wb + WO_OUT) + ko, 512, PK2, PK2, 1}; pg8::SplitOrder S{c < 0 ? 1 << 20 : c, 64};
          pg8::EpiPart E{(float*)(ws + WS_PART) + (size_t)s8 * NSAMP * D};
          pg8::gemm_phase(F.lds, F.tid, g, S, E); }
        if constexpr (L == 0) { if (F.bx >= 192) convert_pull(F, a, 4); }
    } else if constexpr (SP == 5) {
        { pg8::Gemm g{(const bf16_t*)(ws + WS_ONG), (const bf16_t*)(wb + WO_BRDN), D, PK2, PK2}; pg8::StaticOrder S; S.init(32, 8, F.G, F.vb);
          pg8::EpiBrM E{(const bf16_t*)(ws + WS_SGD), (const bf16_t*)(ws + WS_SGS), (bf16_t*)(ws + WS_MERGED)}; pg8::gemm_phase(F.lds, F.tid, g, S, E); }
        if (F.bx < NSAMP) sample_fixup_w(F, a, l, F.bx);
    } else if constexpr (SP == 6) {
        pg8::Gemm g{(const bf16_t*)(ws + WS_MERGED), (const bf16_t*)(wb + WO_OUT), D, PK2, PK2}; pg8::StaticOrder S; S.init(32, 8, F.G, F.vb);
        pg8::EpiRes E{l == 0 ? a.in[I_XP] : F.out, l == 0 ? a.in[I_XS] : F.out + (size_t)NPROMPT * D, F.out, XB, SSQ + (size_t)(2 * l + 1) * MP};
        pg8::gemm_phase(F.lds, F.tid, g, S, E);
    } else if constexpr (SP == 7) {
        pg8::Gemm g{XB, (const bf16_t*)(wb + WO_GU), D, PK2, PK2}; pg8::StaticOrder S; S.init(MP / 256, 44, F.G, F.vb);
        pg8::EpiGU E{(bf16_t*)(ws + WS_ACT), SSQ + (size_t)(2 * l + 1) * MP};
        pg8::gemm_phase(F.lds, F.tid, g, S, E);
        if constexpr (L == 0) { pg8::Unit t_; if (!S.next(5, t_)) convert_pull(F, a, 5); }
    } else if constexpr (SP == 8) {
        { pg8::Gemm g{(const bf16_t*)(ws + WS_ACT), (const bf16_t*)(wb + WO_D), FF, PK5, PK5}; pg8::StaticOrder S; S.init(32, 8, F.G, F.vb);
          pg8::EpiRes E{F.out, F.out + (size_t)NPROMPT * D, F.out, XB, SSQ + (size_t)(2 * l + 2) * MP};
          pg8::gemm_phase(F.lds, F.tid, g, S, E); }
        { const int sp = F.bx >> 3;
          pg8::Gemm g{(const bf16_t*)(ws + WS_ACT) + sp * 256, (const bf16_t*)(wb + WO_D) + sp * 256, 256, PK5, PK5, 1}; pg8::SplitOrder S{F.bx, 8 * NSPLIT};
          pg8::EpiPart E{(float*)(ws + WS_PART) + (size_t)sp * NSAMP * D};
          pg8::gemm_phase(F.lds, F.tid, g, S, E); }
    } else {
        sample_fixup(F, l);
        if constexpr (L == 0) convert_pull(F, a, 1 << 20);
    }
}

__global__ void __launch_bounds__(512, 2) fwd(Args a_unused) {
    extern __shared__ __attribute__((aligned(16))) unsigned char lds_raw[];
    CArgs* ap0 = (CArgs*)__builtin_amdgcn_kernarg_segment_ptr();
    Frame F;
    F.lds = (LAS unsigned char*)lds_raw; F.tid = threadIdx.x; F.lane = F.tid & 63; F.wave = __builtin_amdgcn_readfirstlane(F.tid >> 6);
    F.G = gridDim.x; F.bx = blockIdx.x; F.ws = ap0->ws; F.out = ap0->out;
    volatile LAS unsigned* MISC = (volatile LAS unsigned*)(F.lds + MISC_OFF);
    if (F.tid < 64) MISC[F.tid] = 0u;
    __syncthreads();
    const int lo = ap0->ph_lo, hi = ap0->ph_hi, use_bar = ap0->use_bar;
    if (F.tid == 0) MISC[13] = (blockIdx.x % 8) * (gridDim.x / 8) + blockIdx.x / 8;
    XcdBarrier bar; bar.bar = (unsigned*)(F.ws + WS_CTL) + 1024; bar.x = 0; bar.st = nullptr;
    if (use_bar) bar = xcd_barrier_post((unsigned*)(F.ws + WS_CTL) + 1024, MISC + 8);
    if (use_bar && F.tid == 0) MISC[12] = xb_add((unsigned*)(F.ws + WS_CTL) + 8192 + 64 * xb_xcc_id(), 1u);
    F.vb = 0;
#define PHASE_ENTER() CArgs* ap = ap0; asm volatile("" : "+s"(ap)); const CArgs& a = *ap; \
        { int t_ = threadIdx.x; asm volatile("" : "+v"(t_)); F.tid = t_; F.lane = t_ & 63; F.wave = __builtin_amdgcn_readfirstlane(t_ >> 6); } \
        { int b_ = blockIdx.x; asm volatile("" : "+s"(b_)); F.bx = b_; int g_ = gridDim.x; asm volatile("" : "+s"(g_)); F.G = g_; F.vb = __builtin_amdgcn_readfirstlane((int)MISC[13]); } \
        { long z_ = 0; asm volatile("" : "+s"(z_)); F.ws = a.ws + z_; F.out = a.out + z_; }
#define SEAM() do { if (use_bar) { xcd_barrier(bar); \
        if (false && F.tid == 0 && MISC[14] == 0u) { unsigned off_ = 0u; const unsigned x_ = xb_xcc_id(); \
            for (unsigned j_ = 0; j_ < 16; ++j_) { const unsigned c_ = xb_ld(&bar.bar[XB_XCNT(j_)]); if (j_ < x_) off_ += c_; } \
            MISC[13] = off_ + MISC[12]; MISC[14] = 1u; } \
        __syncthreads(); } else __syncthreads(); } while (0)
#define RUN(k, stmt) if (((PHMASK >> (k)) & 1u) && lo <= (k) && (k) < hi) { { PHASE_ENTER(); stmt; } if ((DUPMASK >> (k)) & 1u) { SEAM(); PHASE_ENTER(); stmt; } if ((k) + 1 < hi) SEAM(); }
    RUN(0, p0_prologue(F, a));
    RUN(1, (layer_phase<0, 0>(F, a))); RUN(2, (layer_phase<0, 1>(F, a))); RUN(3, (layer_phase<0, 2>(F, a))); RUN(4, (layer_phase<0, 3>(F, a))); RUN(5, (layer_phase<0, 4>(F, a)));
    RUN(6, (layer_phase<0, 5>(F, a))); RUN(7, (layer_phase<0, 6>(F, a))); RUN(8, (layer_phase<0, 7>(F, a))); RUN(9, (layer_phase<0, 8>(F, a))); RUN(10, (layer_phase<0, 9>(F, a)));
    RUN(11, (layer_phase<1, 0>(F, a))); RUN(12, (layer_phase<1, 1>(F, a))); RUN(13, (layer_phase<1, 2>(F, a))); RUN(14, (layer_phase<1, 3>(F, a))); RUN(15, (layer_phase<1, 4>(F, a)));
    RUN(16, (layer_phase<1, 5>(F, a))); RUN(17, (layer_phase<1, 6>(F, a))); RUN(18, (layer_phase<1, 7>(F, a))); RUN(19, (layer_phase<1, 8>(F, a)));
    RUN(20, final_norm(F, a));
#undef RUN
#undef PHASE_ENTER
}

extern "C" void kernel_launch(void* const* d_in, const int* in_sizes, int n_in, void* d_out, int out_size, void* d_ws, size_t ws_size, hipStream_t stream) {
    static int grid = 0;
    if (grid == 0) {
        if (n_in != 29 || (size_t)out_size != O_END || ws_size < WS_END) { fprintf(stderr, "kernel_launch: unexpected problem: n_in %d out %d ws %zu (need %zu)\n", n_in, out_size, ws_size, (size_t)WS_END); grid = -1; return; }
        int dev = 0, cus = 0, per_cu = 0;
        if (hipGetDevice(&dev) != hipSuccess || hipDeviceGetAttribute(&cus, hipDeviceAttributeMultiprocessorCount, dev) != hipSuccess) { grid = -1; return; }
        if (hipFuncSetAttribute((const void*)fwd, hipFuncAttributeMaxDynamicSharedMemorySize, LDS_BYTES) != hipSuccess) { fprintf(stderr, "kernel_launch: hipFuncSetAttribute failed\n"); grid = -1; return; }
        if (hipOccupancyMaxActiveBlocksPerMultiprocessor(&per_cu, (const void*)fwd, 512, LDS_BYTES) != hipSuccess || per_cu < 1) { fprintf(stderr, "kernel_launch: occupancy query says %d\n", per_cu); }
        (void)hipGetLastError();
        grid = cus;
    }
    if (grid < 0) return;
    (void)hipMemsetAsync((char*)d_ws + WS_CTL, 0, CTL_ZERO_BYTES, stream);
    Args a{};
    for (int i = 0; i < 29; ++i) a.in[i] = (const float*)d_in[i];
    a.out = (float*)d_out; a.ws = (unsigned char*)d_ws;
#ifndef MK_MULTI
#define MK_MULTI 0
#endif
#if MK_MULTI
    for (int ph = 0; ph < NPHASE; ++ph) { a.ph_lo = ph; a.ph_hi = ph + 1; a.use_bar = 0; hipLaunchKernelGGL(fwd, dim3(grid), dim3(512), LDS_BYTES, stream, a); }
#else
    a.ph_lo = 0; a.ph_hi = NPHASE; a.use_bar = 1;
    hipLaunchKernelGGL(fwd, dim3(grid), dim3(512), LDS_BYTES, stream, a);
#endif
}
```

```cpp
#include <hip/hip_runtime.h>
#include <stdint.h>
#include <stdio.h>

#define LAS __attribute__((address_space(3)))
#define GAS __attribute__((address_space(1)))
typedef unsigned short bf16_t;
typedef short bf16x8 __attribute__((ext_vector_type(8)));
typedef short s16x4 __attribute__((ext_vector_type(4)));
typedef float f32x4 __attribute__((ext_vector_type(4)));
typedef float f32x2 __attribute__((ext_vector_type(2)));
typedef unsigned u32x4 __attribute__((ext_vector_type(4)));
typedef unsigned u32x2 __attribute__((ext_vector_type(2)));

constexpr int D = 2048, NPROMPT = 8192, NSAMP = 128, MR = 8320, MP = 8448, SEQ = 2048, NB = 4;
constexpr int NH = 8, DK = 128, CONVCH = 3072, S5CH = 1024, S5G = 64, S5P = 64, FF = 5632, IN_DIM = 9232, NIN = 9472;
constexpr int NCHUNK = 32;
constexpr float NORM_EPS = 1e-6f;
constexpr int NPHASE = 21, NSPLIT = 22;
constexpr int LDS_BYTES = 163840, MISC_OFF = 163840 - 256;
#ifndef PADK
#define PADK 64
#endif
constexpr int PK2 = D + PADK, PK5 = FF + PADK, PK1 = S5CH + PADK;

constexpr size_t MiB = 1u << 20;
constexpr size_t WS_CTL = 0, CTL_ZERO_BYTES = 64 * 1024;
constexpr size_t WS_SSQ = 1 * MiB;
constexpr size_t WS_BA = 2 * MiB;
constexpr size_t WS_DEC = 3 * MiB;
constexpr size_t WS_A16 = 3 * MiB + 65536;
constexpr size_t WS_BBAR = 4 * MiB;
constexpr size_t WS_S5US = 5 * MiB;
constexpr size_t WS_MB_OLD = 7 * MiB;
constexpr size_t WS_SSQP = 6 * MiB;
constexpr size_t WS_W0 = 8 * MiB, WS_WSTRIDE = 149 * MiB;
constexpr size_t WO_IN = 0, WO_GU = 39 * MiB, WO_D = 85 * MiB, WO_OUT = 108 * MiB, WO_BRDN = 117 * MiB, WO_GLU = 126 * MiB, WO_BTY = 129 * MiB, WO_BTL = 141 * MiB;
constexpr size_t WS_XB = 306 * MiB, WS_ZS = 341 * MiB, WS_SGD = WS_ZS + 16 * MiB + 512 * 1024, WS_SGS = WS_SGD + 33 * MiB;
constexpr size_t WS_S5A = WS_SGS + 33 * MiB, WS_S5L = WS_S5A + 24 * MiB, WS_ONG = WS_S5L + 16 * MiB, WS_G5 = WS_ONG + 35 * MiB;
constexpr size_t WS_MERGED = WS_G5 + 18 * MiB, WS_MB = WS_MERGED + 35 * MiB, WS_QKV = WS_MB + 2 * MiB;
constexpr size_t WS_PREP = WS_QKV + 49 * MiB + 512 * 1024, WS_ACT = WS_QKV, WS_PART = WS_S5A, WS_END = WS_PREP + 72 * MiB;
constexpr size_t PREP_ITEM = 73728;
static_assert(WS_ACT + (size_t)MP * PK5 * 2 <= WS_END, "ACT overlay");
static_assert((size_t)NIN * PK2 * 2 <= 39 * MiB && (size_t)11264 * PK2 * 2 <= 46 * MiB && (size_t)D * PK5 * 2 <= 23 * MiB && (size_t)D * PK2 * 2 <= 9 * MiB && (size_t)1024 * PK1 * 2 <= 3 * MiB, "weights");
static_assert((size_t)MP * PK2 * 2 <= 35 * MiB && (size_t)MP * PK1 * 2 <= 18 * MiB && (size_t)256 * PK2 * 2 <= 2 * MiB && (size_t)NSPLIT * NSAMP * D * 4 <= 40 * MiB, "acts");
static_assert(WS_END <= 690 * MiB, "map");

__device__ __forceinline__ unsigned f2bf(float f) { unsigned u = __float_as_uint(f); return (u + 0x7fffu + ((u >> 16) & 1u)) >> 16; }
__device__ __forceinline__ unsigned pk2(float lo, float hi);
__device__ __forceinline__ float bflo(unsigned w) { return __uint_as_float(w << 16); }
__device__ __forceinline__ float bfhi(unsigned w) { return __uint_as_float(w & 0xffff0000u); }
__device__ __forceinline__ float bf2f(bf16_t b) { return __uint_as_float(((unsigned)b) << 16); }
__device__ __forceinline__ unsigned cvt_pk_bf16(float lo, float hi) { unsigned r; asm volatile("v_cvt_pk_bf16_f32 %0, %1, %2" : "=v"(r) : "v"(lo), "v"(hi)); return r; }
__device__ __forceinline__ unsigned pk2(float lo, float hi) { return cvt_pk_bf16(lo, hi); }
__device__ __forceinline__ unsigned pk2_sw(float lo, float hi) { return f2bf(lo) | (f2bf(hi) << 16); }
__device__ __forceinline__ float sigmoidf_(float x) { return __builtin_amdgcn_rcpf(1.0f + __expf(-x)); }
__device__ __forceinline__ float siluf_(float x) { return x * __builtin_amdgcn_rcpf(1.0f + __expf(-x)); }
__device__ __forceinline__ float softplusf_(float x) { return fmaxf(x, 0.f) + log1pf(__expf(-fabsf(x))); }
__device__ __forceinline__ float geluf_(float x) { const float u = 1.5957691216057308f * (x + 0.044715f * x * x * x); return x * __builtin_amdgcn_rcpf(1.0f + __expf(-u)); }
__device__ __forceinline__ float dpp_f(float v, int) { return v; }
#define WS_DPP(v, ctrl) __builtin_bit_cast(float, __builtin_amdgcn_update_dpp(__builtin_bit_cast(int, (v)), __builtin_bit_cast(int, (v)), (ctrl), 0xF, 0xF, true))
__device__ __forceinline__ float wave_sum(float v) {
    v += WS_DPP(v, 0xB1);
    v += WS_DPP(v, 0x4E);
    v += WS_DPP(v, 0x141);
    v += WS_DPP(v, 0x140);
    v += __shfl_xor(v, 16); v += __shfl_xor(v, 32);
    return v;
}
#if defined(__HIP_DEVICE_COMPILE__)
#define ASSUME_GLOBAL(p) do { __builtin_assume(!__builtin_amdgcn_is_shared((const void*)(p))); __builtin_assume(!__builtin_amdgcn_is_private((const void*)(p))); } while (0)
#else
#define ASSUME_GLOBAL(p) do { } while (0)
#endif
#ifndef DUPMASK
#define DUPMASK 0x0u
#endif
#ifndef PHMASK
#define PHMASK 0x1FFFFFu
#endif
#ifndef DELTA_FAST
#define DELTA_FAST 1
#endif
#ifndef S5_FAST
#define S5_FAST 1
#endif
#define LDS_WAIT() asm volatile("s_waitcnt lgkmcnt(0)" ::: "memory")
#define VM_WAIT() asm volatile("s_waitcnt vmcnt(0)" ::: "memory")
#define LDS_BAR() do { asm volatile("s_waitcnt lgkmcnt(0)" ::: "memory"); __builtin_amdgcn_s_barrier(); asm volatile("" ::: "memory"); } while (0)

#define XB_TMO      128
#define XB_XCNT(j)  (256  + 64 * (j))
#define XB_XSUB(j)  (1280 + 64 * (j))
#define XB_XGEN(j)  (2304 + 64 * (j))
#define XB_TOP      3328
#define XB_TOPGEN   3392
#define XCD_BAR_WORDS 3456
#define XB_SPIN_CAP (1u << 20)
__device__ __forceinline__ unsigned xb_ld(unsigned* p)              { return __hip_atomic_load(p, __ATOMIC_RELAXED, __HIP_MEMORY_SCOPE_AGENT); }
__device__ __forceinline__ unsigned xb_add(unsigned* p, unsigned v) { return __hip_atomic_fetch_add(p, v, __ATOMIC_RELAXED, __HIP_MEMORY_SCOPE_AGENT); }
__device__ __forceinline__ unsigned xb_xcc_id() { return (unsigned)__builtin_amdgcn_s_getreg((3 << 11) | 20) & 0xFu; }
#define XB_SPIN(cond, bar) do { unsigned _sp = 0; while (cond) { __builtin_amdgcn_s_sleep(1); \
    if ((++_sp & 255u) == 0u) { if (xb_ld(&(bar)[XB_TMO])) break; if (_sp > XB_SPIN_CAP) { atomicAdd(&(bar)[XB_TMO], 1u); break; } } } } while (0)
struct XcdBarrier { unsigned* bar; unsigned x; volatile LAS unsigned* st; };
__device__ __forceinline__ XcdBarrier xcd_barrier_post(unsigned* bar, volatile LAS unsigned* st) {
    XcdBarrier b; b.bar = bar; b.x = xb_xcc_id(); b.st = st;
    if (threadIdx.x == 0) (void)xb_add(&bar[XB_XCNT(b.x)], 1u);
    return b;
}
__device__ __forceinline__ void xcd_barrier_complete(unsigned* bar, unsigned x, unsigned& nloc, unsigned& nx) {
    const unsigned G = gridDim.x * gridDim.y * gridDim.z;
    unsigned sum, cnt, mine, sp = 0u;
    for (;;) {
        sum = 0u; cnt = 0u; mine = 0u;
#pragma unroll
        for (unsigned j = 0; j < 16; ++j) { const unsigned c = xb_ld(&bar[XB_XCNT(j)]); sum += c; cnt += (c > 0u) ? 1u : 0u; mine = (j == x) ? c : mine; }
        if (sum == G) break;
        __builtin_amdgcn_s_sleep(1);
        if ((++sp & 255u) == 0u) { if (xb_ld(&bar[XB_TMO])) break; if (sp > XB_SPIN_CAP) { atomicAdd(&bar[XB_TMO], 1u); break; } }
    }
    nloc = mine > 0u ? mine : 1u; nx = cnt > 0u ? cnt : 1u;
}
__device__ __forceinline__ void xcd_barrier(const XcdBarrier& b) {
    asm volatile("s_waitcnt vmcnt(0)" ::: "memory");
    __syncthreads();
    if (threadIdx.x == 0) {
        unsigned* bar = b.bar;
        __builtin_amdgcn_s_waitcnt(0);
        unsigned nloc = b.st[0], nx = b.st[1];
        if (nloc == 0u) { xcd_barrier_complete(bar, b.x, nloc, nx); b.st[0] = nloc; b.st[1] = nx; }
        const unsigned old = xb_add(&bar[XB_XSUB(b.x)], 1u);
        const unsigned gen = old / nloc;
        if (old + 1u == (gen + 1u) * nloc) {
            __builtin_amdgcn_fence(__ATOMIC_RELEASE, "agent");
            asm volatile("s_waitcnt vmcnt(0)" ::: "memory");
            const unsigned og = xb_add(&bar[XB_TOP], 1u);
            const unsigned tg = og / nx;
            if (og + 1u == (tg + 1u) * nx) xb_add(&bar[XB_TOPGEN], 1u);
            else XB_SPIN(xb_ld(&bar[XB_TOPGEN]) == tg, bar);
            __builtin_amdgcn_fence(__ATOMIC_ACQUIRE, "agent");
            xb_add(&bar[XB_XGEN(b.x)], 1u);
            asm volatile("s_waitcnt vmcnt(0)" ::: "memory");
        } else {
            XB_SPIN(xb_ld(&bar[XB_XGEN(b.x)]) == gen, bar);
            __builtin_amdgcn_fence(__ATOMIC_ACQUIRE, "agent");
            asm volatile("s_waitcnt vmcnt(0)" ::: "memory");
        }
    }
    __syncthreads();
}

namespace pg8 {
constexpr int BM = 256, BK = 64, HALF = 128, HTB = HALF * BK * 2, STAGE_BYTES = 8 * HTB, NXCD = 8, WGM = 8;
__device__ __forceinline__ int lds_byte(int r, int c) { const int st = (r >> 4) * 2 + (c >> 5), rr = r & 15, cc = c & 31, ob = rr * 64 + cc * 2; return st * 1024 + (ob ^ (((ob >> 9) & 1) << 5)); }
__device__ __forceinline__ void stage_rc(int b, int& R, int& C) { const int st = b / 1024, sb = b % 1024, swz = sb ^ (((sb >> 9) & 1) << 5); R = (st >> 1) * 16 + swz / 64; C = (st & 1) * 32 + (swz % 64) / 2; }
__device__ __forceinline__ int perm32(int rho) { const int n = rho >> 4, i = rho & 15; return 8 * (i >> 2) + 4 * n + (i & 3); }
struct Unit { int pm, pn; };
struct Gemm { const bf16_t* A; const bf16_t* Bt; int K, lda, ldb; int a_alias = 0; };
struct StaticOrder {
    int nM, nN, nwg, G, c;
    __device__ void init(int nM_, int nN_, int G_, int c_) { nM = nM_; nN = nN_; nwg = nM * nN; G = G_; c = c_; }
    __device__ bool next(int i, Unit& u) const {
        const int per = G / NXCD, xcd = c / per, off = i * per + c % per;
        const int q = nwg / NXCD, rem = nwg % NXCD, base = (xcd < rem ? xcd * (q + 1) : rem * (q + 1) + (xcd - rem) * q), cnt = (xcd < rem ? q + 1 : q);
        if (off >= cnt) return false;
        const int wgid = base + off;
        const int nig = WGM * nN, gid = wgid / nig, fm = gid * WGM, gsz = (nM - fm) < WGM ? (nM - fm) : WGM;
        u.pm = fm + ((wgid % nig) % gsz); u.pn = (wgid % nig) / gsz; return true;
    }
};
struct S5Order {
    int G, c, c0;
    __device__ bool next(int i, Unit& u) const { const int L = i * G + c - c0; if (c < c0 || L >= 128) return false; u.pm = L; u.pn = L >> 1; return true; }
};
struct SampleOrder {
    int c, c0, n;
    __device__ bool next(int i, Unit& u) const { if (i != 0 || c < c0 || c >= c0 + n) return false; u.pm = 32; u.pn = c - c0; return true; }
};
struct SplitOrder {
    int c, n;
    __device__ bool next(int i, Unit& u) const { if (i != 0 || c >= n) return false; u.pm = 32; u.pn = c & 7; return true; }
};
template <class E, class = void> struct has_mid { static constexpr bool value = false; };
template <class E> struct has_mid<E, decltype((void)E::HAS_MID)> { static constexpr bool value = true; };
template <class Epi, class Sched>
__device__ __forceinline__ void gemm_phase(LAS unsigned char* lds, const int tid_in, const Gemm g, const Sched& S, const Epi& E) {
    int tid = tid_in; asm volatile("" : "+v"(tid));
    const int wid = __builtin_amdgcn_readfirstlane(tid >> 6), lane = tid & 63, wr = wid >> 2, wc = wid & 3, fr = lane & 15, fq = lane >> 4;
    const int K = g.K, nt = K / BK;
    unsigned voffA[2], voffB[2];
#pragma unroll
    for (int i = 0; i < 2; ++i) { int R, C; stage_rc(tid * 16 + i * 8192, R, C); const int Rb = Epi::PERM ? ((R & ~31) + perm32(R & 31)) : R;
        voffA[i] = (unsigned)(R * g.lda + C) * 2u; voffB[i] = (unsigned)(Rb * g.ldb + C) * 2u; }
    const size_t kstep = (size_t)(BK * 2);
    const size_t hstepA = g.a_alias ? (size_t)0 : (size_t)HALF * g.lda * 2, hstepB = (size_t)HALF * g.ldb * 2;
    const size_t tstepA = (size_t)BM * g.lda * 2, tstepB = 2 * hstepB;
    const unsigned ldsw = (unsigned)wid * 1024u;
    const int aoff = lds_byte(wr * 64 + fr, fq * 8), boff = lds_byte(wc * 32 + fr, fq * 8);
#define PG8_SA(b, h) (((b) * 2 + (h)) * HTB)
#define PG8_SB(b, h) ((4 + (b) * 2 + (h)) * HTB)
#define PG8_STAGE(bufoff, gbase, voff) do { _Pragma("unroll") for (int _i = 0; _i < 2; ++_i) \
        __builtin_amdgcn_global_load_lds((const unsigned*)((const char*)(gbase) + (voff)[_i]), (LAS unsigned*)(lds + (bufoff) + ldsw + _i * 8192), 16, 0, 0); } while (0)
#define PG8_LDA(dst, b, h) do { _Pragma("unroll") for (int m = 0; m < 4; ++m) _Pragma("unroll") for (int k = 0; k < 2; ++k) dst[m][k] = *(const LAS bf16x8*)(lds + PG8_SA(b, h) + aoff + m * 2048 + k * 1024); } while (0)
#define PG8_LDB(dst, b, h) do { _Pragma("unroll") for (int n = 0; n < 2; ++n) _Pragma("unroll") for (int k = 0; k < 2; ++k) dst[n][k] = *(const LAS bf16x8*)(lds + PG8_SB(b, h) + boff + n * 2048 + k * 1024); } while (0)
#define PG8_MMA(ai, bj, At, Bt) do { __builtin_amdgcn_s_setprio(1); _Pragma("unroll") for (int m = 0; m < 4; ++m) _Pragma("unroll") for (int n = 0; n < 2; ++n) _Pragma("unroll") for (int k = 0; k < 2; ++k) \
        acc[ai][bj][m][n] = __builtin_amdgcn_mfma_f32_16x16x32_bf16(Bt[n][k], At[m][k], acc[ai][bj][m][n], 0, 0, 0); __builtin_amdgcn_s_setprio(0); } while (0)
#define PG8_WAIT_V(n) asm volatile("s_waitcnt vmcnt(" #n ")" ::: "memory")
#define PG8_WAIT_L(n) asm volatile("s_waitcnt lgkmcnt(" #n ")" ::: "memory")
#define PG8_BAR __builtin_amdgcn_s_barrier()
#define PG8_SCHED __builtin_amdgcn_sched_barrier(0)
    Unit cur, nxt; int ui = 0;
    if (!S.next(0, cur)) return;
    f32x4 acc[2][2][4][2];
#pragma unroll
    for (int a = 0; a < 2; ++a)
#pragma unroll
        for (int b = 0; b < 2; ++b)
#pragma unroll
            for (int m = 0; m < 4; ++m)
#pragma unroll
                for (int n = 0; n < 2; ++n) acc[a][b][m][n] = (f32x4){0.f, 0.f, 0.f, 0.f};
    bf16x8 At[4][2], B0[2][2], B1[2][2];
    const char* cA = (const char*)g.A + (size_t)cur.pm * tstepA; const char* cB = (const char*)g.Bt + (size_t)cur.pn * tstepB;
    PG8_STAGE(PG8_SB(0, 0), cB, voffB); PG8_STAGE(PG8_SB(0, 1), cB + hstepB, voffB); PG8_STAGE(PG8_SA(0, 0), cA, voffA); PG8_STAGE(PG8_SA(0, 1), cA + hstepA, voffA);
    if (wr == 1) PG8_BAR;
    PG8_WAIT_V(2); PG8_BAR;
    PG8_STAGE(PG8_SB(1, 0), cB + kstep, voffB); PG8_STAGE(PG8_SA(1, 0), cA + kstep, voffA); PG8_STAGE(PG8_SB(1, 1), cB + hstepB + kstep, voffB);
    PG8_WAIT_V(6); PG8_BAR;
    for (;;) {
        const bool has_next = S.next(ui + 1, nxt);
        const char* nA = has_next ? (const char*)g.A + (size_t)nxt.pm * tstepA : cA; const char* nB = has_next ? (const char*)g.Bt + (size_t)nxt.pn * tstepB : cB;
#pragma unroll 1
        for (int t = 0; t < nt; t += 2) {
            if constexpr (has_mid<Epi>::value) { if (2 * t == nt) E.mid(acc, cur, wr, wc, fr, fq); }
            const bool last = (t == nt - 2);
            const char* a1 = cA + (size_t)(t + 1) * kstep;
            const char* a2 = last ? nA : cA + (size_t)(t + 2) * kstep; const char* b2 = last ? nB : cB + (size_t)(t + 2) * kstep;
            const char* a3 = a2 + kstep; const char* b3 = b2 + kstep;
            PG8_LDB(B0, 0, 0); PG8_LDB(B1, 0, 1); PG8_SCHED; PG8_LDA(At, 0, 0); PG8_STAGE(PG8_SA(1, 1), a1 + hstepA, voffA);
            PG8_WAIT_V(8); PG8_WAIT_L(0); PG8_BAR; PG8_MMA(0, 0, At, B0); PG8_MMA(0, 1, At, B1); PG8_BAR; PG8_SCHED;
            PG8_LDA(At, 0, 1); PG8_STAGE(PG8_SA(0, 0), a2, voffA); PG8_STAGE(PG8_SB(0, 0), b2, voffB); PG8_STAGE(PG8_SB(0, 1), b2 + hstepB, voffB);
            PG8_WAIT_V(8); PG8_WAIT_L(0); PG8_BAR; PG8_MMA(1, 0, At, B0); PG8_MMA(1, 1, At, B1); PG8_BAR; PG8_SCHED;
            PG8_LDB(B0, 1, 0); PG8_LDB(B1, 1, 1); PG8_SCHED; PG8_LDA(At, 1, 0); PG8_STAGE(PG8_SA(0, 1), a2 + hstepA, voffA);
            PG8_WAIT_V(8); PG8_WAIT_L(0); PG8_BAR; PG8_MMA(0, 0, At, B0); PG8_MMA(0, 1, At, B1); PG8_BAR; PG8_SCHED;
            PG8_LDA(At, 1, 1); PG8_STAGE(PG8_SA(1, 0), a3, voffA); PG8_STAGE(PG8_SB(1, 0), b3, voffB); PG8_STAGE(PG8_SB(1, 1), b3 + hstepB, voffB);
            PG8_WAIT_V(8); PG8_WAIT_L(0); PG8_BAR; PG8_MMA(1, 0, At, B0); PG8_MMA(1, 1, At, B1); PG8_BAR; PG8_SCHED;
        }
        if (wr == 0) PG8_BAR;
        E(acc, cur, wr, wc, fr, fq);
        if (!has_next) break;
#pragma unroll
        for (int a = 0; a < 2; ++a)
#pragma unroll
            for (int b = 0; b < 2; ++b)
#pragma unroll
                for (int m = 0; m < 4; ++m)
#pragma unroll
                    for (int n = 0; n < 2; ++n) acc[a][b][m][n] = (f32x4){0.f, 0.f, 0.f, 0.f};
        cur = nxt; cA = nA; cB = nB; ++ui;
        if (wr == 1) PG8_BAR;
    }
    PG8_WAIT_V(0);
    PG8_BAR;
#undef PG8_SA
#undef PG8_SB
#undef PG8_STAGE
#undef PG8_LDA
#undef PG8_LDB
#undef PG8_MMA
#undef PG8_WAIT_V
#undef PG8_WAIT_L
#undef PG8_BAR
#undef PG8_SCHED
}

struct EpiProj {
    static constexpr bool PERM = true;
    bf16_t *QKV, *ZS, *S5A, *S5US, *SGD, *SGS; float* BA; const float* SSQ;
    __device__ __forceinline__ void operator()(const f32x4 (&acc)[2][2][4][2], const Unit& u, int wr, int wc, int fr, int fq) const {
        const int row0 = u.pm * BM + wr * 64 + fr, pn = u.pn, cw = wc * 32 + 8 * fq;
#pragma unroll
        for (int ai = 0; ai < 2; ++ai)
#pragma unroll
            for (int m = 0; m < 4; ++m) {
                const int row = row0 + ai * HALF + m * 16;
                const float rstd = __builtin_amdgcn_rsqf(SSQ[row] * (1.0f / D) + NORM_EPS);
#pragma unroll
                for (int bj = 0; bj < 2; ++bj) {
                    f32x4 v0 = acc[ai][bj][m][0] * rstd, v1 = acc[ai][bj][m][1] * rstd;
                    const int col = pn * BM + bj * HALF + cw;
                    if (pn == 36) {
                        if (col < 9216 + 16) { float* p = BA + (size_t)row * 16 + (col - 9216); *(f32x4*)p = v0; *(f32x4*)(p + 4) = v1; }
                        continue;
                    }
                    bf16_t* dst;
                    if (pn < 12) dst = QKV + (size_t)row * CONVCH + col;
                    else if (pn < 16) { dst = ZS + (size_t)row * 1024 + (col - 3072);
#pragma unroll
                        for (int j = 0; j < 4; ++j) { v0[j] = siluf_(v0[j]); v1[j] = siluf_(v1[j]); } }
                    else if (pn < 20) { const int c = col - 4096, g = c >> 4, cc = c & 15;
                        if (row < NPROMPT) { const int b = row >> 11, t = row & 2047; dst = S5A + ((size_t)(g * 512 + b * 128 + (t >> 4)) * 384 + (t & 15) * 16 + cc); }
                        else dst = S5US + (size_t)(row - NPROMPT) * 1024 + c; }
                    else { dst = (pn < 28) ? SGD + (size_t)row * D + (col - 5120) : SGS + (size_t)row * D + (col - 7168);
#pragma unroll
                        for (int j = 0; j < 4; ++j) { v0[j] = sigmoidf_(v0[j]); v1[j] = sigmoidf_(v1[j]); } }
                    u32x4 w; w.x = cvt_pk_bf16(v0[0], v0[1]); w.y = cvt_pk_bf16(v0[2], v0[3]); w.z = cvt_pk_bf16(v1[0], v1[1]); w.w = cvt_pk_bf16(v1[2], v1[3]);
                    *(u32x4*)dst = w;
                }
            }
    }
};
struct EpiGlu {
    static constexpr bool PERM = true;
    const bf16_t* G5; bf16_t* G5G;
    __device__ __forceinline__ void operator()(const f32x4 (&acc)[2][2][4][2], const Unit& u, int wr, int wc, int fr, int fq) const {
        const int row0 = u.pm * BM + wr * 64 + fr, col0 = u.pn * BM + wc * 32 + 8 * fq;
#pragma unroll
        for (int ai = 0; ai < 2; ++ai)
#pragma unroll
            for (int m = 0; m < 4; ++m) {
                const size_t ro = (size_t)(row0 + ai * HALF + m * 16) * PK1 + col0;
#pragma unroll
                for (int bj = 0; bj < 2; ++bj) {
                    const u32x4 g = *(const u32x4*)(G5 + ro + bj * HALF);
                    const f32x4 a0 = acc[ai][bj][m][0], a1 = acc[ai][bj][m][1];
                    u32x4 w;
                    w.x = cvt_pk_bf16(bflo(g.x) * sigmoidf_(a0[0]), bfhi(g.x) * sigmoidf_(a0[1]));
                    w.y = cvt_pk_bf16(bflo(g.y) * sigmoidf_(a0[2]), bfhi(g.y) * sigmoidf_(a0[3]));
                    w.z = cvt_pk_bf16(bflo(g.z) * sigmoidf_(a1[0]), bfhi(g.z) * sigmoidf_(a1[1]));
                    w.w = cvt_pk_bf16(bflo(g.w) * sigmoidf_(a1[2]), bfhi(g.w) * sigmoidf_(a1[3]));
                    *(u32x4*)(G5G + (size_t)(row0 + ai * HALF + m * 16) * PK2 + 1024 + col0 + bj * HALF) = w;
                }
            }
    }
};
struct EpiBrM {
    static constexpr bool PERM = true, HAS_MID = true;
    const bf16_t *SGD, *SGS; bf16_t* MERGED;
    __device__ __forceinline__ void mid(f32x4 (&acc)[2][2][4][2], const Unit& u, int wr, int wc, int fr, int fq) const {
        int row0 = u.pm * BM + wr * 64 + fr, col0 = u.pn * BM + wc * 32 + 8 * fq;
        asm volatile("" : "+v"(row0), "+v"(col0));
#pragma unroll
        for (int ai = 0; ai < 2; ++ai)
#pragma unroll
            for (int m2 = 0; m2 < 2; ++m2) {
                u32x4 gdv[2][2], gsv[2][2];
#pragma unroll
                for (int mm = 0; mm < 2; ++mm) { const size_t ro = (size_t)(row0 + ai * HALF + (2 * m2 + mm) * 16) * D + col0;
#pragma unroll
                    for (int bj = 0; bj < 2; ++bj) { gdv[mm][bj] = *(const u32x4*)(SGD + ro + bj * HALF); gsv[mm][bj] = *(const u32x4*)(SGS + ro + bj * HALF); } }
#pragma unroll
                for (int mm = 0; mm < 2; ++mm) { const int m = 2 * m2 + mm;
#pragma unroll
                    for (int bj = 0; bj < 2; ++bj) {
                        const u32x4 gd = gdv[mm][bj], gs = gsv[mm][bj];
                        const unsigned dw[4] = {gd.x, gd.y, gd.z, gd.w}, sw[4] = {gs.x, gs.y, gs.z, gs.w};
#pragma unroll
                        for (int j = 0; j < 4; ++j) {
                            const float r0 = bflo(dw[j]) * __builtin_amdgcn_rcpf(fmaxf(bflo(sw[j]), 9.5367431640625e-07f)), r1 = bfhi(dw[j]) * __builtin_amdgcn_rcpf(fmaxf(bfhi(sw[j]), 9.5367431640625e-07f));
                            acc[ai][bj][m][j >> 1][2 * (j & 1)] *= r0; acc[ai][bj][m][j >> 1][2 * (j & 1) + 1] *= r1; }
                    } }
                asm volatile("" ::: "memory");
            }
    }
    __device__ __forceinline__ void operator()(const f32x4 (&acc)[2][2][4][2], const Unit& u, int wr, int wc, int fr, int fq) const {
        const int row0 = u.pm * BM + wr * 64 + fr, col0 = u.pn * BM + wc * 32 + 8 * fq;
#pragma unroll
        for (int ai = 0; ai < 2; ++ai) {
            u32x4 gv[4][2];
#pragma unroll
            for (int m = 0; m < 4; ++m)
#pragma unroll
                for (int bj = 0; bj < 2; ++bj) gv[m][bj] = *(const u32x4*)(SGS + (size_t)(row0 + ai * HALF + m * 16) * D + col0 + bj * HALF);
#pragma unroll
            for (int m = 0; m < 4; ++m) {
                const size_t ro = (size_t)(row0 + ai * HALF + m * 16) * PK2 + col0;
#pragma unroll
                for (int bj = 0; bj < 2; ++bj) {
                    const u32x4 g = gv[m][bj];
                    const f32x4 a0 = acc[ai][bj][m][0], a1 = acc[ai][bj][m][1];
                    const float c = 9.5367431640625e-07f;
                    u32x4 w; w.x = cvt_pk_bf16(fmaxf(bflo(g.x), c) * a0[0], fmaxf(bfhi(g.x), c) * a0[1]); w.y = cvt_pk_bf16(fmaxf(bflo(g.y), c) * a0[2], fmaxf(bfhi(g.y), c) * a0[3]);
                    w.z = cvt_pk_bf16(fmaxf(bflo(g.z), c) * a1[0], fmaxf(bfhi(g.z), c) * a1[1]); w.w = cvt_pk_bf16(fmaxf(bflo(g.w), c) * a1[2], fmaxf(bfhi(g.w), c) * a1[3]);
                    *(u32x4*)(MERGED + ro + bj * HALF) = w;
                }
            }
            asm volatile("" ::: "memory");
        }
    }
};
struct EpiGate {
    static constexpr bool PERM = true;
    const bf16_t* GATE; bf16_t* OUT;
    __device__ __forceinline__ void operator()(const f32x4 (&acc)[2][2][4][2], const Unit& u, int wr, int wc, int fr, int fq) const {
        const int row0 = u.pm * BM + wr * 64 + fr, col0 = u.pn * BM + wc * 32 + 8 * fq;
#pragma unroll
        for (int ai = 0; ai < 2; ++ai)
#pragma unroll
            for (int m = 0; m < 4; ++m) {
                const size_t ro = (size_t)(row0 + ai * HALF + m * 16) * D + col0, rp = (size_t)(row0 + ai * HALF + m * 16) * PK2 + col0;
#pragma unroll
                for (int bj = 0; bj < 2; ++bj) {
                    const u32x4 g = *(const u32x4*)(GATE + ro + bj * HALF);
                    const f32x4 a0 = acc[ai][bj][m][0], a1 = acc[ai][bj][m][1];
                    u32x4 w; w.x = cvt_pk_bf16(bflo(g.x) * a0[0], bfhi(g.x) * a0[1]); w.y = cvt_pk_bf16(bflo(g.y) * a0[2], bfhi(g.y) * a0[3]);
                    w.z = cvt_pk_bf16(bflo(g.z) * a1[0], bfhi(g.z) * a1[1]); w.w = cvt_pk_bf16(bflo(g.w) * a1[2], bfhi(g.w) * a1[3]);
                    *(u32x4*)(OUT + rp + bj * HALF) = w;
                }
                asm volatile("" ::: "memory");
            }
    }
};
struct EpiRes {
    static constexpr bool PERM = false;
    const float* XP; const float* XS;
    float* X; bf16_t* XB; float* SSQ;
    __device__ __forceinline__ void operator()(const f32x4 (&acc)[2][2][4][2], const Unit& u, int wr, int wc, int fr, int fq) const {
        const int row0 = u.pm * BM + wr * 64 + fr, col0 = u.pn * BM + wc * 32 + 4 * fq;
#pragma unroll
        for (int ai = 0; ai < 2; ++ai) {
            f32x4 xv[4][2][2];
#pragma unroll
            for (int m = 0; m < 4; ++m) { const int row = row0 + ai * HALF + m * 16;
                const float* xo = (row < NPROMPT ? XP + (size_t)row * D : XS + (size_t)(row - NPROMPT) * D) + col0;
#pragma unroll
                for (int bj = 0; bj < 2; ++bj)
#pragma unroll
                    for (int n = 0; n < 2; ++n) xv[m][bj][n] = (row < MR) ? *(const f32x4*)(xo + bj * HALF + n * 16) : (f32x4){0.f, 0.f, 0.f, 0.f}; }
#pragma unroll
            for (int m = 0; m < 4; ++m) {
                const int row = row0 + ai * HALF + m * 16;
                float ss = 0.f;
                if (row < MR) {
                    float* xn = X + (size_t)row * D + col0; bf16_t* xb = XB + (size_t)row * PK2 + col0;
#pragma unroll
                    for (int bj = 0; bj < 2; ++bj)
#pragma unroll
                        for (int n = 0; n < 2; ++n) {
                            const f32x4 v = xv[m][bj][n] + acc[ai][bj][m][n];
                            *(f32x4*)(xn + bj * HALF + n * 16) = v;
                            u32x2 w; w.x = cvt_pk_bf16(v[0], v[1]); w.y = cvt_pk_bf16(v[2], v[3]);
                            *(u32x2*)(xb + bj * HALF + n * 16) = w;
                            ss += (v[0] * v[0] + v[1] * v[1]) + (v[2] * v[2] + v[3] * v[3]);
                        }
                }
                ss += __shfl_xor(ss, 16); ss += __shfl_xor(ss, 32);
                if (fq == 0 && row < MR) atomicAdd(SSQ + row, ss);
            }
            asm volatile("" ::: "memory");
        }
    }
};
struct EpiGU {
    static constexpr bool PERM = true;
    bf16_t* ACT; const float* SSQ;
    __device__ __forceinline__ void operator()(const f32x4 (&acc)[2][2][4][2], const Unit& u, int wr, int wc, int fr, int fq) const {
        const int row0 = u.pm * BM + wr * 64 + fr, col0 = u.pn * HALF + wc * 32 + 8 * fq;
#pragma unroll
        for (int ai = 0; ai < 2; ++ai)
#pragma unroll
            for (int m = 0; m < 4; ++m) {
                const int row = row0 + ai * HALF + m * 16;
                const float rstd = __builtin_amdgcn_rsqf(SSQ[row] * (1.0f / D) + NORM_EPS);
                float r[8];
#pragma unroll
                for (int n = 0; n < 2; ++n)
#pragma unroll
                    for (int j = 0; j < 4; ++j) r[n * 4 + j] = siluf_(acc[ai][0][m][n][j] * rstd) * (acc[ai][1][m][n][j] * rstd);
                u32x4 w; w.x = cvt_pk_bf16(r[0], r[1]); w.y = cvt_pk_bf16(r[2], r[3]); w.z = cvt_pk_bf16(r[4], r[5]); w.w = cvt_pk_bf16(r[6], r[7]);
                *(u32x4*)(ACT + (size_t)row * PK5 + col0) = w;
            }
    }
};
struct EpiPart {
    static constexpr bool PERM = false;
    float* P;
    __device__ __forceinline__ void operator()(const f32x4 (&acc)[2][2][4][2], const Unit& u, int wr, int wc, int fr, int fq) const {
        const int row0 = wr * 64 + fr, col0 = u.pn * BM + wc * 32 + 4 * fq;
#pragma unroll
        for (int m = 0; m < 4; ++m) { float* p = P + (size_t)(row0 + m * 16) * D + col0;
#pragma unroll
            for (int bj = 0; bj < 2; ++bj)
#pragma unroll
                for (int n = 0; n < 2; ++n) *(f32x4*)(p + bj * HALF + n * 16) = acc[0][bj][m][n]; }
    }
};
struct EpiS5L {
    static constexpr bool PERM = false;
    float* L;
    __device__ __forceinline__ void operator()(const f32x4 (&acc)[2][2][4][2], const Unit& u, int wr, int wc, int fr, int fq) const {
        const int row0 = u.pm * BM + wr * 64 + fr, col0 = wc * 32 + 4 * fq;
#pragma unroll
        for (int ai = 0; ai < 2; ++ai)
#pragma unroll
            for (int m = 0; m < 4; ++m) { float* p = L + (size_t)(row0 + ai * HALF + m * 16) * 128 + col0;
#pragma unroll
                for (int n = 0; n < 2; ++n) *(f32x4*)(p + n * 16) = acc[ai][0][m][n]; }
    }
};
struct EpiS5Y {
    static constexpr bool PERM = true;
    bf16_t* G5;
    __device__ __forceinline__ void operator()(const f32x4 (&acc)[2][2][4][2], const Unit& u, int wr, int wc, int fr, int fq) const {
        const int g = u.pm >> 1, cbase = 64 * wr + fr, t0 = 2 * wc + (fq >> 1), c0 = 8 * (fq & 1);
#pragma unroll
        for (int ai = 0; ai < 2; ++ai) {
            const int b = 2 * (u.pm & 1) + ai;
#pragma unroll
            for (int m = 0; m < 4; ++m) {
                bf16_t* p = G5 + (size_t)(b * SEQ + (cbase + 16 * m) * 16 + t0) * PK1 + g * 16 + c0;
#pragma unroll
                for (int bj = 0; bj < 2; ++bj) {
                    const f32x4 a0 = acc[ai][bj][m][0], a1 = acc[ai][bj][m][1];
                    u32x4 w; w.x = cvt_pk_bf16(geluf_(a0[0]), geluf_(a0[1])); w.y = cvt_pk_bf16(geluf_(a0[2]), geluf_(a0[3]));
                    w.z = cvt_pk_bf16(geluf_(a1[0]), geluf_(a1[1])); w.w = cvt_pk_bf16(geluf_(a1[2]), geluf_(a1[3]));
                    *(u32x4*)(p + (size_t)(8 * bj) * PK1) = w;
                }
                asm volatile("" ::: "memory");
            }
        }
    }
};
}

struct Args {
    const float* in[29];
    float* out; unsigned char* ws;
    int ph_lo, ph_hi, use_bar, pad;
};
enum { I_XP = 0, I_XS, I_SCONV, I_SSSM, I_S5RE, I_S5IM, I_N1, I_WIN, I_CONVW, I_ALOG, I_DTB, I_DNNW, I_WBRDN, I_LRE, I_LIM, I_LDT, I_BRE, I_BIM, I_CRE, I_CIM, I_DS, I_WGLU, I_WBRS5, I_WOUT, I_N2, I_WG, I_WU, I_WD, I_NF };
constexpr size_t O_YP = 0, O_YS = 16777216, O_PCONV = 17039360, O_PSSM = 17113088, O_PS5RE = 18161664, O_PS5IM = 18194432, O_SCONV = 18227200, O_SSSM = 20586496, O_SS5RE = 54140928, O_SS5IM = 55189504, O_END = 56238080;

typedef const __attribute__((address_space(4))) Args CArgs;
struct Frame {
    LAS unsigned char* lds;
    int tid, lane, wave, G, bx, vb;
    unsigned char* ws; float* out;
};

__device__ __forceinline__ void p0_transpose_item(const float* W, int ldw, int src, int nvalid, const float* scale, bf16_t* WT, int ldt, int nrow0, int k0, LAS float* scr, int lane) {
    const int l16 = lane & 15, r4 = lane >> 4;
    f32x4 v[16];
    const bool ok = (4 * l16 < nvalid);
#pragma unroll
    for (int i = 0; i < 16; ++i) v[i] = ok ? __builtin_nontemporal_load((const f32x4*)(W + (size_t)(k0 + 4 * i + r4) * ldw + src + 4 * l16)) : (f32x4){0.f, 0.f, 0.f, 0.f};
#pragma unroll
    for (int i = 0; i < 16; ++i) { const int kk = 4 * i + r4; f32x4 x = v[i]; if (scale) x = x * scale[k0 + kk];
        LAS float* s = scr + kk * 65 + 4 * l16; s[0] = x[0]; s[1] = x[1]; s[2] = x[2]; s[3] = x[3]; }
    LDS_WAIT(); asm volatile("" ::: "memory");
    const int c = lane & 7;
#pragma unroll
    for (int j = 0; j < 8; ++j) { const int n = (lane >> 3) + 8 * j; const LAS float* s = scr + (8 * c) * 65 + n;
        u32x4 o; o.x = cvt_pk_bf16(s[0 * 65], s[1 * 65]); o.y = cvt_pk_bf16(s[2 * 65], s[3 * 65]); o.z = cvt_pk_bf16(s[4 * 65], s[5 * 65]); o.w = cvt_pk_bf16(s[6 * 65], s[7 * 65]);
        *(u32x4*)(WT + (size_t)(nrow0 + n) * ldt + k0 + 8 * c) = o; }
    LDS_WAIT(); asm volatile("" ::: "memory");
}

__device__ __forceinline__ void p0_s5_precompute(const Frame& F, const CArgs& a, int l, int g) {
    LAS float* apr = (LAS float*)F.lds;
    LAS float* api = apr + 17 * 64;
    LAS float* bbr = api + 17 * 64;
    LAS float* bbi = bbr + 1024;
    LAS float* cre = bbi + 1024;
    LAS float* cim = cre + 1024;
    LAS float* kt = cim + 1024;
    const int tid = F.tid;
    __syncthreads();
    if (tid < 64) {
        const int p = tid;
        const float dt = expf(a.in[I_LDT][l * 64 + g]);
        const float lr = a.in[I_LRE][(l * 64 + g) * 64 + p], li = a.in[I_LIM][(l * 64 + g) * 64 + p];
        for (int d = 0; d <= 16; ++d) { const float mag = expf(lr * dt * (float)d), ang = li * dt * (float)d; apr[d * 64 + p] = mag * cosf(ang); api[d * 64 + p] = mag * sinf(ang); }
        const float ar = apr[64 + p], ai = api[64 + p], nr = ar - 1.0f, den = lr * lr + li * li;
        const float fr = (nr * lr + ai * li) / den, fi = (ai * lr - nr * li) / den;
        float* bb = (float*)(F.ws + WS_BBAR) + ((size_t)(l * 64 + g) * 64 + p) * 32;
        for (int c = 0; c < 16; ++c) { const float br = a.in[I_BRE][((size_t)(l * 64 + g) * 64 + p) * 16 + c], bi = a.in[I_BIM][((size_t)(l * 64 + g) * 64 + p) * 16 + c];
            const float xr = fr * br - fi * bi, xi = fr * bi + fi * br; bbr[p * 16 + c] = xr; bbi[p * 16 + c] = xi; bb[c] = xr; bb[16 + c] = xi; }
        float* a16 = (float*)(F.ws + WS_A16) + ((size_t)(l * 64 + g) * 64 + p) * 2;
        a16[0] = apr[16 * 64 + p]; a16[1] = api[16 * 64 + p];
    }
    for (int i = tid; i < 1024; i += 512) { cre[i] = a.in[I_CRE][(size_t)(l * 64 + g) * 1024 + i]; cim[i] = a.in[I_CIM][(size_t)(l * 64 + g) * 1024 + i]; }
    __syncthreads();
    for (int e = tid; e < 4096; e += 512) { const int d = e >> 8, c = (e >> 4) & 15, cc = e & 15; float s = 0.f;
        for (int p = 0; p < 64; ++p) { const float pr = apr[d * 64 + p], pi = api[d * 64 + p], br = bbr[p * 16 + cc], bi = bbi[p * 16 + cc];
            const float gr = pr * br - pi * bi, gi = pr * bi + pi * br; s += cre[c * 64 + p] * gr - cim[c * 64 + p] * gi; }
        if (d == 0 && c == cc) s += a.in[I_DS][l * 1024 + g * 16 + c];
        kt[e] = s; }
    __syncthreads();
    bf16_t* bty = (bf16_t*)(F.ws + WS_W0 + l * WS_WSTRIDE + WO_BTY) + (size_t)g * 256 * 384;
    for (int ch = tid; ch < 256 * 48; ch += 512) {
        const int row = ch / 48, c8 = (ch % 48) * 8, t = row >> 4, c = row & 15; float v[8];
#pragma unroll
        for (int j = 0; j < 8; ++j) { const int col = c8 + j;
            if (col < 256) { const int s = col >> 4, cc = col & 15; v[j] = (s <= t) ? kt[((t - s) * 16 + c) * 16 + cc] : 0.f; }
            else if (col < 320) { const int p = col - 256; v[j] = cre[c * 64 + p] * apr[(t + 1) * 64 + p] - cim[c * 64 + p] * api[(t + 1) * 64 + p]; }
            else { const int p = col - 320; v[j] = -(cre[c * 64 + p] * api[(t + 1) * 64 + p] + cim[c * 64 + p] * apr[(t + 1) * 64 + p]); } }
        u32x4 o; o.x = pk2(v[0], v[1]); o.y = pk2(v[2], v[3]); o.z = pk2(v[4], v[5]); o.w = pk2(v[6], v[7]);
        *(u32x4*)(bty + (size_t)row * 384 + c8) = o; }
    bf16_t* btl = (bf16_t*)(F.ws + WS_W0 + l * WS_WSTRIDE + WO_BTL) + (size_t)g * 256 * 256;
    for (int ch = tid; ch < 256 * 32; ch += 512) {
        const int row = ch >> 5, c8 = (ch & 31) * 8; float v[8];
#pragma unroll
        for (int j = 0; j < 8; ++j) { const int col = c8 + j, s = col >> 4, cc = col & 15;
            if (row < 128) { const int p = row & 63, d = 15 - s; const float pr = apr[d * 64 + p], pi = api[d * 64 + p], br = bbr[p * 16 + cc], bi = bbi[p * 16 + cc];
                v[j] = (row < 64) ? (pr * br - pi * bi) : (pr * bi + pi * br); }
            else v[j] = 0.f; }
        u32x4 o; o.x = pk2(v[0], v[1]); o.y = pk2(v[2], v[3]); o.z = pk2(v[4], v[5]); o.w = pk2(v[6], v[7]);
        *(u32x4*)(btl + (size_t)row * 256 + c8) = o; }
    __syncthreads();
}

constexpr int P0_I0 = 32 * 145, P0_I1 = 16 * 32, P0_I2 = 16 * 16, P0_I3 = 16 * 32, P0_I4 = 32 * 32, P0_I5 = 32 * 176, P0_I6 = 88 * 32, P0_IL = P0_I0 + P0_I1 + P0_I2 + P0_I3 + P0_I4 + P0_I5 + P0_I6;
__device__ __forceinline__ void p0_item(const Frame& F, const CArgs& a, int it, LAS float* scr) {
    const int l = it / P0_IL; int r = it % P0_IL;
    unsigned char* wb = F.ws + WS_W0 + l * WS_WSTRIDE;
    if (r < P0_I0) { const int kb = r / 145, nb = r % 145, n0 = nb * 64; int src, nv = 64;
        if (n0 < 4096) src = n0; else if (n0 < 9216) src = n0 + 16; else { src = 4096; nv = 16; }
        p0_transpose_item(a.in[I_WIN] + (size_t)l * D * IN_DIM, IN_DIM, src, nv, a.in[I_N1] + l * D, (bf16_t*)(wb + WO_IN), PK2, n0, kb * 64, scr, F.lane); return; } r -= P0_I0;
    if (r < P0_I1) { const int kb = r / 32, nb = r % 32; p0_transpose_item(a.in[I_WBRDN] + (size_t)l * 1024 * D, D, nb * 64, 64, nullptr, (bf16_t*)(wb + WO_BRDN), PK2, nb * 64, kb * 64, scr, F.lane); return; } r -= P0_I1;
    if (r < P0_I2) { const int kb = r / 16, nb = r % 16; p0_transpose_item(a.in[I_WGLU] + (size_t)l * 1024 * 1024, 1024, nb * 64, 64, nullptr, (bf16_t*)(wb + WO_GLU), PK1, nb * 64, kb * 64, scr, F.lane); return; } r -= P0_I2;
    if (r < P0_I3) { const int kb = r / 32, nb = r % 32; p0_transpose_item(a.in[I_WBRS5] + (size_t)l * 1024 * D, D, nb * 64, 64, nullptr, (bf16_t*)(wb + WO_BRDN) + 1024, PK2, nb * 64, kb * 64, scr, F.lane); return; } r -= P0_I3;
    if (r < P0_I4) { const int kb = r / 32, nb = r % 32; p0_transpose_item(a.in[I_WOUT] + (size_t)l * D * D, D, nb * 64, 64, nullptr, (bf16_t*)(wb + WO_OUT), PK2, nb * 64, kb * 64, scr, F.lane); return; } r -= P0_I4;
    if (r < P0_I5) { const int kb = r / 176, nb = r % 176, n0 = nb * 64, tile = n0 >> 8, j = n0 & 255;
        const float* W = (j < 128 ? a.in[I_WG] : a.in[I_WU]) + (size_t)l * D * FF;
        p0_transpose_item(W, FF, tile * 128 + (j & 127), 64, a.in[I_N2] + l * D, (bf16_t*)(wb + WO_GU), PK2, n0, kb * 64, scr, F.lane); return; } r -= P0_I5;
    { const int kb = r / 32, nb = r % 32; p0_transpose_item(a.in[I_WD] + (size_t)l * FF * D, D, nb * 64, 64, nullptr, (bf16_t*)(wb + WO_D), PK5, nb * 64, kb * 64, scr, F.lane); }
}
__device__ __forceinline__ void convert_pull(const Frame& F, const CArgs& a, int npulls) {
    volatile LAS unsigned* MISC = (volatile LAS unsigned*)(F.lds + MISC_OFF);
    LAS float* scr = (LAS float*)(F.lds + F.wave * 16640);
    unsigned* qhead = (unsigned*)(F.ws + WS_CTL) + 12288;
    for (int p = 0; p < npulls; ++p) {
        __syncthreads();
        if (F.tid == 0) MISC[16] = xb_add(qhead, 8u);
        __syncthreads();
        const int base = __builtin_amdgcn_readfirstlane((int)MISC[16]);
        if (base >= P0_IL) break;
        if (base + F.wave < P0_IL) p0_item(F, a, P0_IL + base + F.wave, scr);
    }
    __syncthreads();
}
__device__ __forceinline__ void p0_prologue(const Frame& F, const CArgs& a) {
    if (F.bx < 128) p0_s5_precompute(F, a, F.bx >> 6, F.bx & 63);
    __syncthreads();
    LAS float* scr = (LAS float*)(F.lds + F.wave * 16640);
    const int gw = F.bx * 8 + F.wave, NGW = F.G * 8;
    for (int it = gw; it < P0_IL; it += NGW) p0_item(F, a, it, scr);
    const int gt = F.bx * 512 + F.tid, NGT = F.G * 512;
    for (int l = 0; l < 2; ++l) { u32x4* z = (u32x4*)(F.ws + WS_W0 + l * WS_WSTRIDE + WO_IN + (size_t)9280 * PK2 * 2);
        for (int i = gt; i < 192 * PK2 * 2 / 16; i += NGT) z[i] = (u32x4){0u, 0u, 0u, 0u}; }
    { float* s = (float*)(F.ws + WS_SSQ) + MP; for (int i = gt; i < 4 * MP; i += NGT) s[i] = 0.f; }
    float* ssq0 = (float*)(F.ws + WS_SSQ); bf16_t* XB = (bf16_t*)(F.ws + WS_XB);
    for (int m = gw; m < MR; m += NGW) {
        const float* xr = (m < NPROMPT) ? a.in[I_XP] + (size_t)m * D : a.in[I_XS] + (size_t)(m - NPROMPT) * D;
        const f32x4* x4 = (const f32x4*)xr + F.lane; u32x2* o = (u32x2*)(XB + (size_t)m * PK2) + F.lane; float s = 0.f;
#pragma unroll
        for (int j = 0; j < 8; ++j) { const f32x4 v = x4[64 * j]; s += (v[0] * v[0] + v[1] * v[1]) + (v[2] * v[2] + v[3] * v[3]);
            u32x2 w; w.x = pk2(v[0], v[1]); w.y = pk2(v[2], v[3]); o[64 * j] = w; }
        s = wave_sum(s); if (F.lane == 0) ssq0[m] = s;
    }
}


__device__ __forceinline__ void conv_state_out(const Frame& F, const CArgs& a, int l) {
    const int gt = (F.bx - 128) * 512 + F.tid, NGT = 124 * 512;
    const bf16_t* QKV = (const bf16_t*)(F.ws + WS_QKV);
    float* pc = F.out + O_PCONV + (size_t)l * NB * 3 * CONVCH;
    for (int i = gt; i < NB * 3 * CONVCH; i += NGT) { const int ch = i % CONVCH, j = (i / CONVCH) % 3, b = i / (3 * CONVCH);
        pc[i] = bf2f(QKV[(size_t)(b * SEQ + SEQ - 3 + j) * CONVCH + ch]); }
    float* sc = F.out + O_SCONV + (size_t)l * NSAMP * 3 * CONVCH; const float* st = a.in[I_SCONV] + (size_t)l * NSAMP * 3 * CONVCH;
    for (int i = gt; i < NSAMP * 3 * CONVCH; i += NGT) { const int ch = i % CONVCH, j = (i / CONVCH) % 3, b = i / (3 * CONVCH);
        sc[i] = (j < 2) ? st[i + CONVCH] : bf2f(QKV[(size_t)(NPROMPT + b) * CONVCH + ch]); }
}


__device__ __forceinline__ void delta_seq(const Frame& F, const CArgs& a, int l, int h, int r0, int L, const float* conv0, const float* ssm0, float* ssm_out) {
    LAS float* raw = (LAS float*)F.lds;
    LAS float* qk = raw + 384;
    LAS float* part = qk + 256;
    LAS float* red = part + 512;
    const int tid = F.tid, lane = F.lane, wave = F.wave, dv = tid & 127, kg = tid >> 7;
    const bf16_t* QKV = (const bf16_t*)(F.ws + WS_QKV); const float* BA = (const float*)(F.ws + WS_BA); const bf16_t* ZS = (const bf16_t*)(F.ws + WS_ZS); bf16_t* ON = (bf16_t*)(F.ws + WS_ONG);
    const int ch = (tid < 384) ? ((tid >> 7) * 1024 + h * 128 + (tid & 127)) : 0;
    const float* cw = a.in[I_CONVW] + (size_t)l * 4 * CONVCH;
    const float cw0 = cw[ch], cw1 = cw[CONVCH + ch], cw2 = cw[2 * CONVCH + ch], cw3 = cw[3 * CONVCH + ch];
    float w0 = conv0 ? conv0[ch] : 0.f, w1 = conv0 ? conv0[CONVCH + ch] : 0.f, w2 = conv0 ? conv0[2 * CONVCH + ch] : 0.f;
    float s[32];
#pragma unroll
    for (int i = 0; i < 32; ++i) s[i] = ssm0 ? ssm0[(size_t)(kg * 32 + i) * 128 + dv] : 0.f;
    const float Aexp = expf(a.in[I_ALOG][l * NH + h]), dtb = a.in[I_DTB][l * NH + h], nw = a.in[I_DNNW][l * 128 + dv];
    __syncthreads();
    for (int t = 0; t < L; ++t) {
        const int r = r0 + t;
        if (tid < 384) { const float x = bf2f(QKV[(size_t)r * CONVCH + ch]); const float y = cw0 * w0 + cw1 * w1 + cw2 * w2 + cw3 * x; w0 = w1; w1 = w2; w2 = x; raw[tid] = siluf_(y); }
        __syncthreads();
        if (wave < 2) { const float v0 = raw[wave * 128 + lane], v1 = raw[wave * 128 + 64 + lane]; const float ss = wave_sum(v0 * v0 + v1 * v1);
            const float rs = (__builtin_amdgcn_rsqf(ss + 1e-6f)) * (wave == 0 ? 0.08838834764831845f : 1.0f); qk[wave * 128 + lane] = v0 * rs; qk[wave * 128 + 64 + lane] = v1 * rs; }
        __syncthreads();
        const float beta = sigmoidf_(BA[(size_t)r * 16 + h]), gg = -Aexp * softplusf_(BA[(size_t)r * 16 + 8 + h] + dtb), dec = expf(gg);
        float ks = 0.f;
#pragma unroll
        for (int i = 0; i < 32; ++i) { s[i] *= dec; ks += qk[128 + kg * 32 + i] * s[i]; }
        part[kg * 128 + dv] = ks;
        __syncthreads();
        const float vnew = (raw[256 + dv] - ((part[dv] + part[128 + dv]) + (part[256 + dv] + part[384 + dv]))) * beta;
        __syncthreads();
        float op = 0.f;
#pragma unroll
        for (int i = 0; i < 32; ++i) { s[i] += qk[128 + kg * 32 + i] * vnew; op += qk[kg * 32 + i] * s[i]; }
        part[kg * 128 + dv] = op;
        __syncthreads();
        const float o = (part[dv] + part[128 + dv]) + (part[256 + dv] + part[384 + dv]);
        const float ss = wave_sum(o * o); if (lane == 0) red[wave] = ss;
        __syncthreads();
        if (tid < 128) { const float rstd = __builtin_amdgcn_rsqf((red[0] + red[1]) * (1.0f / 128.0f) + NORM_EPS);
            const float z = bf2f(ZS[(size_t)r * 1024 + h * 128 + dv]); ON[(size_t)r * PK2 + h * 128 + dv] = (bf16_t)f2bf(o * rstd * nw * z); }
    }
#pragma unroll
    for (int i = 0; i < 32; ++i) ssm_out[(size_t)(kg * 32 + i) * 128 + dv] = s[i];
    __syncthreads();
}
__device__ __forceinline__ void s5_seq(const Frame& F, const CArgs& a, int l, int g, int b, bool sample, int L, const float* x0re, const float* x0im, float* ore, float* oim) {
    const int p = F.lane;
    const float dt = expf(a.in[I_LDT][l * 64 + g]);
    const float lr = a.in[I_LRE][(l * 64 + g) * 64 + p], li = a.in[I_LIM][(l * 64 + g) * 64 + p];
    const float mag = expf(lr * dt), ar = mag * cosf(li * dt), ai = mag * sinf(li * dt);
    const float* bb = (const float*)(F.ws + WS_BBAR) + ((size_t)(l * 64 + g) * 64 + p) * 32;
    float br[16], bi[16], cr[16], ci[16];
#pragma unroll
    for (int c = 0; c < 16; ++c) { br[c] = bb[c]; bi[c] = bb[16 + c]; cr[c] = a.in[I_CRE][((size_t)(l * 64 + g) * 16 + c) * 64 + p]; ci[c] = a.in[I_CIM][((size_t)(l * 64 + g) * 16 + c) * 64 + p]; }
    const float dsk = a.in[I_DS][l * 1024 + g * 16 + (p & 15)];
    float xr = x0re ? x0re[p] : 0.f, xi = x0im ? x0im[p] : 0.f;
    const bf16_t* S5A = (const bf16_t*)(F.ws + WS_S5A); const bf16_t* S5US = (const bf16_t*)(F.ws + WS_S5US); bf16_t* G5 = (bf16_t*)(F.ws + WS_G5);
    for (int t = 0; t < L; ++t) {
        const bf16_t* up = sample ? S5US + (size_t)b * 1024 + g * 16 : S5A + ((size_t)(g * 512 + b * 128 + (t >> 4)) * 384 + (t & 15) * 16);
        const u32x4 u0 = *(const u32x4*)up, u1 = *(const u32x4*)(up + 8);
        const float u[16] = {bflo(u0.x), bfhi(u0.x), bflo(u0.y), bfhi(u0.y), bflo(u0.z), bfhi(u0.z), bflo(u0.w), bfhi(u0.w), bflo(u1.x), bfhi(u1.x), bflo(u1.y), bfhi(u1.y), bflo(u1.z), bfhi(u1.z), bflo(u1.w), bfhi(u1.w)};
        float bur = 0.f, bui = 0.f;
#pragma unroll
        for (int c = 0; c < 16; ++c) { bur += br[c] * u[c]; bui += bi[c] * u[c]; }
        const float nxr = ar * xr - ai * xi + bur, nxi = ar * xi + ai * xr + bui; xr = nxr; xi = nxi;
        float y = 0.f, um = 0.f;
#pragma unroll
        for (int c = 0; c < 16; ++c) { const float v = wave_sum(cr[c] * xr - ci[c] * xi); if (p == c) { y = v; um = u[c]; } }
        if (p < 16) { y += dsk * um; const size_t row = sample ? (size_t)(NPROMPT + b) : (size_t)(b * SEQ + t); G5[row * PK1 + g * 16 + p] = (bf16_t)f2bf(geluf_(y)); }
    }
    ore[p] = xr; oim[p] = xi;
}


__device__ __forceinline__ void s5_sample_wave(const Frame& F, const CArgs& a, int l, int g, int b0) {
    const int p = F.lane;
    const float dt = expf(a.in[I_LDT][l * 64 + g]);
    const float lr = a.in[I_LRE][(l * 64 + g) * 64 + p], li = a.in[I_LIM][(l * 64 + g) * 64 + p];
    const float mag = expf(lr * dt), ar = mag * cosf(li * dt), ai = mag * sinf(li * dt);
    const float* bb = (const float*)(F.ws + WS_BBAR) + ((size_t)(l * 64 + g) * 64 + p) * 32;
    float br[16], bi[16], cr[16], ci[16];
#pragma unroll
    for (int c = 0; c < 16; ++c) { br[c] = bb[c]; bi[c] = bb[16 + c]; cr[c] = a.in[I_CRE][((size_t)(l * 64 + g) * 16 + c) * 64 + p]; ci[c] = a.in[I_CIM][((size_t)(l * 64 + g) * 16 + c) * 64 + p]; }
    const float dsk = a.in[I_DS][l * 1024 + g * 16 + (p & 15)];
    const bf16_t* S5US = (const bf16_t*)(F.ws + WS_S5US); bf16_t* G5 = (bf16_t*)(F.ws + WS_G5);
    float x0r[4], x0i[4]; u32x4 uu[4][2];
#pragma unroll
    for (int k = 0; k < 4; ++k) { const int b = b0 + 32 * k; const size_t so = ((size_t)(l * NSAMP + b) * 64 + g) * 64;
        x0r[k] = a.in[I_S5RE][so + p]; x0i[k] = a.in[I_S5IM][so + p];
        const bf16_t* up = S5US + (size_t)b * 1024 + g * 16; uu[k][0] = *(const u32x4*)up; uu[k][1] = *(const u32x4*)(up + 8); }
#pragma unroll
    for (int k = 0; k < 4; ++k) { const int b = b0 + 32 * k; const size_t so = ((size_t)(l * NSAMP + b) * 64 + g) * 64;
        const u32x4 u0 = uu[k][0], u1 = uu[k][1];
        const float u[16] = {bflo(u0.x), bfhi(u0.x), bflo(u0.y), bfhi(u0.y), bflo(u0.z), bfhi(u0.z), bflo(u0.w), bfhi(u0.w), bflo(u1.x), bfhi(u1.x), bflo(u1.y), bfhi(u1.y), bflo(u1.z), bfhi(u1.z), bflo(u1.w), bfhi(u1.w)};
        float bur = 0.f, bui = 0.f;
#pragma unroll
        for (int c = 0; c < 16; ++c) { bur += br[c] * u[c]; bui += bi[c] * u[c]; }
        const float xr = ar * x0r[k] - ai * x0i[k] + bur, xi = ar * x0i[k] + ai * x0r[k] + bui;
        float y = 0.f, um = 0.f;
#pragma unroll
        for (int c = 0; c < 16; ++c) { const float v = wave_sum(cr[c] * xr - ci[c] * xi); if (p == c) { y = v; um = u[c]; } }
        if (p < 16) { y += dsk * um; G5[(size_t)(NPROMPT + b) * PK1 + g * 16 + p] = (bf16_t)f2bf(geluf_(y)); }
        F.out[O_SS5RE + so + p] = xr; F.out[O_SS5IM + so + p] = xi; }
}
__device__ __forceinline__ void s5_chunk_scan(const Frame& F, int l, int g, int b) {
    const int p = F.lane;
    const float* a16 = (const float*)(F.ws + WS_A16) + ((size_t)(l * 64 + g) * 64 + p) * 2; const float ar = a16[0], ai = a16[1];
    const float* L = (const float*)(F.ws + WS_S5L) + (size_t)(g * 512 + b * 128) * 128;
    bf16_t* A = (bf16_t*)(F.ws + WS_S5A) + (size_t)(g * 512 + b * 128) * 384 + 256;
    float xr = 0.f, xi = 0.f;
    for (int k0 = 0; k0 < 128; k0 += 16) {
        float lr[16], li[16];
#pragma unroll
        for (int j = 0; j < 16; ++j) { lr[j] = L[(size_t)(k0 + j) * 128 + p]; li[j] = L[(size_t)(k0 + j) * 128 + 64 + p]; }
#pragma unroll
        for (int j = 0; j < 16; ++j) { A[(size_t)(k0 + j) * 384 + p] = (bf16_t)f2bf(xr); A[(size_t)(k0 + j) * 384 + 64 + p] = (bf16_t)f2bf(xi);
            const float nxr = ar * xr - ai * xi + lr[j], nxi = ar * xi + ai * xr + li[j]; xr = nxr; xi = nxi; }
    }
    F.out[O_PS5RE + ((size_t)(l * NB + b) * 64 + g) * 64 + p] = xr; F.out[O_PS5IM + ((size_t)(l * NB + b) * 64 + g) * 64 + p] = xi;
}

constexpr int PH_KT = 0, PH_QT = 17408, PH_VB = 34816, PH_KBG = 52224, PH_MISC = 69632, PH_HALF = 73728, PP = 136, TP = 72;
typedef short v4i16_t __attribute__((ext_vector_type(4)));
__device__ __forceinline__ s16x4 lds_tr16(const LAS bf16_t* p) { return __builtin_bit_cast(s16x4, __builtin_amdgcn_ds_read_tr16_b64_v4i16((LAS v4i16_t*)p)); }
__device__ __forceinline__ bf16x8 cat8(s16x4 a, s16x4 b) { return (bf16x8){a[0], a[1], a[2], a[3], b[0], b[1], b[2], b[3]}; }
__device__ __forceinline__ bf16x8 pack8(f32x4 a, f32x4 b) { u32x4 w; w.x = cvt_pk_bf16(a[0], a[1]); w.y = cvt_pk_bf16(a[2], a[3]); w.z = cvt_pk_bf16(b[0], b[1]); w.w = cvt_pk_bf16(b[2], b[3]); return __builtin_bit_cast(bf16x8, w); }
#define MFMA16(A, B, C) __builtin_amdgcn_mfma_f32_16x16x32_bf16((A), (B), (C), 0, 0, 0)

__device__ __forceinline__ void delta_prep_item(const Frame& F, const CArgs& a, int l, int b, int c, int hp) {
    const int half = F.wave >> 2, w4 = F.wave & 3, lane = F.lane, q = lane >> 4, c16 = lane & 15, h = 2 * hp + half;
    LAS unsigned char* hb = F.lds + half * PH_HALF;
    LAS bf16_t* Kt = (LAS bf16_t*)(hb + PH_KT); LAS bf16_t* Qt = (LAS bf16_t*)(hb + PH_QT); LAS bf16_t* Vb = (LAS bf16_t*)(hb + PH_VB); LAS bf16_t* Kbg = (LAS bf16_t*)(hb + PH_KBG);
    LAS float* Af = (LAS float*)(hb + PH_QT); LAS bf16_t* Tm = (LAS bf16_t*)(hb + PH_QT); LAS float* gcs = (LAS float*)(hb + PH_MISC);
    const int row0 = b * SEQ + c * 64;
    bf16_t* item = (bf16_t*)(F.ws + WS_PREP) + (size_t)((b * NH + h) * NCHUNK + c) * 36864;
    bf16_t* gW = item; bf16_t* gQD = item + 8192; bf16_t* gKD = item + 16384; bf16_t* gQK = item + 24576; bf16_t* gUT = item + 28672;
    if (w4 == 0) {
        const float* BA = (const float*)(F.ws + WS_BA) + (size_t)(row0 + lane) * 16;
        const float beta = sigmoidf_(BA[h]);
        float gc = -expf(a.in[I_ALOG][l * NH + h]) * softplusf_(BA[8 + h] + a.in[I_DTB][l * NH + h]);
#pragma unroll
        for (int o = 1; o < 64; o <<= 1) { const float t = __shfl_up(gc, o); if (lane >= o) gc += t; }
        const float glast = __shfl(gc, 63);
        gcs[lane] = gc; gcs[64 + lane] = beta; gcs[128 + lane] = expf(gc); gcs[192 + lane] = expf(glast - gc);
        if (lane == 0) ((float*)(F.ws + WS_DEC))[(b * NH + h) * NCHUNK + c] = expf(glast);
    }
    LDS_BAR();
    {
        const bf16_t* QKV = (const bf16_t*)(F.ws + WS_QKV); const int chq = h * 128 + 2 * lane;
        const float* cwp = a.in[I_CONVW] + (size_t)l * 4 * CONVCH;
        float cw[4][6];
#pragma unroll
        for (int i = 0; i < 4; ++i)
#pragma unroll
            for (int s = 0; s < 3; ++s) { const f32x2 v = *(const f32x2*)(cwp + (size_t)i * CONVCH + s * 1024 + chq); cw[i][2 * s] = v[0]; cw[i][2 * s + 1] = v[1]; }
#pragma unroll 1
        for (int hh = 0; hh < 2; ++hh) {
            unsigned pre[11][3];
#pragma unroll
            for (int i = 0; i < 11; ++i) { const int tok = 16 * w4 + 8 * hh - 3 + i; const bool ok = (c > 0) || (tok >= 0);
#pragma unroll
                for (int s = 0; s < 3; ++s) pre[i][s] = ok ? *(const unsigned*)(QKV + (size_t)(row0 + tok) * CONVCH + s * 1024 + chq) : 0u; }
#pragma unroll
            for (int tt = 0; tt < 8; ++tt) {
                const int t = 16 * w4 + 8 * hh + tt; float y[6];
#pragma unroll
                for (int s = 0; s < 3; ++s) {
                    float y0 = 0.f, y1 = 0.f;
#pragma unroll
                    for (int i = 0; i < 4; ++i) { y0 += cw[i][2 * s] * bflo(pre[tt + i][s]); y1 += cw[i][2 * s + 1] * bfhi(pre[tt + i][s]); }
                    y[2 * s] = siluf_(y0); y[2 * s + 1] = siluf_(y1);
                }
                const float ssq = wave_sum(y[0] * y[0] + y[1] * y[1]), ssk = wave_sum(y[2] * y[2] + y[3] * y[3]);
                const float rq = (__builtin_amdgcn_rsqf(ssq + 1e-6f)) * 0.08838834764831845f, rk = __builtin_amdgcn_rsqf(ssk + 1e-6f);
                const float beta = gcs[64 + t], egc = gcs[128 + t], ekd = gcs[192 + t];
                const float q0 = y[0] * rq, q1 = y[1] * rq, k0 = y[2] * rk, k1 = y[3] * rk;
                *(LAS unsigned*)(Kt + t * PP + 2 * lane) = pk2(k0, k1);
                *(LAS unsigned*)(Qt + t * PP + 2 * lane) = pk2(q0, q1);
                *(LAS unsigned*)(Vb + t * PP + 2 * lane) = pk2(y[4] * beta, y[5] * beta);
                *(LAS unsigned*)(Kbg + t * PP + 2 * lane) = pk2(k0 * beta * egc, k1 * beta * egc);
                *(unsigned*)(gQD + t * 128 + 2 * lane) = pk2(q0 * egc, q1 * egc);
                *(unsigned*)(gKD + t * 128 + 2 * lane) = pk2(k0 * ekd, k1 * ekd);
            }
        }
    }
    LDS_BAR();
    f32x4 kk[4];
    {
        bf16x8 kf[4], qf[4];
#pragma unroll
        for (int ks = 0; ks < 4; ++ks) { kf[ks] = *(const LAS bf16x8*)(Kt + (16 * w4 + c16) * PP + 32 * ks + 8 * q); qf[ks] = *(const LAS bf16x8*)(Qt + (16 * w4 + c16) * PP + 32 * ks + 8 * q); }
        const float gci = gcs[16 * w4 + c16];
#pragma unroll
        for (int mt = 0; mt < 4; ++mt) {
            f32x4 pq = (f32x4){0.f, 0.f, 0.f, 0.f}, pk = (f32x4){0.f, 0.f, 0.f, 0.f};
#pragma unroll
            for (int ks = 0; ks < 4; ++ks) { const bf16x8 kr = *(const LAS bf16x8*)(Kt + (16 * mt + c16) * PP + 32 * ks + 8 * q);
                pq = MFMA16(kr, qf[ks], pq);
                pk = MFMA16(kf[ks], kr, pk); }
            {   const int i = 16 * w4 + c16; float v[4];
#pragma unroll
                for (int r = 0; r < 4; ++r) { const int j = 16 * mt + 4 * q + r; v[r] = (i >= j) ? pq[r] * __expf(gci - gcs[j]) : 0.f; }
                u32x2 w; w.x = pk2(v[0], v[1]); w.y = pk2(v[2], v[3]); *(u32x2*)(gQK + i * 64 + 16 * mt + 4 * q) = w; }
            {   const int j = 16 * mt + c16; const float gcj = gcs[j];
#pragma unroll
                for (int r = 0; r < 4; ++r) { const int i = 16 * w4 + 4 * q + r; kk[mt][r] = (i > j) ? gcs[64 + i] * pk[r] * __expf(gcs[i] - gcj) : 0.f; } }
        }
    }
    LDS_BAR();
    constexpr int AP = 68;
#pragma unroll
    for (int mt = 0; mt < 4; ++mt)
#pragma unroll
        for (int r = 0; r < 4; ++r) Af[(16 * w4 + 4 * q + r) * AP + 16 * mt + c16] = kk[mt][r];
    LDS_BAR();
    LAS float* Tf = (LAS float*)(hb + PH_KT);
#define MM16(x, P, Q) do { const LAS float* P_ = (P) + (lane >> 2) * AP; const LAS float* Q_ = (Q) + 4 * (lane & 3); \
        _Pragma("unroll") for (int k4 = 0; k4 < 4; ++k4) { const f32x4 pv = *(const LAS f32x4*)(P_ + 4 * k4); \
            _Pragma("unroll") for (int e = 0; e < 4; ++e) (x) = (x) + pv[e] * *(const LAS f32x4*)(Q_ + (4 * k4 + e) * AP); } } while (0)
#define BLK(M, bi, bj) ((M) + (16 * (bi)) * AP + 16 * (bj))
    if (w4 == 0) {
        const int bk = lane >> 4, cc = lane & 15; const LAS float* Ab = BLK(Af, bk, bk); float t[16];
#pragma unroll
        for (int i = 0; i < 16; ++i) {
            float sp[4] = {(i == cc) ? 1.0f : 0.0f, 0.f, 0.f, 0.f};
#pragma unroll
            for (int j4 = 0; j4 < (i + 3) / 4; ++j4) { const f32x4 av = *(const LAS f32x4*)(Ab + i * AP + 4 * j4);
#pragma unroll
                for (int e = 0; e < 4; ++e) if (4 * j4 + e < i) sp[e] -= av[e] * t[4 * j4 + e]; }
            t[i] = (sp[0] + sp[1]) + (sp[2] + sp[3]);
        }
#pragma unroll
        for (int i = 0; i < 16; ++i) BLK(Tf, bk, bk)[i * AP + cc] = t[i];
    }
    LDS_BAR();
    {
#pragma unroll
        for (int lv = 1; lv <= 3; ++lv) {
            if (w4 < 4 - lv) {
                const int bi = w4 + lv, bj = w4; f32x4 x = (f32x4){0.f, 0.f, 0.f, 0.f};
#pragma unroll
                for (int kb = 0; kb < 3; ++kb) if (kb < lv) MM16(x, BLK(Af, bi, bj + kb), BLK(Tf, bj + kb, bj));
                LAS float* xo = BLK(Tf, bi, bj) + (lane >> 2) * AP + 4 * (lane & 3);
                *(LAS f32x4*)xo = x;
                LDS_WAIT();
                f32x4 y = (f32x4){0.f, 0.f, 0.f, 0.f};
                MM16(y, BLK(Tf, bi, bi), BLK(Tf, bi, bj));
                LDS_WAIT();
                *(LAS f32x4*)xo = (f32x4){-y[0], -y[1], -y[2], -y[3]};
            }
            LDS_BAR();
        }
    }
#undef MM16
#pragma unroll
    for (int e = 0; e < 4; ++e) { const int idx = (F.tid & 255) + 256 * e, i = idx >> 4, j4 = (idx & 15) * 4;
        f32x4 v = *(const LAS f32x4*)(Tf + i * AP + j4); if ((j4 >> 4) > (i >> 4)) v = (f32x4){0.f, 0.f, 0.f, 0.f};
        u32x2 w; w.x = pk2(v[0], v[1]); w.y = pk2(v[2], v[3]); *(LAS u32x2*)(Tm + i * TP + j4) = w; }
#undef BLK
    LDS_BAR();
    {
        bf16x8 tf[4][2];
#pragma unroll
        for (int mt = 0; mt < 4; ++mt)
#pragma unroll
            for (int ks = 0; ks < 2; ++ks) tf[mt][ks] = *(const LAS bf16x8*)(Tm + (16 * mt + c16) * TP + 32 * ks + 8 * q);
#pragma unroll
        for (int n2 = 0; n2 < 2; ++n2) {
            const int nt = 2 * w4 + n2;
            bf16x8 vf[2], gf[2];
#pragma unroll
            for (int ks = 0; ks < 2; ++ks) {
                const int rr = 32 * ks + 8 * q + (c16 >> 2), cc = 16 * nt + 4 * (c16 & 3);
                vf[ks] = cat8(lds_tr16(Vb + rr * PP + cc), lds_tr16(Vb + (rr + 4) * PP + cc));
                gf[ks] = cat8(lds_tr16(Kbg + rr * PP + cc), lds_tr16(Kbg + (rr + 4) * PP + cc));
            }
#pragma unroll
            for (int mt = 0; mt < 4; ++mt) {
                f32x4 u = (f32x4){0.f, 0.f, 0.f, 0.f}, w = (f32x4){0.f, 0.f, 0.f, 0.f};
#pragma unroll
                for (int ks = 0; ks < 2; ++ks) { u = MFMA16(tf[mt][ks], vf[ks], u);
                                                 w = MFMA16(gf[ks], tf[mt][ks], w); }
                u32x2 uw; uw.x = pk2_sw(u[0], u[1]); uw.y = pk2_sw(u[2], u[3]); *(u32x2*)(gUT + (16 * nt + c16) * 64 + 16 * mt + 4 * q) = uw;
                u32x2 ww; ww.x = pk2_sw(-w[0], -w[1]); ww.y = pk2_sw(-w[2], -w[3]); *(u32x2*)(gW + (16 * mt + c16) * 128 + 16 * nt + 4 * q) = ww;
            }
        }
    }
    LDS_BAR();
}

constexpr int SC_OPS = 61440, SC_W = 0, SC_QD = 17408, SC_KD = 34816, SC_QK = 52224, SC_OT = 2 * SC_OPS, SC_OTB = 17408;
static_assert(SC_OT + 2 * SC_OTB <= MISC_OFF, "scan LDS map");
__device__ __forceinline__ bf16x8 frag2(const LAS bf16_t* p) { const u32x2 a = *(const LAS u32x2*)p, b = *(const LAS u32x2*)(p + 16); return __builtin_bit_cast(bf16x8, (u32x4){a.x, a.y, b.x, b.y}); }
__device__ __forceinline__ void delta_scan(const Frame& F, const CArgs& a, int l, int b, int h, int sl) {
    const int wave = F.wave, lane = F.lane, q = lane >> 4, c16 = lane & 15;
    const bf16_t* items = (const bf16_t*)(F.ws + WS_PREP) + (size_t)((b * NH + h) * NCHUNK) * 36864;
    LAS unsigned char* lds = F.lds;
    __syncthreads();
    if (wave >= 4) {
        const int t2 = F.tid - 256;
        u32x4 stA[14], stB[14];
#pragma unroll
        for (int i = 0; i < 14; ++i) { stA[i] = *(const u32x4*)(items + (size_t)(t2 + 256 * i) * 8); stB[i] = *(const u32x4*)(items + (size_t)36864 + (size_t)(t2 + 256 * i) * 8); }
#define SCAN_LOADER_STEP(s, ST) do { \
            { LAS unsigned char* ob = lds + ((s) & 1) * SC_OPS; \
              _Pragma("unroll") for (int i = 0; i < 14; ++i) { const int idx = t2 + 256 * i; \
                  const int off = (i < 12) ? ((idx >> 10) * 17408 + ((idx & 1023) >> 4) * 272 + (idx & 15) * 16) : (SC_QK + ((idx - 3072) >> 3) * 144 + ((idx - 3072) & 7) * 16); \
                  *(LAS u32x4*)(ob + off) = ST[i]; } } \
            LDS_BAR();                                         \
            { const int cn = ((s) + 2 < NCHUNK) ? (s) + 2 : NCHUNK - 1; \
              _Pragma("unroll") for (int i = 0; i < 14; ++i) ST[i] = *(const u32x4*)(items + (size_t)cn * 36864 + (size_t)(t2 + 256 * i) * 8); } } while (0)
#pragma unroll 1
        for (int s = 0; s < NCHUNK; s += 2) { SCAN_LOADER_STEP(s, stA); SCAN_LOADER_STEP(s + 1, stB); }
#undef SCAN_LOADER_STEP
        LDS_BAR();
    } else if (wave >= 2) {
        const int t3 = F.tid - 128; bf16_t* ON = (bf16_t*)(F.ws + WS_ONG); float* SSQP = (float*)(F.ws + WS_SSQP);
        for (int s = 0; s <= NCHUNK; ++s) {
            LDS_BAR();
            if (s >= 1) { const int cc = s - 1, p = cc & 1;
#pragma unroll
                for (int i = 0; i < 2; ++i) { const int idx = t3 + 128 * i, row = idx >> 2, pc = idx & 3;
                    const size_t gr = (size_t)(b * SEQ + cc * 64 + row);
                    const u32x4 o = *(const LAS u32x4*)(lds + SC_OT + p * SC_OTB + row * 272 + pc * 16);
                    const float o0 = bflo(o.x), o1 = bfhi(o.x), o2 = bflo(o.y), o3 = bfhi(o.y), o4 = bflo(o.z), o5 = bfhi(o.z), o6 = bflo(o.w), o7 = bfhi(o.w);
                    float ss = ((o0 * o0 + o1 * o1) + (o2 * o2 + o3 * o3)) + ((o4 * o4 + o5 * o5) + (o6 * o6 + o7 * o7));
                    ss += WS_DPP(ss, 0xB1); ss += WS_DPP(ss, 0x4E);
                    *(u32x4*)(ON + gr * PK2 + h * 128 + 32 * sl + pc * 8) = o;
                    if (pc == 0) SSQP[(gr * NH + h) * 4 + sl] = ss; } }
        }
    } else {
        const int cb = 32 * sl + 16 * wave;
        const float* DEC = (const float*)(F.ws + WS_DEC) + (b * NH + h) * NCHUNK;
        f32x4 S[8];
#pragma unroll
        for (int i = 0; i < 8; ++i) S[i] = (f32x4){0.f, 0.f, 0.f, 0.f};
        u32x2 un[4], un1[4];
#pragma unroll
        for (int mt = 0; mt < 4; ++mt) { un[mt] = *(const u32x2*)(items + 28672 + (cb + c16) * 64 + 16 * mt + 4 * q); un1[mt] = *(const u32x2*)(items + (size_t)36864 + 28672 + (cb + c16) * 64 + 16 * mt + 4 * q); }
        float dn0 = DEC[0], dn1 = DEC[1];
        const int fo = c16 * PP + 4 * q;
        const int fk = c16 * TP + 4 * q;
        const int ft = (4 * q + (c16 >> 2)) * PP + 4 * (c16 & 3);
        for (int c = 0; c <= NCHUNK; ++c) {
            LDS_BAR();
            if (c == NCHUNK) break;
            const LAS bf16_t* Wl = (const LAS bf16_t*)(lds + (c & 1) * SC_OPS + SC_W); const LAS bf16_t* QDl = (const LAS bf16_t*)(lds + (c & 1) * SC_OPS + SC_QD);
            const LAS bf16_t* KDl = (const LAS bf16_t*)(lds + (c & 1) * SC_OPS + SC_KD); const LAS bf16_t* QKl = (const LAS bf16_t*)(lds + (c & 1) * SC_OPS + SC_QK);
#define LDF_WQ(i) frag2((((i) >> 2) & 1 ? QDl : Wl) + (16 * ((i) >> 3)) * PP + 32 * ((i) & 3) + fo)
#define LDF_QK(j) frag2(QKl + (16 * ((j) >> 1)) * TP + 32 * ((j) & 1) + fk)
#define LDF_KD(j) cat8(lds_tr16(KDl + (32 * ((j) & 1)) * PP + 16 * ((j) >> 1) + ft), lds_tr16(KDl + (32 * ((j) & 1) + 16) * PP + 16 * ((j) >> 1) + ft))
            bf16x8 fr[8];
#pragma unroll
            for (int i = 0; i < 8; ++i) fr[i] = LDF_WQ(i);
            f32x4 vacc[4], oacc[4];
#pragma unroll
            for (int mt = 0; mt < 4; ++mt) { const u32x2 u = un[mt]; vacc[mt] = (f32x4){bflo(u.x), bfhi(u.x), bflo(u.y), bfhi(u.y)}; oacc[mt] = (f32x4){0.f, 0.f, 0.f, 0.f}; }
            const float d = dn0; dn0 = dn1;
#pragma unroll
            for (int mt = 0; mt < 4; ++mt) un[mt] = un1[mt];
            if (c + 2 < NCHUNK) { dn1 = DEC[c + 2];
#pragma unroll
                for (int mt = 0; mt < 4; ++mt) un1[mt] = *(const u32x2*)(items + (size_t)(c + 2) * 36864 + 28672 + (cb + c16) * 64 + 16 * mt + 4 * q); }
            bf16x8 sb[4], vb[2];
#pragma unroll
            for (int ks = 0; ks < 4; ++ks) sb[ks] = pack8(S[2 * ks], S[2 * ks + 1]);
            __builtin_amdgcn_sched_barrier(0);
#pragma unroll
            for (int i = 0; i < 24; ++i) {
                const bf16x8 f = fr[i & 7]; fr[i & 7] = LDF_WQ(i + 8);
                const int mt = i >> 3, ks = i & 3;
                if ((i >> 2) & 1) oacc[mt] = MFMA16(f, sb[ks], oacc[mt]); else vacc[mt] = MFMA16(f, sb[ks], vacc[mt]);
                __builtin_amdgcn_sched_barrier(0);
            }
#pragma unroll
            for (int i = 24; i < 32; ++i) {
                const bf16x8 f = fr[i & 7]; fr[i & 7] = LDF_QK(i - 24);
                const int ks = i & 3;
                if ((i >> 2) & 1) oacc[3] = MFMA16(f, sb[ks], oacc[3]); else vacc[3] = MFMA16(f, sb[ks], vacc[3]);
                __builtin_amdgcn_sched_barrier(0);
            }
            vb[0] = pack8(vacc[0], vacc[1]); vb[1] = pack8(vacc[2], vacc[3]);
#pragma unroll
            for (int j = 0; j < 8; ++j) {
                const bf16x8 f = fr[j & 7]; fr[j & 7] = LDF_KD(j);
                oacc[j >> 1] = MFMA16(f, vb[j & 1], oacc[j >> 1]);
                __builtin_amdgcn_sched_barrier(0);
            }
#pragma unroll
            for (int j = 0; j < 16; ++j) {
                const bf16x8 f = fr[j & 7]; if (j + 8 < 16) fr[j & 7] = LDF_KD(j + 8);
                const int m8 = j >> 1;
                if ((j & 1) == 0) S[m8] = S[m8] * d;
                S[m8] = MFMA16(f, vb[j & 1], S[m8]);
                __builtin_amdgcn_sched_barrier(0);
                if (j == 3) {
                    LAS bf16_t* OT = (LAS bf16_t*)(lds + SC_OT + (c & 1) * SC_OTB) + 16 * wave + c16;
#pragma unroll
                    for (int mt = 0; mt < 4; ++mt) { const unsigned p01 = cvt_pk_bf16(oacc[mt][0], oacc[mt][1]), p23 = cvt_pk_bf16(oacc[mt][2], oacc[mt][3]); const int tok = 16 * mt + 4 * q;
                        OT[(tok + 0) * PP] = (bf16_t)(p01 & 0xffffu); OT[(tok + 1) * PP] = (bf16_t)(p01 >> 16); OT[(tok + 2) * PP] = (bf16_t)(p23 & 0xffffu); OT[(tok + 3) * PP] = (bf16_t)(p23 >> 16); } }
            }
#undef LDF_WQ
#undef LDF_QK
#undef LDF_KD
        }
        float* so = F.out + O_PSSM + ((size_t)(l * NB + b) * NH + h) * 16384;
#pragma unroll
        for (int m8 = 0; m8 < 8; ++m8)
#pragma unroll
            for (int r = 0; r < 4; ++r) so[(16 * m8 + 4 * q + r) * 128 + cb + c16] = S[m8][r];
    }
    __syncthreads();
}

__device__ __forceinline__ void mixer_reference(const Frame& F, const CArgs& a, int l) {
#if !S5_FAST
    if (F.wave == 0) { const int it = F.bx; if (it < 256) { const int b = it >> 6, g = it & 63;
            s5_seq(F, a, l, g, b, false, SEQ, nullptr, nullptr, F.out + O_PS5RE + ((size_t)(l * NB + b) * 64 + g) * 64, F.out + O_PS5IM + ((size_t)(l * NB + b) * 64 + g) * 64); } }
    else { for (int it = F.bx * 7 + (F.wave - 1); it < NSAMP * 64; it += F.G * 7) { const int b = it >> 6, g = it & 63; const size_t so = ((size_t)(l * NSAMP + b) * 64 + g) * 64;
            s5_seq(F, a, l, g, b, true, 1, a.in[I_S5RE] + so, a.in[I_S5IM] + so, F.out + O_SS5RE + so, F.out + O_SS5IM + so); } }
#else
    { const int it = F.bx * 8 + F.wave; s5_sample_wave(F, a, l, it & 63, it >> 6); }
#endif
    __syncthreads();
#if DELTA_FAST
    for (int it = F.bx; it < NB * NCHUNK * 4; it += F.G) delta_prep_item(F, a, l, it >> 7, (it >> 2) & 31, it & 3);
    if (0) { for (int it = F.bx; it < NSAMP * NH; it += F.G) {
#else
    if (F.bx < 32) { const int b = F.bx >> 3, h = F.bx & 7; delta_seq(F, a, l, h, b * SEQ, SEQ, nullptr, nullptr, F.out + O_PSSM + ((size_t)(l * NB + b) * NH + h) * 16384); }
    else { for (int it = F.bx - 32; it < NSAMP * NH; it += F.G - 32) {
#endif
            const int b = it >> 3, h = it & 7; const size_t so = ((size_t)(l * NSAMP + b) * NH + h) * 16384;
            delta_seq(F, a, l, h, NPROMPT + b, 1, a.in[I_SCONV] + (size_t)(l * NSAMP + b) * 3 * CONVCH, a.in[I_SSSM] + so, F.out + O_SSSM + so); } }
}


__device__ __forceinline__ void sample_delta_pair(const Frame& F, const CArgs& a, int l, int it0, int it1) {
    const int tid = F.tid, half = tid >> 8, t2 = tid & 255, lane = F.lane, w4 = F.wave & 3, dv = t2 & 127, kg = t2 >> 7;
    const int it = half ? it1 : it0; const bool act = it >= 0;
    const int b = act ? (it >> 3) : 0, h = it & 7; const int r = NPROMPT + b;
    LAS float* raw = (LAS float*)F.lds + half * 1024;
    LAS float* qk = raw + 384;
    LAS float* part = qk + 256;
    LAS float* red = part + 256;
    const size_t so = ((size_t)(l * NSAMP + b) * NH + h) * 16384;
    const float* ssm0 = a.in[I_SSSM] + so; float* ssm_out = F.out + O_SSSM + so;
    float s[64];
#pragma unroll
    for (int i = 0; i < 64; ++i) s[i] = act ? ssm0[(size_t)(kg * 64 + i) * 128 + dv] : 0.f;
    const bf16_t* QKV = (const bf16_t*)(F.ws + WS_QKV); const float* BA = (const float*)(F.ws + WS_BA); const bf16_t* ZS = (const bf16_t*)(F.ws + WS_ZS); bf16_t* ON = (bf16_t*)(F.ws + WS_ONG);
    const float* cw = a.in[I_CONVW] + (size_t)l * 4 * CONVCH; const float* c0 = a.in[I_SCONV] + (size_t)(l * NSAMP + b) * 3 * CONVCH;
#pragma unroll
    for (int ps = 0; ps < 2; ++ps) { const int ci = t2 + 256 * ps;
        if (ci < 384 && act) { const int ch = (ci >> 7) * 1024 + h * 128 + (ci & 127);
            const float y = cw[ch] * c0[ch] + cw[CONVCH + ch] * c0[CONVCH + ch] + cw[2 * CONVCH + ch] * c0[2 * CONVCH + ch] + cw[3 * CONVCH + ch] * bf2f(QKV[(size_t)r * CONVCH + ch]);
            raw[ci] = siluf_(y); } }
    LDS_BAR();
    if (w4 < 2) { const float v0 = raw[w4 * 128 + lane], v1 = raw[w4 * 128 + 64 + lane]; const float ss = wave_sum(v0 * v0 + v1 * v1);
        const float rs = (__builtin_amdgcn_rsqf(ss + 1e-6f)) * (w4 == 0 ? 0.08838834764831845f : 1.0f); qk[w4 * 128 + lane] = v0 * rs; qk[w4 * 128 + 64 + lane] = v1 * rs; }
    LDS_BAR();
    const float beta = sigmoidf_(BA[(size_t)r * 16 + h]), dec = expf(-expf(a.in[I_ALOG][l * NH + h]) * softplusf_(BA[(size_t)r * 16 + 8 + h] + a.in[I_DTB][l * NH + h]));
    float ks = 0.f;
#pragma unroll
    for (int i = 0; i < 64; ++i) { s[i] *= dec; ks += qk[128 + kg * 64 + i] * s[i]; }
    part[kg * 128 + dv] = ks;
    LDS_BAR();
    const float vnew = (raw[256 + dv] - (part[dv] + part[128 + dv])) * beta;
    LDS_BAR();
    float op = 0.f;
#pragma unroll
    for (int i = 0; i < 64; ++i) { s[i] += qk[128 + kg * 64 + i] * vnew; op += qk[kg * 64 + i] * s[i]; }
    part[kg * 128 + dv] = op;
    LDS_BAR();
    const float o = part[dv] + part[128 + dv];
    const float ss = wave_sum(o * o); if (lane == 0) red[w4] = ss;
    LDS_BAR();
    if (t2 < 128 && act) { const float rstd = __builtin_amdgcn_rsqf((red[0] + red[1]) * (1.0f / 128.0f) + NORM_EPS);
        const float z = bf2f(ZS[(size_t)r * 1024 + h * 128 + dv]); ON[(size_t)r * PK2 + h * 128 + dv] = (bf16_t)f2bf(o * rstd * a.in[I_DNNW][l * 128 + dv] * z); }
    if (act) {
#pragma unroll
        for (int i = 0; i < 64; ++i) ssm_out[(size_t)(kg * 64 + i) * 128 + dv] = s[i]; }
    LDS_BAR();
}
__device__ __forceinline__ void sample_delta(const Frame& F, const CArgs& a, int l) {
    if (F.bx >= F.G - 4) return;
    if (F.bx >= 128) { const int i0 = F.bx - 128;
        sample_delta_pair(F, a, l, i0, i0 + 124); sample_delta_pair(F, a, l, i0 + 248, i0 + 372); sample_delta_pair(F, a, l, i0 + 496, i0 + 620); sample_delta_pair(F, a, l, i0 + 744, -1); }
    else sample_delta_pair(F, a, l, 868 + F.bx, F.bx < 28 ? 996 + F.bx : -1);
}
__device__ __forceinline__ void on_finish(const Frame& F, const CArgs& a, int l, int b0, int nb) {
    const bf16_t* ZS = (const bf16_t*)(F.ws + WS_ZS); bf16_t* ON = (bf16_t*)(F.ws + WS_ONG); const float* SSQP = (const float*)(F.ws + WS_SSQP);
    const int pcn = F.tid & 15; const f32x4 n0 = *(const f32x4*)(a.in[I_DNNW] + l * 128 + pcn * 8), n1 = *(const f32x4*)(a.in[I_DNNW] + l * 128 + pcn * 8 + 4);
    for (int p = (F.bx - b0) * 512 + F.tid; p < NPROMPT * 128; p += nb * 512) {
        const int row = p >> 7, pc = p & 127, h = pc >> 4;
        const f32x4 s4 = *(const f32x4*)(SSQP + ((size_t)row * NH + h) * 4);
        const u32x4 z = *(const u32x4*)(ZS + (size_t)row * 1024 + pc * 8);
        bf16_t* op = ON + (size_t)row * PK2 + pc * 8; const u32x4 o = *(const u32x4*)op;
        const float rstd = __builtin_amdgcn_rsqf(((s4[0] + s4[1]) + (s4[2] + s4[3])) * (1.0f / 128.0f) + NORM_EPS);
        u32x4 wv;
        wv.x = cvt_pk_bf16(bflo(o.x) * rstd * n0[0] * bflo(z.x), bfhi(o.x) * rstd * n0[1] * bfhi(z.x));
        wv.y = cvt_pk_bf16(bflo(o.y) * rstd * n0[2] * bflo(z.y), bfhi(o.y) * rstd * n0[3] * bfhi(z.y));
        wv.z = cvt_pk_bf16(bflo(o.z) * rstd * n1[0] * bflo(z.z), bfhi(o.z) * rstd * n1[1] * bfhi(z.z));
        wv.w = cvt_pk_bf16(bflo(o.w) * rstd * n1[2] * bflo(z.w), bfhi(o.w) * rstd * n1[3] * bfhi(z.w));
        *(u32x4*)op = wv;
    }
}


__device__ __forceinline__ void sample_fixup_w(const Frame& F, const CArgs& a, int l, int r) {
    const float* xo = (l == 0 ? a.in[I_XS] : F.out + (size_t)NPROMPT * D) + (size_t)r * D; const float* PART = (const float*)(F.ws + WS_PART) + (size_t)r * D;
    LAS float* red = (LAS float*)F.lds;
    f32x4 v = ((const f32x4*)xo)[F.tid];
#pragma unroll
    for (int s = 0; s < 8; ++s) v = v + ((const f32x4*)(PART + (size_t)s * NSAMP * D))[F.tid];
    ((f32x4*)(F.out + (size_t)(NPROMPT + r) * D))[F.tid] = v;
    u32x2 w; w.x = cvt_pk_bf16(v[0], v[1]); w.y = cvt_pk_bf16(v[2], v[3]); ((u32x2*)((bf16_t*)(F.ws + WS_XB) + (size_t)(NPROMPT + r) * PK2))[F.tid] = w;
    const float ss = wave_sum((v[0] * v[0] + v[1] * v[1]) + (v[2] * v[2] + v[3] * v[3]));
    __syncthreads();
    if (F.lane == 0) red[F.wave] = ss;
    __syncthreads();
    if (F.tid == 0) ((float*)(F.ws + WS_SSQ))[(size_t)(2 * l + 1) * MP + NPROMPT + r] = ((red[0] + red[1]) + (red[2] + red[3])) + ((red[4] + red[5]) + (red[6] + red[7]));
    __syncthreads();
}

__device__ __forceinline__ void sample_fixup(const Frame& F, int l) {
    const int gw = F.bx * 8 + F.wave, NGW = F.G * 8;
    const float* PART = (const float*)(F.ws + WS_PART); float* ssq = (float*)(F.ws + WS_SSQ) + (size_t)(2 * l + 2) * MP; bf16_t* XB = (bf16_t*)(F.ws + WS_XB);
    for (int r = gw; r < NSAMP; r += NGW) {
        f32x4* x4 = (f32x4*)(F.out + (size_t)(NPROMPT + r) * D) + F.lane; u32x2* o = (u32x2*)(XB + (size_t)(NPROMPT + r) * PK2) + F.lane; float s = 0.f;
#pragma unroll
        for (int j = 0; j < 8; ++j) { f32x4 v = x4[64 * j];
#pragma unroll 2
            for (int sp = 0; sp < NSPLIT; ++sp) v = v + ((const f32x4*)(PART + ((size_t)sp * NSAMP + r) * D) + F.lane)[64 * j];
            x4[64 * j] = v; s += (v[0] * v[0] + v[1] * v[1]) + (v[2] * v[2] + v[3] * v[3]);
            u32x2 w; w.x = cvt_pk_bf16(v[0], v[1]); w.y = cvt_pk_bf16(v[2], v[3]); o[64 * j] = w; }
        s = wave_sum(s); if (F.lane == 0) ssq[NPROMPT + r] = s;
    }
}

__device__ __forceinline__ void final_norm(const Frame& F, const CArgs& a) {
    const int gw = F.bx * 8 + F.wave, NGW = F.G * 8; const float* ssq = (const float*)(F.ws + WS_SSQ) + 4 * MP; const f32x4* nf = (const f32x4*)a.in[I_NF] + F.lane;
    const float* PART = (const float*)(F.ws + WS_PART);
    for (int m = gw; m < MR; m += NGW) {
        f32x4* x4 = (f32x4*)(F.out + (size_t)m * D) + F.lane;
        if (m < NPROMPT) {
            const float rstd = __builtin_amdgcn_rsqf(ssq[m] * (1.0f / D) + NORM_EPS);
#pragma unroll
            for (int j = 0; j < 8; ++j) { f32x4 v = x4[64 * j]; const f32x4 w = nf[64 * j]; v = v * rstd * w; x4[64 * j] = v; }
        } else {
            const int r = m - NPROMPT; f32x4 v[8]; float s = 0.f;
#pragma unroll
            for (int j = 0; j < 8; ++j) { v[j] = x4[64 * j];
#pragma unroll 2
                for (int sp = 0; sp < NSPLIT; ++sp) v[j] = v[j] + ((const f32x4*)(PART + ((size_t)sp * NSAMP + r) * D) + F.lane)[64 * j];
                s += (v[j][0] * v[j][0] + v[j][1] * v[j][1]) + (v[j][2] * v[j][2] + v[j][3] * v[j][3]); }
            s = wave_sum(s); const float rstd = __builtin_amdgcn_rsqf(s * (1.0f / D) + NORM_EPS);
#pragma unroll
            for (int j = 0; j < 8; ++j) x4[64 * j] = v[j] * rstd * nf[64 * j];
        }
    }
}

template <int L, int SP> __device__ __forceinline__ void layer_phase(Frame& F, const CArgs& a) {
    constexpr int l = L;
    unsigned char* ws = F.ws; unsigned char* wb = ws + WS_W0 + l * WS_WSTRIDE;
    float* SSQ = (float*)(ws + WS_SSQ); bf16_t* XB = (bf16_t*)(ws + WS_XB);
    if constexpr (SP == 0) {
        pg8::Gemm g{XB, (const bf16_t*)(wb + WO_IN), D, PK2, PK2}; pg8::StaticOrder S; S.init(MP / 256, NIN / 256, F.G, F.vb);
        pg8::EpiProj E{(bf16_t*)(ws + WS_QKV), (bf16_t*)(ws + WS_ZS), (bf16_t*)(ws + WS_S5A), (bf16_t*)(ws + WS_S5US), (bf16_t*)(ws + WS_SGD), (bf16_t*)(ws + WS_SGS), (float*)(ws + WS_BA), SSQ + (size_t)(2 * l) * MP};
        pg8::gemm_phase(F.lds, F.tid, g, S, E);
        if constexpr (L == 0) { pg8::Unit t_; if (!S.next(4, t_)) convert_pull(F, a, 5); }
    } else if constexpr (SP == 1) {
#if S5_FAST
        { pg8::Gemm g{(const bf16_t*)(ws + WS_S5A), (const bf16_t*)(wb + WO_BTL), 256, 384, 256}; pg8::S5Order S{F.G, F.bx, 128};
          pg8::EpiS5L E{(float*)(ws + WS_S5L)}; pg8::gemm_phase(F.lds, F.tid, g, S, E); }
        __syncthreads();
#endif
        mixer_reference(F, a, l);
    } else if constexpr (SP == 2) {
#if DELTA_FAST
        if (F.bx < 128) delta_scan(F, a, l, (F.bx & 31) >> 3, F.bx & 7, F.bx >> 5);
#endif
        sample_delta(F, a, l);
        if (F.bx >= 128 && F.bx < 252) conv_state_out(F, a, l);
        __syncthreads();
        { pg8::Gemm g{(const bf16_t*)(ws + WS_G5), (const bf16_t*)(wb + WO_GLU), 1024, PK1, PK1, 1}; pg8::SampleOrder S{F.bx, 252, 4};
          pg8::EpiGlu E{(const bf16_t*)(ws + WS_G5), (bf16_t*)(ws + WS_ONG)}; pg8::gemm_phase(F.lds, F.tid, g, S, E); }
    } else if constexpr (SP == 3) {
#if S5_FAST
        if (F.bx < 128 && F.wave < 2) s5_chunk_scan(F, l, F.bx >> 1, 2 * (F.bx & 1) + F.wave);
        __syncthreads();
        { pg8::Gemm g{(const bf16_t*)(ws + WS_S5A), (const bf16_t*)(wb + WO_BTY), 384, 384, 384}; pg8::S5Order S{F.G, F.bx, 0};
          pg8::EpiS5Y E{(bf16_t*)(ws + WS_G5)}; pg8::gemm_phase(F.lds, F.tid, g, S, E); }
#endif
        { const int hf = (F.bx >= 136) ? 1 : 0;
          pg8::Gemm g{(const bf16_t*)(ws + WS_ONG) + hf * 1024, (const bf16_t*)(wb + WO_BRDN) + hf * 1024, 1024, PK2, PK2, 1}; pg8::SampleOrder S{F.bx, 128 + 8 * hf, 8};
          pg8::EpiGate E{(const bf16_t*)(ws + (hf ? WS_SGS : WS_SGD)), hf ? (bf16_t*)(ws + WS_MB) - (size_t)NPROMPT * PK2 : (bf16_t*)(ws + WS_MERGED)};
          pg8::gemm_phase(F.lds, F.tid, g, S, E); }
        if (F.bx >= 144) on_finish(F, a, l, 144, 112);
        if constexpr (L == 0) { if (F.bx >= 144) convert_pull(F, a, 6); }
    } else if constexpr (SP == 4) {
        { pg8::Gemm g{(const bf16_t*)(ws + WS_G5), (const bf16_t*)(wb + WO_GLU), 1024, PK1, PK1}; pg8::StaticOrder S; S.init(32, 4, F.G, F.vb);
          pg8::EpiGlu E{(const bf16_t*)(ws + WS_G5), (bf16_t*)(ws + WS_ONG)};
          pg8::gemm_phase(F.lds, F.tid, g, S, E); }
        { const int c = F.bx - 128, s8 = (c >> 3) & 7, hf = s8 >> 2, ko = (s8 & 3) * 512;
          const bf16_t* Ab = hf ? (const bf16_t*)(ws + WS_MB) - (size_t)NPROMPT * PK2 : (const bf16_t*)(ws + WS_MERGED);
          pg8::Gemm g{Ab + ko, (const bf16_t*)(wb + WO_OUT) + ko, 512, PK2, PK2, 1}; pg8::SplitOrder S{c < 0 ? 1 << 20 : c, 64};
          pg8::EpiPart E{(float*)(ws + WS_PART) + (size_t)s8 * NSAMP * D};
          pg8::gemm_phase(F.lds, F.tid, g, S, E); }
        if constexpr (L == 0) { if (F.bx >= 192) convert_pull(F, a, 4); }
    } else if constexpr (SP == 5) {
        { pg8::Gemm g{(const bf16_t*)(ws + WS_ONG), (const bf16_t*)(wb + WO_BRDN), D, PK2, PK2}; pg8::StaticOrder S; S.init(32, 8, F.G, F.vb);
          pg8::EpiBrM E{(const bf16_t*)(ws + WS_SGD), (const bf16_t*)(ws + WS_SGS), (bf16_t*)(ws + WS_MERGED)}; pg8::gemm_phase(F.lds, F.tid, g, S, E); }
        if (F.bx < NSAMP) sample_fixup_w(F, a, l, F.bx);
    } else if constexpr (SP == 6) {
        pg8::Gemm g{(const bf16_t*)(ws + WS_MERGED), (const bf16_t*)(wb + WO_OUT), D, PK2, PK2}; pg8::StaticOrder S; S.init(32, 8, F.G, F.vb);
        pg8::EpiRes E{l == 0 ? a.in[I_XP] : F.out, l == 0 ? a.in[I_XS] : F.out + (size_t)NPROMPT * D, F.out, XB, SSQ + (size_t)(2 * l + 1) * MP};
        pg8::gemm_phase(F.lds, F.tid, g, S, E);
    } else if constexpr (SP == 7) {
        pg8::Gemm g{XB, (const bf16_t*)(wb + WO_GU), D, PK2, PK2}; pg8::StaticOrder S; S.init(MP / 256, 44, F.G, F.vb);
        pg8::EpiGU E{(bf16_t*)(ws + WS_ACT), SSQ + (size_t)(2 * l + 1) * MP};
        pg8::gemm_phase(F.lds, F.tid, g, S, E);
        if constexpr (L == 0) { pg8::Unit t_; if (!S.next(5, t_)) convert_pull(F, a, 5); }
    } else if constexpr (SP == 8) {
        { pg8::Gemm g{(const bf16_t*)(ws + WS_ACT), (const bf16_t*)(wb + WO_D), FF, PK5, PK5}; pg8::StaticOrder S; S.init(32, 8, F.G, F.vb);
          pg8::EpiRes E{F.out, F.out + (size_t)NPROMPT * D, F.out, XB, SSQ + (size_t)(2 * l + 2) * MP};
          pg8::gemm_phase(F.lds, F.tid, g, S, E); }
        { const int sp = F.bx >> 3;
          pg8::Gemm g{(const bf16_t*)(ws + WS_ACT) + sp * 256, (const bf16_t*)(wb + WO_D) + sp * 256, 256, PK5, PK5, 1}; pg8::SplitOrder S{F.bx, 8 * NSPLIT};
          pg8::EpiPart E{(float*)(ws + WS_PART) + (size_t)sp * NSAMP * D};
          pg8::gemm_phase(F.lds, F.tid, g, S, E); }
    } else {
        sample_fixup(F, l);
        if constexpr (L == 0) convert_pull(F, a, 1 << 20);
    }
}

__global__ void __launch_bounds__(512, 2) fwd(Args a_unused) {
    extern __shared__ __attribute__((aligned(16))) unsigned char lds_raw[];
    CArgs* ap0 = (CArgs*)__builtin_amdgcn_kernarg_segment_ptr();
    Frame F;
    F.lds = (LAS unsigned char*)lds_raw; F.tid = threadIdx.x; F.lane = F.tid & 63; F.wave = __builtin_amdgcn_readfirstlane(F.tid >> 6);
    F.G = gridDim.x; F.bx = blockIdx.x; F.ws = ap0->ws; F.out = ap0->out;
    volatile LAS unsigned* MISC = (volatile LAS unsigned*)(F.lds + MISC_OFF);
    if (F.tid < 64) MISC[F.tid] = 0u;
    __syncthreads();
    const int lo = ap0->ph_lo, hi = ap0->ph_hi, use_bar = ap0->use_bar;
    if (F.tid == 0) MISC[13] = (blockIdx.x % 8) * (gridDim.x / 8) + blockIdx.x / 8;
    XcdBarrier bar; bar.bar = (unsigned*)(F.ws + WS_CTL) + 1024; bar.x = 0; bar.st = nullptr;
    if (use_bar) bar = xcd_barrier_post((unsigned*)(F.ws + WS_CTL) + 1024, MISC + 8);
    if (use_bar && F.tid == 0) MISC[12] = xb_add((unsigned*)(F.ws + WS_CTL) + 8192 + 64 * xb_xcc_id(), 1u);
    F.vb = 0;
#define PHASE_ENTER() CArgs* ap = ap0; asm volatile("" : "+s"(ap)); const CArgs& a = *ap; \
        { int t_ = threadIdx.x; asm volatile("" : "+v"(t_)); F.tid = t_; F.lane = t_ & 63; F.wave = __builtin_amdgcn_readfirstlane(t_ >> 6); } \
        { int b_ = blockIdx.x; asm volatile("" : "+s"(b_)); F.bx = b_; int g_ = gridDim.x; asm volatile("" : "+s"(g_)); F.G = g_; F.vb = __builtin_amdgcn_readfirstlane((int)MISC[13]); } \
        { long z_ = 0; asm volatile("" : "+s"(z_)); F.ws = a.ws + z_; F.out = a.out + z_; }
#define SEAM() do { if (use_bar) { xcd_barrier(bar); \
        if (false && F.tid == 0 && MISC[14] == 0u) { unsigned off_ = 0u; const unsigned x_ = xb_xcc_id(); \
            for (unsigned j_ = 0; j_ < 16; ++j_) { const unsigned c_ = xb_ld(&bar.bar[XB_XCNT(j_)]); if (j_ < x_) off_ += c_; } \
            MISC[13] = off_ + MISC[12]; MISC[14] = 1u; } \
        __syncthreads(); } else __syncthreads(); } while (0)
#define RUN(k, stmt) if (((PHMASK >> (k)) & 1u) && lo <= (k) && (k) < hi) { { PHASE_ENTER(); stmt; } if ((DUPMASK >> (k)) & 1u) { SEAM(); PHASE_ENTER(); stmt; } if ((k) + 1 < hi) SEAM(); }
    RUN(0, p0_prologue(F, a));
    RUN(1, (layer_phase<0, 0>(F, a))); RUN(2, (layer_phase<0, 1>(F, a))); RUN(3, (layer_phase<0, 2>(F, a))); RUN(4, (layer_phase<0, 3>(F, a))); RUN(5, (layer_phase<0, 4>(F, a)));
    RUN(6, (layer_phase<0, 5>(F, a))); RUN(7, (layer_phase<0, 6>(F, a))); RUN(8, (layer_phase<0, 7>(F, a))); RUN(9, (layer_phase<0, 8>(F, a))); RUN(10, (layer_phase<0, 9>(F, a)));
    RUN(11, (layer_phase<1, 0>(F, a))); RUN(12, (layer_phase<1, 1>(F, a))); RUN(13, (layer_phase<1, 2>(F, a))); RUN(14, (layer_phase<1, 3>(F, a))); RUN(15, (layer_phase<1, 4>(F, a)));
    RUN(16, (layer_phase<1, 5>(F, a))); RUN(17, (layer_phase<1, 6>(F, a))); RUN(18, (layer_phase<1, 7>(F, a))); RUN(19, (layer_phase<1, 8>(F, a)));
    RUN(20, final_norm(F, a));
#undef RUN
#undef PHASE_ENTER
}

extern "C" void kernel_launch(void* const* d_in, const int* in_sizes, int n_in, void* d_out, int out_size, void* d_ws, size_t ws_size, hipStream_t stream) {
    static int grid = 0;
    if (grid == 0) {
        if (n_in != 29 || (size_t)out_size != O_END || ws_size < WS_END) { fprintf(stderr, "kernel_launch: unexpected problem: n_in %d out %d ws %zu (need %zu)\n", n_in, out_size, ws_size, (size_t)WS_END); grid = -1; return; }
        int dev = 0, cus = 0, per_cu = 0;
        if (hipGetDevice(&dev) != hipSuccess || hipDeviceGetAttribute(&cus, hipDeviceAttributeMultiprocessorCount, dev) != hipSuccess) { grid = -1; return; }
        if (hipFuncSetAttribute((const void*)fwd, hipFuncAttributeMaxDynamicSharedMemorySize, LDS_BYTES) != hipSuccess) { fprintf(stderr, "kernel_launch: hipFuncSetAttribute failed\n"); grid = -1; return; }
        if (hipOccupancyMaxActiveBlocksPerMultiprocessor(&per_cu, (const void*)fwd, 512, LDS_BYTES) != hipSuccess || per_cu < 1) { fprintf(stderr, "kernel_launch: occupancy query says %d\n", per_cu); }
        (void)hipGetLastError();
        grid = cus;
    }
    if (grid < 0) return;
    (void)hipMemsetAsync((char*)d_ws + WS_CTL, 0, CTL_ZERO_BYTES, stream);
    Args a{};
    for (int i = 0; i < 29; ++i) a.in[i] = (const float*)d_in[i];
    a.out = (float*)d_out; a.ws = (unsigned char*)d_ws;
#ifndef MK_MULTI
#define MK_MULTI 0
#endif
#if MK_MULTI
    for (int ph = 0; ph < NPHASE; ++ph) { a.ph_lo = ph; a.ph_hi = ph + 1; a.use_bar = 0; hipLaunchKernelGGL(fwd, dim3(grid), dim3(512), LDS_BYTES, stream, a); }
#else
    a.ph_lo = 0; a.ph_hi = NPHASE; a.use_bar = 1;
    hipLaunchKernelGGL(fwd, dim3(grid), dim3(512), LDS_BYTES, stream, a);
#endif
}
```
